# Optimizing an MI355X kernel written in HIP

```python
import jax, jax.numpy as jnp
from jax import lax
import numpy as np


D_MODEL = 1024
BATCH = 8
SEQ = 8192
DEPTH = 1

HEAD_DIM = 64
BLOCK = 128
DIL_PATTERNS = ((128, 1), (512, 4), (2048, 16))
N_DIL_GROUPS = 3
DIL_HEADS_PER_GROUP = 8
DIL_HEADS = N_DIL_GROUPS * DIL_HEADS_PER_GROUP
DIL_WIDTH = DIL_HEADS * HEAD_DIM
DIL_MERGED = DIL_HEADS_PER_GROUP * HEAD_DIM
SWA_WINDOW = 128
SWA_Q_HEADS = 16
SWA_KV_HEADS = 2
SWA_Q_WIDTH = SWA_Q_HEADS * HEAD_DIM
SWA_KV_WIDTH = SWA_KV_HEADS * HEAD_DIM
IN_WIDTHS = (DIL_WIDTH, DIL_WIDTH, DIL_WIDTH, SWA_Q_WIDTH, SWA_KV_WIDTH, SWA_KV_WIDTH, D_MODEL, D_MODEL)
IN_WIDTH = sum(IN_WIDTHS)
MOE_GROUPS = 4
EXPERTS_PER_GROUP = 8
N_EXPERTS = MOE_GROUPS * EXPERTS_PER_GROUP
TOP_K = 2
D_EXPERT = 512
RMS_EPS = 1e-6

kernel_name = 'hybrid_dilated_swa_sink_hiermoe_block'


def rmsnorm(x, gain):
    x32 = x.astype(jnp.float32)
    y = x32 * lax.rsqrt(jnp.mean(x32 * x32, axis=-1, keepdims=True) + RMS_EPS)
    return (y * gain.astype(jnp.float32)).astype(x.dtype)


def alibi_slopes(n):
    return (2.0 ** (-8.0 * np.arange(1, n + 1) / n)).astype(np.float32)


def split_cols(proj, widths):
    offs = [0]
    for w in widths:
        offs.append(offs[-1] + w)
    return [proj[..., offs[i]:offs[i + 1]] for i in range(len(widths))]


def banded_attention(q, k, v, slopes, max_back, unit, sinks=None):
    b, s, l, hq, hd = q.shape
    hkv = k.shape[3]
    rep = hq // hkv
    nb = -(-l // BLOCK)
    lp = nb * BLOCK
    pad = [(0, 0), (0, 0), (0, lp - l), (0, 0), (0, 0)]
    qb = jnp.pad(q, pad).reshape(b, s, nb, BLOCK, hkv, rep, hd)
    kb = jnp.pad(k, pad).reshape(b, s, nb, BLOCK, hkv, hd)
    vb = jnp.pad(v, pad).reshape(b, s, nb, BLOCK, hkv, hd)

    def with_prev(z):
        prev = jnp.pad(z[:, :, :-1], [(0, 0), (0, 0), (1, 0), (0, 0), (0, 0), (0, 0)])
        return jnp.concatenate([prev, z], axis=3)

    kk, vv = with_prev(kb), with_prev(vb)
    scores = jnp.einsum('bsnqgrd,bsnkgd->bsngrqk', qb, kk,
                        preferred_element_type=jnp.float32) * (hd ** -0.5)
    a = np.arange(BLOCK)[:, None]
    c = np.arange(2 * BLOCK)[None, :]
    delta = a + BLOCK - c
    band = (delta >= 0) & (delta <= max_back)
    valid = band[None] & ((np.arange(nb)[:, None, None] > 0) | (c >= BLOCK)[None])
    bias = (-slopes.reshape(hkv, rep)[:, :, None, None] * (delta * unit)[None, None]).astype(np.float32)
    scores = jnp.where(valid[None, None, :, None, None], scores + bias, -jnp.inf)
    m = scores.max(axis=-1)
    if sinks is not None:
        sink = sinks.astype(jnp.float32).reshape(hkv, rep)[:, :, None]
        m = jnp.maximum(m, sink)
    p = jnp.exp(scores - m[..., None])
    denom = p.sum(axis=-1)
    if sinks is not None:
        denom = denom + jnp.exp(sink - m)
    out = jnp.einsum('bsngrqk,bsnkgd->bsnqgrd', p, vv.astype(jnp.float32))
    denom_t = jnp.moveaxis(denom, -1, 3)
    out = (out / denom_t[..., None]).reshape(b, s, lp, hq, hd)[:, :, :l]
    lse = (jnp.moveaxis(m, -1, 3) + jnp.log(denom_t)).reshape(b, s, lp, hq)[:, :, :l]
    return out.astype(q.dtype), lse


def dilated_attention(q, k, v):
    b, t = q.shape[:2]
    slopes = alibi_slopes(DIL_HEADS)
    outs, lses = [], []
    for gi, (window, dil) in enumerate(DIL_PATTERNS):
        lo, hi = gi * DIL_HEADS_PER_GROUP, (gi + 1) * DIL_HEADS_PER_GROUP
        l = t // dil

        def to_streams(z):
            return z[:, :, lo:hi].reshape(b, l, dil, DIL_HEADS_PER_GROUP, HEAD_DIM).transpose(0, 2, 1, 3, 4)

        o, lse = banded_attention(to_streams(q), to_streams(k), to_streams(v),
                                  slopes[lo:hi], window // dil, dil)
        outs.append(o.transpose(0, 2, 1, 3, 4).reshape(b, t, DIL_HEADS_PER_GROUP, HEAD_DIM))
        lses.append(lse.transpose(0, 2, 1, 3).reshape(b, t, DIL_HEADS_PER_GROUP))
    alpha = jax.nn.softmax(jnp.stack(lses, axis=2), axis=2)
    y = jnp.einsum('btgh,btghd->bthd', alpha.astype(q.dtype), jnp.stack(outs, axis=2))
    return y.reshape(b, t, DIL_MERGED)


def swa_sink_attention(q, k, v, sinks):
    b, t = q.shape[:2]
    out, _ = banded_attention(q[:, None], k[:, None], v[:, None], alibi_slopes(SWA_Q_HEADS),
                              SWA_WINDOW - 1, 1, sinks=sinks)
    return out[:, 0].reshape(b, t, SWA_Q_WIDTH)


def hier_moe(h, w_group, b_group, w_router, b_router, w_e_gate, w_e_up, w_e_down):
    b, t, d = h.shape
    hf = h.reshape(b * t, d)
    g_logits = (hf @ w_group).astype(jnp.float32) + b_group.astype(jnp.float32)
    g_probs = jax.nn.softmax(g_logits, axis=-1)
    g_top = jnp.argmax(g_logits, axis=-1)
    g_w = jnp.take_along_axis(g_probs, g_top[:, None], axis=1)
    e_logits = ((hf @ w_router).astype(jnp.float32) + b_router.astype(jnp.float32)).reshape(
        -1, MOE_GROUPS, EXPERTS_PER_GROUP)
    e_logits = jnp.take_along_axis(e_logits, g_top[:, None, None], axis=1)[:, 0]
    e_w, e_idx = lax.top_k(jax.nn.softmax(e_logits, axis=-1), TOP_K)
    e_w = e_w / e_w.sum(axis=-1, keepdims=True)
    ids = g_top[:, None] * EXPERTS_PER_GROUP + e_idx
    gates = jnp.einsum('nk,nke->ne', g_w * e_w, jax.nn.one_hot(ids, N_EXPERTS, dtype=jnp.float32))
    out = jnp.zeros_like(hf)
    for e in range(N_EXPERTS):
        a = jax.nn.silu(hf @ w_e_gate[e]) * (hf @ w_e_up[e])
        out = out + gates[:, e:e + 1].astype(hf.dtype) * (a @ w_e_down[e])
    return out.reshape(b, t, d)


def setup_inputs(seed: int = 0) -> dict:
    key = jax.random.key(seed)
    ks = jax.random.split(key, 20)
    f32 = jnp.float32

    def nrm(k, shape, fan_in):
        return jax.random.normal(k, shape, f32) * (fan_in ** -0.5)

    return {
        'x': jax.random.normal(ks[0], (BATCH, SEQ, D_MODEL), f32),
        'g_mix': 1.0 + 0.05 * jax.random.normal(ks[1], (DEPTH, D_MODEL), f32),
        'w_in': nrm(ks[2], (DEPTH, D_MODEL, IN_WIDTH), D_MODEL),
        'sinks': jax.random.normal(ks[3], (DEPTH, SWA_Q_HEADS), f32),
        'w_br_dil': nrm(ks[4], (DEPTH, DIL_MERGED, D_MODEL), DIL_MERGED),
        'w_br_swa': nrm(ks[5], (DEPTH, SWA_Q_WIDTH, D_MODEL), SWA_Q_WIDTH),
        'w_out': nrm(ks[6], (DEPTH, D_MODEL, D_MODEL), D_MODEL),
        'g_ffn': 1.0 + 0.05 * jax.random.normal(ks[7], (DEPTH, D_MODEL), f32),
        'w_group': nrm(ks[8], (DEPTH, D_MODEL, MOE_GROUPS), D_MODEL),
        'b_group': 0.01 * jax.random.normal(ks[9], (DEPTH, MOE_GROUPS), f32),
        'w_router': nrm(ks[10], (DEPTH, D_MODEL, N_EXPERTS), D_MODEL),
        'b_router': 0.01 * jax.random.normal(ks[11], (DEPTH, N_EXPERTS), f32),
        'w_e_gate': nrm(ks[12], (DEPTH, N_EXPERTS, D_MODEL, D_EXPERT), D_MODEL),
        'w_e_up': nrm(ks[13], (DEPTH, N_EXPERTS, D_MODEL, D_EXPERT), D_MODEL),
        'w_e_down': nrm(ks[14], (DEPTH, N_EXPERTS, D_EXPERT, D_MODEL), D_EXPERT),
        'g_final': 1.0 + 0.05 * jax.random.normal(ks[15], (D_MODEL,), f32),
    }


def reference(x, g_mix, w_in, sinks, w_br_dil, w_br_swa, w_out, g_ffn, w_group, b_group,
              w_router, b_router, w_e_gate, w_e_up, w_e_down, g_final):
    b, t, _ = x.shape
    for l in range(DEPTH):
        h = rmsnorm(x, g_mix[l])
        proj = h @ w_in[l]
        q_d, k_d, v_d, q_s, k_s, v_s, gate_d, gate_s = split_cols(proj, IN_WIDTHS)
        y_dil = dilated_attention(q_d.reshape(b, t, DIL_HEADS, HEAD_DIM),
                                  k_d.reshape(b, t, DIL_HEADS, HEAD_DIM),
                                  v_d.reshape(b, t, DIL_HEADS, HEAD_DIM))
        y_swa = swa_sink_attention(q_s.reshape(b, t, SWA_Q_HEADS, HEAD_DIM),
                                   k_s.reshape(b, t, SWA_KV_HEADS, HEAD_DIM),
                                   v_s.reshape(b, t, SWA_KV_HEADS, HEAD_DIM), sinks[l])
        mixed = (jax.nn.sigmoid(gate_d) * (y_dil @ w_br_dil[l])
                 + jax.nn.sigmoid(gate_s) * (y_swa @ w_br_swa[l]))
        x = x + mixed @ w_out[l]
        x = x + hier_moe(rmsnorm(x, g_ffn[l]), w_group[l], b_group[l], w_router[l], b_router[l],
                         w_e_gate[l], w_e_up[l], w_e_down[l])
    return rmsnorm(x, g_final)
```

```cpp
#include <hip/hip_runtime.h>
#include <cstdio>
#include <cstdint>

#ifndef MK_ONE_LAUNCH
#define MK_ONE_LAUNCH 0
#endif

#define LAS __attribute__((address_space(3)))
#define GAS __attribute__((address_space(1)))
typedef unsigned short bf16;
typedef short bf16x8 __attribute__((ext_vector_type(8)));
typedef short s16x4 __attribute__((ext_vector_type(4)));
typedef float f32x4 __attribute__((ext_vector_type(4)));
typedef float f32x16 __attribute__((ext_vector_type(16)));
typedef unsigned u32x4 __attribute__((ext_vector_type(4)));
typedef unsigned u32x2 __attribute__((ext_vector_type(2)));
typedef float f32x2_t __attribute__((ext_vector_type(2)));
typedef __bf16 bf16x2_t __attribute__((ext_vector_type(2)));
typedef GAS unsigned gu32;

constexpr int NB = 8, T = 8192, D = 1024, NTOK = NB * T;
constexpr int QKV_W = 5888;
constexpr int IN_W = 7936;
constexpr int COL_KD = 1536, COL_VD = 3072, COL_QS = 4608, COL_KS = 5632, COL_VS = 5760;
constexpr int NEXP = 32, DEXP = 512;
constexpr int SLOT_ROWS = 2 * NTOK + NEXP * 256;
constexpr int MAX_PANELS = SLOT_ROWS / 256;
constexpr float RMS_EPS = 1e-6f;
constexpr float LOG2E = 1.4426950408889634f, LN2 = 0.6931471805599453f;
constexpr float QSCALE = 0.125f * LOG2E;

constexpr size_t MiB = 1u << 20;
constexpr size_t WS_CTL = 0, CTL_ZERO_BYTES = 1 * MiB;
constexpr size_t WS_WIN = 1 * MiB;
constexpr size_t WS_WBD = 17 * MiB;
constexpr size_t WS_WBS = 18 * MiB;
constexpr size_t WS_WOUT = 20 * MiB;
constexpr size_t WS_WGU = 22 * MiB;
constexpr size_t WS_WD = 86 * MiB;
constexpr size_t WS_WRT = 118 * MiB;
constexpr size_t WS_RE = 119 * MiB;
constexpr size_t WS_RREL = WS_RE + 256 * 1024;
constexpr size_t WS_RW = WS_RREL + 512 * 1024;
constexpr size_t WS_TOS = 121 * MiB;
constexpr size_t WS_WOS = 122 * MiB;
constexpr size_t WS_SOT = 123 * MiB;
constexpr size_t WS_PEX = 124 * MiB;
constexpr size_t WS_LSE = 125 * MiB;
constexpr size_t WS_H = 128 * MiB;
constexpr size_t WS_QKV = 256 * MiB;
constexpr size_t WS_OA = 352 * MiB;
constexpr size_t WS_SGD = 384 * MiB;
constexpr size_t WS_SGS = 512 * MiB;
constexpr size_t WS_YDIL = 640 * MiB;
constexpr size_t WS_YSWA = 704 * MiB;
constexpr size_t WS_MIX = 832 * MiB;
constexpr size_t WS_ACT = 256 * MiB;
constexpr size_t WS_YS = 392 * MiB;
constexpr size_t WS_END = 960 * MiB;
static_assert(WS_ACT + (size_t)SLOT_ROWS * 512 * 2 <= WS_YS && WS_YS + (size_t)SLOT_ROWS * 1024 * 2 <= WS_END, "moe overlay");
constexpr int CW_BAR = 4096;
constexpr int CW_CNT = 8192;

constexpr int LDS_BYTES = 155648;
constexpr int MISC_OFF = LDS_BYTES - 256;
constexpr int PANEL_TAB_OFF = 131072 + 1024;
constexpr int P5_CNT_OFF = 147456, P5_BASE_OFF = P5_CNT_OFF + 128, P5_REC_OFF = P5_BASE_OFF + 128;

#define RLX_AGENT __ATOMIC_RELAXED, __HIP_MEMORY_SCOPE_AGENT
#define LDS_WAIT() asm volatile("s_waitcnt lgkmcnt(0)" ::: "memory")
__device__ __forceinline__ unsigned cvtpk(float lo, float hi) { f32x2_t v = {lo, hi}; bf16x2_t b = __builtin_convertvector(v, bf16x2_t); return __builtin_bit_cast(unsigned, b); }
__device__ __forceinline__ float bf_lo(unsigned u) { return __builtin_bit_cast(float, u << 16); }
__device__ __forceinline__ float bf_hi(unsigned u) { return __builtin_bit_cast(float, u & 0xffff0000u); }
__device__ __forceinline__ unsigned ld_agent(const unsigned* p) { return __hip_atomic_load(p, RLX_AGENT); }
__device__ __forceinline__ float wave_sum(float v) {
#pragma unroll
    for (int o = 1; o < 64; o <<= 1) v += __shfl_xor(v, o);
    return v;
}

namespace pg8 {
constexpr int BM = 256, BK = 64, HALF = 128, HTB = HALF * BK * 2, STAGE_BYTES = 8 * HTB, NXCD = 8, WGM = 8;
__host__ __device__ __forceinline__ int lds_byte(int r, int c) { const int st = (r >> 4) * 2 + (c >> 5), rr = r & 15, cc = c & 31, ob = rr * 64 + cc * 2; return st * 1024 + (ob ^ (((ob >> 9) & 1) << 5)); }
__host__ __device__ __forceinline__ void stage_rc(int b, int& R, int& C) { const int st = b / 1024, sb = b % 1024, swz = sb ^ (((sb >> 9) & 1) << 5); R = (st >> 1) * 16 + swz / 64; C = (st & 1) * 32 + (swz % 64) / 2; }
__host__ __device__ __forceinline__ int perm32(int rho) { const int n = rho >> 4, i = rho & 15; return 8 * (i >> 2) + 4 * n + (i & 3); }

struct Unit { int pm, pn; };
struct Gemm { const bf16* A; const bf16* Bt; int M, N, K; };

struct StaticOrder {
    int nM, nN, nwg, G, c;
    __device__ void init(int M, int N, int G_, int c_) { nM = M / BM; nN = N / BM; nwg = nM * nN; G = G_; c = c_; }
    __device__ bool next(int i, Unit& u) const {
        const long L = (long)i * G + c; if (L >= nwg) return false;
        int wgid = (int)L; { const int q = nwg / NXCD, r = nwg % NXCD, xcd = wgid % NXCD, off = wgid / NXCD; wgid = (xcd < r ? xcd * (q + 1) : r * (q + 1) + (xcd - r) * q) + off; }
        const int nig = WGM * nN, gid = wgid / nig, fm = gid * WGM, gsz = (nM - fm) < WGM ? (nM - fm) : WGM;
        u.pm = fm + ((wgid % nig) % gsz); u.pn = (wgid % nig) / gsz; return true;
    }
};
struct PanelOrder {
    volatile LAS int* tab; int np4, G, c;
    __device__ void init(const unsigned* pex, volatile LAS int* tab_, int G_, int vcu, int tid) {
        tab = tab_; G = G_; c = vcu; np4 = 4 * __builtin_amdgcn_readfirstlane((int)ld_agent(pex + 1023));
        if (tid < 64) { const int L = tid * G_ + vcu; tab_[tid] = (L < np4) ? (int)ld_agent(pex + (L >> 2)) : 0; }
        __syncthreads();
    }
    __device__ bool next(int i, Unit& u) const {
        const int L = i * G + c; if (L >= np4 || i >= 64) return false;
        u.pm = L >> 2; u.pn = 4 * __builtin_amdgcn_readfirstlane(tab[i]) + (L & 3); return true;
    }
};

template <class Epi, class Sched, bool GATHER>
__device__ __forceinline__ void gemm_phase(LAS unsigned char* lds, const int tid, const Gemm g, const Sched& S, const Epi& E, const unsigned* rowidx) {
    const int wid = __builtin_amdgcn_readfirstlane(tid >> 6), lane = tid & 63, wr = wid >> 2, wc = wid & 3, fr = lane & 15, fq = lane >> 4;
    const int K = g.K, nt = K / BK;
    int Rr[2], Cc[2]; unsigned voffB[2];
#pragma unroll
    for (int i = 0; i < 2; ++i) { stage_rc(tid * 16 + i * 8192, Rr[i], Cc[i]); const int Rb = (Rr[i] & ~31) + perm32(Rr[i] & 31); voffB[i] = (unsigned)(Rb * K + Cc[i]) * 2u; }
    const size_t kstep = (size_t)(BK * 2);
    const size_t hstep = (size_t)HALF * K * 2;
    const size_t tstep = 2 * hstep;
    const unsigned ldsw = (unsigned)wid * 1024u;
    const int aoff = lds_byte(wr * 64 + fr, fq * 8), boff = lds_byte(wc * 32 + fr, fq * 8);
    unsigned vc[2][2], vn[2][2];
#define PG8_SA(b, h) (((b) * 2 + (h)) * HTB)
#define PG8_SB(b, h) ((4 + (b) * 2 + (h)) * HTB)
#define PG8_STAGE(bufoff, gbase, voff) do { _Pragma("unroll") for (int _i = 0; _i < 2; ++_i) \
        __builtin_amdgcn_global_load_lds((const unsigned*)((const char*)(gbase) + (voff)[_i]), (LAS unsigned*)(lds + (bufoff) + ldsw + _i * 8192), 16, 0, 0); } while (0)
#define PG8_LDA(dst, b, h) do { _Pragma("unroll") for (int m = 0; m < 4; ++m) _Pragma("unroll") for (int k = 0; k < 2; ++k) dst[m][k] = *(const LAS bf16x8*)(lds + PG8_SA(b, h) + aoff + m * 2048 + k * 1024); } while (0)
#define PG8_LDB(dst, b, h) do { _Pragma("unroll") for (int n = 0; n < 2; ++n) _Pragma("unroll") for (int k = 0; k < 2; ++k) dst[n][k] = *(const LAS bf16x8*)(lds + PG8_SB(b, h) + boff + n * 2048 + k * 1024); } while (0)
#define PG8_MMA(ai, bj, At, Bt) do { __builtin_amdgcn_s_setprio(1); _Pragma("unroll") for (int m = 0; m < 4; ++m) _Pragma("unroll") for (int n = 0; n < 2; ++n) _Pragma("unroll") for (int k = 0; k < 2; ++k) \
        acc[ai][bj][m][n] = __builtin_amdgcn_mfma_f32_16x16x32_bf16(Bt[n][k], At[m][k], acc[ai][bj][m][n], 0, 0, 0); __builtin_amdgcn_s_setprio(0); } while (0)
#define PG8_WAIT_V(n) asm volatile("s_waitcnt vmcnt(" #n ")" ::: "memory")
#define PG8_WAIT_L(n) asm volatile("s_waitcnt lgkmcnt(" #n ")" ::: "memory")
#define PG8_BAR __builtin_amdgcn_s_barrier()
#define PG8_SCHED __builtin_amdgcn_sched_barrier(0)
#define PG8_VOFFS(v, u) do { _Pragma("unroll") for (int _h = 0; _h < 2; ++_h) _Pragma("unroll") for (int _i = 0; _i < 2; ++_i) { \
        if (GATHER) { const unsigned _t = rowidx[(u).pm * BM + _h * HALF + Rr[_i]]; v[_h][_i] = _t * (unsigned)(K * 2) + (unsigned)(Cc[_i] * 2); } \
        else v[_h][_i] = (unsigned)((_h * HALF + Rr[_i]) * K + Cc[_i]) * 2u; } } while (0)
    Unit cur, nxt; int ui = 0;
    if (!S.next(0, cur)) return;
    f32x4 acc[2][2][4][2];
#pragma unroll
    for (int a = 0; a < 2; ++a)
#pragma unroll
        for (int b = 0; b < 2; ++b)
#pragma unroll
            for (int m = 0; m < 4; ++m)
#pragma unroll
                for (int n = 0; n < 2; ++n) acc[a][b][m][n] = (f32x4){0.f, 0.f, 0.f, 0.f};
    bf16x8 At[4][2], B0[2][2], B1[2][2];
    PG8_VOFFS(vc, cur);
    const char* cA = GATHER ? (const char*)g.A : (const char*)g.A + (size_t)cur.pm * tstep; const char* cB = (const char*)g.Bt + (size_t)cur.pn * tstep;
    PG8_STAGE(PG8_SB(0, 0), cB, voffB); PG8_STAGE(PG8_SB(0, 1), cB + hstep, voffB); PG8_STAGE(PG8_SA(0, 0), cA, vc[0]); PG8_STAGE(PG8_SA(0, 1), cA, vc[1]);
    if (wr == 1) PG8_BAR;
    PG8_WAIT_V(2); PG8_BAR;
    PG8_STAGE(PG8_SB(1, 0), cB + kstep, voffB); PG8_STAGE(PG8_SA(1, 0), cA + kstep, vc[0]); PG8_STAGE(PG8_SB(1, 1), cB + hstep + kstep, voffB);
    PG8_WAIT_V(6); PG8_BAR;
    for (;;) {
        const bool has_next = S.next(ui + 1, nxt);
        const char* nA = GATHER ? (const char*)g.A : (has_next ? (const char*)g.A + (size_t)nxt.pm * tstep : cA);
        const char* nB = has_next ? (const char*)g.Bt + (size_t)nxt.pn * tstep : cB;
        if constexpr (GATHER) {
            if (has_next) { PG8_VOFFS(vn, nxt); } else {
#pragma unroll
                for (int h = 0; h < 2; ++h)
#pragma unroll
                    for (int i = 0; i < 2; ++i) vn[h][i] = vc[h][i]; }
        }
        for (int t = 0; t < nt; t += 2) {
            const bool last = (t == nt - 2);
            const char* a1 = cA + (size_t)(t + 1) * kstep;
            const char* a2 = last ? nA : cA + (size_t)(t + 2) * kstep; const char* b2 = last ? nB : cB + (size_t)(t + 2) * kstep;
            const char* a3 = a2 + kstep; const char* b3 = b2 + kstep;
            unsigned v2[2][2];
#pragma unroll
            for (int h = 0; h < 2; ++h)
#pragma unroll
                for (int i = 0; i < 2; ++i) { if constexpr (GATHER) v2[h][i] = last ? vn[h][i] : vc[h][i]; else v2[h][i] = vc[h][i]; }
            PG8_LDB(B0, 0, 0); PG8_LDB(B1, 0, 1); PG8_SCHED; PG8_LDA(At, 0, 0); PG8_STAGE(PG8_SA(1, 1), a1, vc[1]);
            PG8_WAIT_V(8); PG8_WAIT_L(0); PG8_BAR; PG8_MMA(0, 0, At, B0); PG8_MMA(0, 1, At, B1); PG8_BAR; PG8_SCHED;
            PG8_LDA(At, 0, 1); PG8_STAGE(PG8_SB(0, 0), b2, voffB); PG8_STAGE(PG8_SB(0, 1), b2 + hstep, voffB); PG8_STAGE(PG8_SA(0, 0), a2, v2[0]);
            PG8_WAIT_V(8); PG8_WAIT_L(0); PG8_BAR; PG8_MMA(1, 0, At, B0); PG8_MMA(1, 1, At, B1); PG8_BAR; PG8_SCHED;
            PG8_LDB(B0, 1, 0); PG8_LDB(B1, 1, 1); PG8_SCHED; PG8_LDA(At, 1, 0); PG8_STAGE(PG8_SA(0, 1), a2, v2[1]);
            PG8_WAIT_V(8); PG8_WAIT_L(0); PG8_BAR; PG8_MMA(0, 0, At, B0); PG8_MMA(0, 1, At, B1); PG8_BAR; PG8_SCHED;
            PG8_LDA(At, 1, 1); PG8_STAGE(PG8_SB(1, 0), b3, voffB); PG8_STAGE(PG8_SB(1, 1), b3 + hstep, voffB); PG8_STAGE(PG8_SA(1, 0), a3, v2[0]);
            PG8_WAIT_V(8); PG8_WAIT_L(0); PG8_BAR; PG8_MMA(1, 0, At, B0); PG8_MMA(1, 1, At, B1); PG8_BAR; PG8_SCHED;
        }
        if (wr == 0) PG8_BAR;
        E(acc, cur, wr, wc, fr, fq);
        if (!has_next) break;
#pragma unroll
        for (int a = 0; a < 2; ++a)
#pragma unroll
            for (int b = 0; b < 2; ++b)
#pragma unroll
                for (int m = 0; m < 4; ++m)
#pragma unroll
                    for (int n = 0; n < 2; ++n) acc[a][b][m][n] = (f32x4){0.f, 0.f, 0.f, 0.f};
        cur = nxt; cA = nA; cB = nB; ++ui;
        if constexpr (GATHER) {
#pragma unroll
            for (int h = 0; h < 2; ++h)
#pragma unroll
                for (int i = 0; i < 2; ++i) vc[h][i] = vn[h][i];
        }
        if (wr == 1) PG8_BAR;
    }
    PG8_WAIT_V(0);
    PG8_BAR;
#undef PG8_SA
#undef PG8_SB
#undef PG8_STAGE
#undef PG8_LDA
#undef PG8_LDB
#undef PG8_MMA
#undef PG8_WAIT_V
#undef PG8_WAIT_L
#undef PG8_BAR
#undef PG8_SCHED
#undef PG8_VOFFS
}
}

__device__ __forceinline__ float sigmoidf_fast(float a) { return __builtin_amdgcn_rcpf(1.f + __builtin_amdgcn_exp2f(-a * LOG2E)); }
__device__ __forceinline__ u32x4 pack8(const f32x4 a, const f32x4 b) { u32x4 w; w.x = cvtpk(a[0], a[1]); w.y = cvtpk(a[2], a[3]); w.z = cvtpk(b[0], b[1]); w.w = cvtpk(b[2], b[3]); return w; }
__device__ __forceinline__ void unpack8(const u32x4 w, f32x4& a, f32x4& b) { a = (f32x4){bf_lo(w.x), bf_hi(w.x), bf_lo(w.y), bf_hi(w.y)}; b = (f32x4){bf_lo(w.z), bf_hi(w.z), bf_lo(w.w), bf_hi(w.w)}; }
typedef const f32x4 (&AccRef)[2][2][4][2];

struct Epi1 {
    bf16* qkv; bf16* sgd; bf16* sgs; int tok0;
    __device__ __forceinline__ void operator()(AccRef acc, const pg8::Unit& u, int wr, int wc, int fr, int fq) const {
        const int pn = u.pn;
        if (pn < 23) {
            int sh = 0; float sc = 1.f;
            if (pn < 18) { sh = 2 * ((pn % 6) >> 1); if (pn < 6) sc = QSCALE; } else if (pn < 22) sc = QSCALE;
            const int col0 = pn * 256 + wc * 32 + fq * 8;
#pragma unroll
            for (int ai = 0; ai < 2; ++ai)
#pragma unroll
                for (int m = 0; m < 4; ++m) {
                    const int t = u.pm * 256 + ai * 128 + wr * 64 + m * 16 + fr;
                    const int rowp = ((t & ((1 << sh) - 1)) << (13 - sh)) | (t >> sh);
                    bf16* rp = qkv + (size_t)rowp * QKV_W + col0;
#pragma unroll
                    for (int bj = 0; bj < 2; ++bj) *(u32x4*)(rp + bj * 128) = pack8(acc[ai][bj][m][0] * sc, acc[ai][bj][m][1] * sc);
                }
        } else {
            const int col0 = (pn - 23) * 128 + wc * 32 + fq * 8;
#pragma unroll
            for (int ai = 0; ai < 2; ++ai)
#pragma unroll
                for (int m = 0; m < 4; ++m) {
                    const size_t off = (size_t)(tok0 + u.pm * 256 + ai * 128 + wr * 64 + m * 16 + fr) * 1024 + col0;
#pragma unroll
                    for (int bj = 0; bj < 2; ++bj) { f32x4 a = acc[ai][bj][m][0], b = acc[ai][bj][m][1];
#pragma unroll
                        for (int i = 0; i < 4; ++i) { a[i] = sigmoidf_fast(a[i]); b[i] = sigmoidf_fast(b[i]); }
                        *(u32x4*)((bj ? sgs : sgd) + off) = pack8(a, b); }
                }
        }
    }
};
template <bool ADD> struct EpiGate {
    const bf16* sg; bf16* mix;
    __device__ __forceinline__ void operator()(AccRef acc, const pg8::Unit& u, int wr, int wc, int fr, int fq) const {
#pragma unroll
        for (int ai = 0; ai < 2; ++ai)
#pragma unroll
            for (int m = 0; m < 4; ++m) {
                const size_t off = (size_t)(u.pm * 256 + ai * 128 + wr * 64 + m * 16 + fr) * 1024 + u.pn * 256 + wc * 32 + fq * 8;
#pragma unroll
                for (int bj = 0; bj < 2; ++bj) { f32x4 ga, gb; unpack8(*(const u32x4*)(sg + off + bj * 128), ga, gb);
                    f32x4 a = ga * acc[ai][bj][m][0], b = gb * acc[ai][bj][m][1];
                    if (ADD) { f32x4 pa, pb; unpack8(*(const u32x4*)(mix + off + bj * 128), pa, pb); a += pa; b += pb; }
                    *(u32x4*)(mix + off + bj * 128) = pack8(a, b); }
            }
    }
};
struct EpiRes {
    const float* x; float* out;
    __device__ __forceinline__ void operator()(AccRef acc, const pg8::Unit& u, int wr, int wc, int fr, int fq) const {
#pragma unroll
        for (int ai = 0; ai < 2; ++ai)
#pragma unroll
            for (int m = 0; m < 4; ++m) {
                const size_t off = (size_t)(u.pm * 256 + ai * 128 + wr * 64 + m * 16 + fr) * 1024 + u.pn * 256 + wc * 32 + fq * 8;
#pragma unroll
                for (int bj = 0; bj < 2; ++bj)
#pragma unroll
                    for (int n = 0; n < 2; ++n) *(f32x4*)(out + off + bj * 128 + n * 4) = *(const f32x4*)(x + off + bj * 128 + n * 4) + acc[ai][bj][m][n];
            }
    }
};
struct EpiGU {
    bf16* act;
    __device__ __forceinline__ void operator()(AccRef acc, const pg8::Unit& u, int wr, int wc, int fr, int fq) const {
        const int col0 = (u.pn & 3) * 128 + wc * 32 + fq * 8;
#pragma unroll
        for (int ai = 0; ai < 2; ++ai)
#pragma unroll
            for (int m = 0; m < 4; ++m) {
                const size_t off = (size_t)(u.pm * 256 + ai * 128 + wr * 64 + m * 16 + fr) * DEXP + col0;
                f32x4 o[2];
#pragma unroll
                for (int n = 0; n < 2; ++n)
#pragma unroll
                    for (int i = 0; i < 4; ++i) { const float gt = acc[ai][0][m][n][i]; o[n][i] = gt * sigmoidf_fast(gt) * acc[ai][1][m][n][i]; }
                *(u32x4*)(act + off) = pack8(o[0], o[1]);
            }
    }
};
struct EpiDown {
    bf16* ys; const float* wos;
    __device__ __forceinline__ void operator()(AccRef acc, const pg8::Unit& u, int wr, int wc, int fr, int fq) const {
#pragma unroll
        for (int ai = 0; ai < 2; ++ai)
#pragma unroll
            for (int m = 0; m < 4; ++m) {
                const int row = u.pm * 256 + ai * 128 + wr * 64 + m * 16 + fr; const float wv = wos[row];
                const size_t off = (size_t)row * 1024 + (u.pn & 3) * 256 + wc * 32 + fq * 8;
#pragma unroll
                for (int bj = 0; bj < 2; ++bj) *(u32x4*)(ys + off + bj * 128) = pack8(acc[ai][bj][m][0] * wv, acc[ai][bj][m][1] * wv);
            }
    }
};

namespace att {
constexpr int KPITCH = 144, VPITCH = 128, KROWS = 384, LDS_K = 0, LDS_V = KROWS * KPITCH;
static_assert(LDS_V + KROWS * VPITCH <= 131072, "attention LDS");
#define MFMA32(a, b, c) __builtin_amdgcn_mfma_f32_32x32x16_bf16((a), (b), (c), 0, 0, 0)
typedef short v4i16_t __attribute__((ext_vector_type(4)));
__device__ __forceinline__ s16x4 vtr(const LAS unsigned char* p) { return __builtin_bit_cast(s16x4, __builtin_amdgcn_ds_read_tr16_b64_v4i16((LAS v4i16_t*)p)); }

struct UnitDesc {
    const bf16* Q; const bf16* K; const bf16* V;
    bf16* O; float* lse;
    int has_prev, nh, W, mixer, head0, dil;
    int otok0, otstride, opitch, ocol0;
};
__device__ __forceinline__ void attn_unit(LAS unsigned char* lds, const int tid, const UnitDesc& U, const float* sinks) {
    const int w = __builtin_amdgcn_readfirstlane(tid >> 6), lane = tid & 63, ql = lane & 31, h = lane >> 5;
#pragma unroll
    for (int i = 0; i < 6; ++i) {
        const int cid = tid + 512 * i, row = cid >> 3, ch = cid & 7;
        if (U.has_prev || row >= 128) {
            const u32x4 kv = *(const u32x4*)(U.K + (ptrdiff_t)(row - 128) * QKV_W + ch * 8);
            const u32x4 vv = *(const u32x4*)(U.V + (ptrdiff_t)(row - 128) * QKV_W + ch * 8);
            *(LAS u32x4*)(lds + LDS_K + row * KPITCH + ch * 16) = kv;
            *(LAS u32x4*)(lds + LDS_V + row * VPITCH + ((ch ^ (((row >> 1) & 1) << 2)) * 16)) = vv;
        }
    }
    __syncthreads();
    const int cstart = U.has_prev ? 0 : (w < 4 ? 4 - w : 0);
    const int i16 = lane & 15, q4 = i16 >> 2, p4 = i16 & 3, blk = (lane >> 4) & 1, swz = (q4 >> 1) & 1;
    for (int hh = 0; hh < U.nh; ++hh) {
        const int head = U.head0 + hh;
        const float slope = U.mixer ? __builtin_amdgcn_exp2f(-0.5f * (float)(head + 1)) : __builtin_amdgcn_exp2f((float)(head + 1) * (-8.f / 24.f));
        const float c2 = slope * (float)U.dil * LOG2E;
        const float sink2 = U.mixer ? sinks[head] * LOG2E : -INFINITY;
        const bf16* qrow = U.Q + (size_t)(32 * w + ql) * QKV_W + hh * 64 + 8 * h;
        bf16x8 qf[4];
#pragma unroll
        for (int kk = 0; kk < 4; ++kk) qf[kk] = *(const bf16x8*)(qrow + 16 * kk);
        f32x16 S[5];
        const float tl = -c2 * (float)(128 + ql - 4 * h);
#pragma unroll
        for (int c = 0; c < 5; ++c) {
            if (c >= cstart) {
                const float tc = tl + c2 * (32.f * (float)c);
#pragma unroll
                for (int r = 0; r < 16; ++r) S[c][r] = tc + c2 * (float)((r & 3) + 8 * (r >> 2));
                const LAS unsigned char* kp = lds + LDS_K + (32 * w + 32 * c + ql) * KPITCH + h * 16;
#pragma unroll
                for (int kk = 0; kk < 4; ++kk) { const bf16x8 kf = *(const LAS bf16x8*)(kp + kk * 32); S[c] = MFMA32(kf, qf[kk], S[c]); }
            } else {
#pragma unroll
                for (int r = 0; r < 16; ++r) S[c][r] = -INFINITY;
            }
        }
        const int d0 = 128 - U.W;
#pragma unroll
        for (int r = 0; r < 16; ++r) { const int kl = (r & 3) + 8 * (r >> 2) + 4 * h; if (kl < ql + d0) S[0][r] = -INFINITY; if (kl > ql) S[4][r] = -INFINITY; }
        float m = sink2;
#pragma unroll
        for (int c = 0; c < 5; ++c)
#pragma unroll
            for (int r = 0; r < 16; ++r) m = fmaxf(m, S[c][r]);
        m = fmaxf(m, __shfl_xor(m, 32));
        float l = 0.f;
#pragma unroll
        for (int c = 0; c < 5; ++c)
#pragma unroll
            for (int r = 0; r < 16; ++r) { const float p = __builtin_amdgcn_exp2f(S[c][r] - m); S[c][r] = p; l += p; }
        l += __shfl_xor(l, 32);
        l += __builtin_amdgcn_exp2f(sink2 - m);
        f32x16 O[2];
#pragma unroll
        for (int r = 0; r < 16; ++r) { O[0][r] = 0.f; O[1][r] = 0.f; }
#pragma unroll
        for (int c = 0; c < 5; ++c) {
            if (c >= cstart) {
#pragma unroll
                for (int s = 0; s < 2; ++s) {
                    u32x4 pw; pw.x = cvtpk(S[c][8 * s], S[c][8 * s + 1]); pw.y = cvtpk(S[c][8 * s + 2], S[c][8 * s + 3]); pw.z = cvtpk(S[c][8 * s + 4], S[c][8 * s + 5]); pw.w = cvtpk(S[c][8 * s + 6], S[c][8 * s + 7]);
                    const bf16x8 pf = __builtin_bit_cast(bf16x8, pw);
                    const int row0 = 32 * w + 32 * c + 16 * s + 4 * h + q4;
#pragma unroll
                    for (int dt = 0; dt < 2; ++dt) {
                        const LAS unsigned char* vp = lds + LDS_V + row0 * VPITCH + (4 * (dt ^ swz) + 2 * blk + (p4 >> 1)) * 16 + 8 * (p4 & 1);
                        const s16x4 lo = vtr(vp), hi = vtr(vp + 8 * VPITCH);
                        const bf16x8 vf = __builtin_shufflevector(lo, hi, 0, 1, 2, 3, 4, 5, 6, 7);
                        O[dt] = MFMA32(vf, pf, O[dt]);
                    }
                }
            }
        }
        const float inv = 1.f / l;
        const int qi = 32 * w + ql; const size_t orow = (size_t)(U.otok0 + qi * U.otstride);
        bf16* op = U.O + orow * U.opitch + U.ocol0 + hh * 64 + 4 * h;
#pragma unroll
        for (int dt = 0; dt < 2; ++dt)
#pragma unroll
            for (int g4 = 0; g4 < 4; ++g4) { u32x2 o2; o2.x = cvtpk(O[dt][4 * g4] * inv, O[dt][4 * g4 + 1] * inv); o2.y = cvtpk(O[dt][4 * g4 + 2] * inv, O[dt][4 * g4 + 3] * inv);
                *(u32x2*)(op + 32 * dt + 8 * g4) = o2; }
        if (U.lse && h == 0) U.lse[orow * 24 + head] = (m + __builtin_amdgcn_logf(l)) * LN2;
    }
    __syncthreads();
}
#undef MFMA32
}

#define XB_TMO      128
#define XB_XCNT(j)  (256  + 64 * (j))
#define XB_XSUB(j)  (1280 + 64 * (j))
#define XB_XGEN(j)  (2304 + 64 * (j))
#define XB_TOP      3328
#define XB_TOPGEN   3392
#define XCD_BAR_WORDS 3456
#define XB_SPIN_CAP (1u << 18)
__device__ __forceinline__ unsigned xb_ld(unsigned* p)              { return __hip_atomic_load(p, __ATOMIC_RELAXED, __HIP_MEMORY_SCOPE_AGENT); }
__device__ __forceinline__ unsigned xb_add(unsigned* p, unsigned v) { return __hip_atomic_fetch_add(p, v, __ATOMIC_RELAXED, __HIP_MEMORY_SCOPE_AGENT); }
__device__ __forceinline__ unsigned xb_xcc_id() { return (unsigned)__builtin_amdgcn_s_getreg((3 << 11) | 20) & 0xFu; }
#define XB_SPIN(cond, bar) do { unsigned _sp = 0; while (cond) { __builtin_amdgcn_s_sleep(1); \
    if ((++_sp & 255u) == 0u) { if (xb_ld(&(bar)[XB_TMO])) break; if (_sp > XB_SPIN_CAP) { atomicAdd(&(bar)[XB_TMO], 1u); break; } } } } while (0)
struct XcdBarrier { unsigned* bar; unsigned x; volatile LAS unsigned* st; };
__device__ __forceinline__ XcdBarrier xcd_barrier_post(unsigned* bar, volatile LAS unsigned* st) {
    XcdBarrier b; b.bar = bar; b.x = xb_xcc_id(); b.st = st;
    if (threadIdx.x == 0) (void)xb_add(&bar[XB_XCNT(b.x)], 1u);
    return b;
}
__device__ __forceinline__ void xcd_barrier_complete(unsigned* bar, unsigned x, unsigned& nloc, unsigned& nx) {
    const unsigned G = gridDim.x * gridDim.y * gridDim.z;
    unsigned sum, cnt, mine, sp = 0u;
    for (;;) {
        sum = 0u; cnt = 0u; mine = 0u;
#pragma unroll
        for (unsigned j = 0; j < 16; ++j) { const unsigned c = xb_ld(&bar[XB_XCNT(j)]); sum += c; cnt += (c > 0u) ? 1u : 0u; mine = (j == x) ? c : mine; }
        if (sum == G) break;
        __builtin_amdgcn_s_sleep(1);
        if ((++sp & 255u) == 0u) { if (xb_ld(&bar[XB_TMO])) break; if (sp > XB_SPIN_CAP) { atomicAdd(&bar[XB_TMO], 1u); break; } }
    }
    nloc = mine > 0u ? mine : 1u; nx = cnt > 0u ? cnt : 1u;
}
__device__ __forceinline__ void xcd_barrier(const XcdBarrier& b) {
    asm volatile("s_waitcnt vmcnt(0)" ::: "memory");
    __syncthreads();
    if (threadIdx.x == 0) {
        unsigned* bar = b.bar;
        __builtin_amdgcn_s_waitcnt(0);
        unsigned nloc = b.st[0], nx = b.st[1];
        if (nloc == 0u) { xcd_barrier_complete(bar, b.x, nloc, nx); b.st[0] = nloc; b.st[1] = nx; }
        const unsigned old = xb_add(&bar[XB_XSUB(b.x)], 1u);
        const unsigned gen = old / nloc;
        if (old + 1u == (gen + 1u) * nloc) {
            __builtin_amdgcn_fence(__ATOMIC_RELEASE, "agent");
            asm volatile("s_waitcnt vmcnt(0)" ::: "memory");
            const unsigned og = xb_add(&bar[XB_TOP], 1u);
            const unsigned tg = og / nx;
            if (og + 1u == (tg + 1u) * nx) xb_add(&bar[XB_TOPGEN], 1u);
            else XB_SPIN(xb_ld(&bar[XB_TOPGEN]) == tg, bar);
            __builtin_amdgcn_fence(__ATOMIC_ACQUIRE, "agent");
            xb_add(&bar[XB_XGEN(b.x)], 1u);
            asm volatile("s_waitcnt vmcnt(0)" ::: "memory");
        } else {
            XB_SPIN(xb_ld(&bar[XB_XGEN(b.x)]) == gen, bar);
            __builtin_amdgcn_fence(__ATOMIC_ACQUIRE, "agent");
            asm volatile("s_waitcnt vmcnt(0)" ::: "memory");
        }
    }
    __syncthreads();
}

struct Args { const float* in[16]; float* out; unsigned char* ws; int ph_lo, ph_hi; };
struct Frame {
    LAS unsigned char* lds; volatile LAS unsigned* MISC; unsigned* ctl; unsigned char* ws;
    int tid, lane, wave, vcu, G, bx;
};

__device__ __forceinline__ void tr_item(const float* W, int ldw, int k0, int src_n0, bf16* WT, int ldt, int dst_r0, LAS float* scr, int lane) {
#pragma unroll 8
    for (int i = 0; i < 32; ++i) { const int kk = 2 * i + (lane >> 5); scr[kk * 33 + (lane & 31)] = W[(size_t)(k0 + kk) * ldw + src_n0 + (lane & 31)]; }
    LDS_WAIT(); asm volatile("" ::: "memory");
    const int c = lane & 7;
#pragma unroll
    for (int j = 0; j < 4; ++j) { const int n = (lane >> 3) + 8 * j; const LAS float* sp = scr + (8 * c) * 33 + n;
        u32x4 o; o.x = cvtpk(sp[0 * 33], sp[1 * 33]); o.y = cvtpk(sp[2 * 33], sp[3 * 33]); o.z = cvtpk(sp[4 * 33], sp[5 * 33]); o.w = cvtpk(sp[6 * 33], sp[7 * 33]);
        *(u32x4*)(WT + (size_t)(dst_r0 + n) * ldt + k0 + 8 * c) = o; }
    LDS_WAIT(); asm volatile("" ::: "memory");
}
__device__ __forceinline__ void p0_prologue(const Frame& F, const Args& a) {
    LAS float* scr = (LAS float*)(F.lds + F.wave * 16384);
    const int gw = F.vcu * 8 + F.wave, NGW = F.G * 8, lane = F.lane;
    bf16* win = (bf16*)(F.ws + WS_WIN); bf16* wbd = (bf16*)(F.ws + WS_WBD); bf16* wbs = (bf16*)(F.ws + WS_WBS); bf16* wout = (bf16*)(F.ws + WS_WOUT);
    bf16* wgu = (bf16*)(F.ws + WS_WGU); bf16* wd = (bf16*)(F.ws + WS_WD);
    constexpr int I_IN = 16 * 248, I_BD = 8 * 32, I_BS = 16 * 32, I_OUT = 16 * 32, I_G = 32 * 256, I_U = 32 * 256, I_D = 32 * 256;
    constexpr int NITEMS = I_IN + I_BD + I_BS + I_OUT + I_G + I_U + I_D;
    for (int it = gw; it < NITEMS; it += NGW) {
        int r = it;
        if (r < I_IN) { const int kb = r / 248, nb = r % 248, dr = 32 * nb; int src = dr;
            if (dr >= QKV_W) { const int o = dr - QKV_W, j = o >> 8, i = o & 255; src = (i < 128) ? QKV_W + 128 * j + i : QKV_W + 1024 + 128 * j + (i - 128); }
            tr_item(a.in[2], IN_W, 64 * kb, src, win, 1024, dr, scr, lane); continue; } r -= I_IN;
        if (r < I_BD) { tr_item(a.in[4], 1024, 64 * (r >> 5), 32 * (r & 31), wbd, 512, 32 * (r & 31), scr, lane); continue; } r -= I_BD;
        if (r < I_BS) { tr_item(a.in[5], 1024, 64 * (r >> 5), 32 * (r & 31), wbs, 1024, 32 * (r & 31), scr, lane); continue; } r -= I_BS;
        if (r < I_OUT) { tr_item(a.in[6], 1024, 64 * (r >> 5), 32 * (r & 31), wout, 1024, 32 * (r & 31), scr, lane); continue; } r -= I_OUT;
        if (r < I_G + I_U) { const int up = r >= I_G; if (up) r -= I_G; const int e = r >> 8, kb = (r >> 4) & 15, nb = r & 15;
            tr_item((up ? a.in[13] : a.in[12]) + (size_t)e * 1024 * 512, 512, 64 * kb, 32 * nb, wgu, 1024, e * 1024 + 256 * (nb >> 2) + 128 * up + 32 * (nb & 3), scr, lane); continue; } r -= I_G + I_U;
        { const int e = r >> 8, kb = (r >> 5) & 7, nb = r & 31;
            tr_item(a.in[14] + (size_t)e * 512 * 1024, 1024, 64 * kb, 32 * nb, wd, 512, e * 1024 + 32 * nb, scr, lane); }
    }
    { float* wrt = (float*)(F.ws + WS_WRT); const float* gf = a.in[7]; const float* wg = a.in[8]; const float* wr = a.in[10];
        for (int i = F.vcu * 512 + F.tid; i < 36 * 1024; i += F.G * 512) { const int e = i >> 10, k = i & 1023; wrt[i] = gf[k] * (e < 4 ? wg[k * 4 + e] : wr[k * 32 + e - 4]); } }
    { const float* x = a.in[0]; const float* gm = a.in[1]; bf16* H = (bf16*)(F.ws + WS_H);
        f32x4 gv[4];
#pragma unroll
        for (int j = 0; j < 4; ++j) gv[j] = *(const f32x4*)(gm + 4 * lane + 256 * j);
        for (int row = gw; row < NTOK; row += NGW) {
            const f32x4* xr = (const f32x4*)(x + (size_t)row * 1024) + lane; f32x4 v[4]; float ss = 0.f;
#pragma unroll
            for (int j = 0; j < 4; ++j) { v[j] = xr[64 * j]; ss += (v[j].x * v[j].x + v[j].y * v[j].y) + (v[j].z * v[j].z + v[j].w * v[j].w); }
            const float rstd = 1.f / sqrtf(wave_sum(ss) * (1.f / 1024.f) + RMS_EPS);
            u32x2* o = (u32x2*)(H + (size_t)row * 1024) + lane;
#pragma unroll
            for (int j = 0; j < 4; ++j) { const f32x4 t = v[j] * rstd * gv[j]; u32x2 p; p.x = cvtpk(t.x, t.y); p.y = cvtpk(t.z, t.w); o[64 * j] = p; }
        }
    }
}

__device__ __forceinline__ void attn_phase(const Frame& F, const float* sinks, int b) {
    const bf16* qkv = (const bf16*)(F.ws + WS_QKV);
    for (int ui = F.vcu; ui < 1024; ui += F.G) {
        att::UnitDesc U;
        if (ui < 256) {
            const int pair = ui & 3, blkq = (ui >> 2) & 31, kvh = ui >> 7, head0 = kvh * 8 + pair * 2;
            const bf16* rb = qkv + (size_t)(256 * blkq) * QKV_W;
            U.Q = rb + COL_QS + head0 * 64; U.K = rb + COL_KS + kvh * 64; U.V = rb + COL_VS + kvh * 64;
            U.O = (bf16*)(F.ws + WS_YSWA) + (size_t)b * T * 1024; U.lse = nullptr;
            U.has_prev = blkq != 0; U.nh = 2; U.W = 127; U.mixer = 1; U.head0 = head0; U.dil = 1;
            U.otok0 = 256 * blkq; U.otstride = 1; U.opitch = 1024; U.ocol0 = head0 * 64;
        } else {
            const int au = ui - 256, blkq = au & 31, head = au >> 5, sh = 2 * (head >> 3), L = T >> sh;
            const int prow = 256 * blkq, r = prow >> (13 - sh), u0 = prow & (L - 1);
            const bf16* rb = qkv + (size_t)prow * QKV_W;
            U.Q = rb + head * 64; U.K = rb + COL_KD + head * 64; U.V = rb + COL_VD + head * 64;
            U.O = (bf16*)(F.ws + WS_OA); U.lse = (float*)(F.ws + WS_LSE);
            U.has_prev = u0 != 0; U.nh = 1; U.W = 128; U.mixer = 0; U.head0 = head; U.dil = 1 << sh;
            U.otok0 = (u0 << sh) + r; U.otstride = 1 << sh; U.opitch = 1536; U.ocol0 = head * 64;
        }
        att::attn_unit(F.lds, F.tid, U, sinks);
    }
}
__device__ __forceinline__ void merge_phase(const Frame& F, int b) {
    const bf16* oa = (const bf16*)(F.ws + WS_OA); const float* lse = (const float*)(F.ws + WS_LSE); bf16* yd = (bf16*)(F.ws + WS_YDIL) + (size_t)b * T * 512;
    for (int it = F.vcu * 512 + F.tid; it < T * 64; it += F.G * 512) {
        const int dc = it & 7, hs = (it >> 3) & 7, t = it >> 6;
        const float l0 = lse[t * 24 + hs], l1 = lse[t * 24 + 8 + hs], l2 = lse[t * 24 + 16 + hs];
        const float mx = fmaxf(l0, fmaxf(l1, l2));
        float w0 = __expf(l0 - mx), w1 = __expf(l1 - mx), w2 = __expf(l2 - mx); const float inv = 1.f / (w0 + w1 + w2); w0 *= inv; w1 *= inv; w2 *= inv;
        f32x4 a0, b0, a1, b1, a2, b2;
        unpack8(*(const u32x4*)(oa + (size_t)t * 1536 + hs * 64 + dc * 8), a0, b0);
        unpack8(*(const u32x4*)(oa + (size_t)t * 1536 + 512 + hs * 64 + dc * 8), a1, b1);
        unpack8(*(const u32x4*)(oa + (size_t)t * 1536 + 1024 + hs * 64 + dc * 8), a2, b2);
        *(u32x4*)(yd + (size_t)t * 512 + hs * 64 + dc * 8) = pack8(a0 * w0 + a1 * w1 + a2 * w2, b0 * w0 + b1 * w1 + b2 * w2);
    }
}

__device__ __forceinline__ float dot4(const f32x4 a, const f32x4 b) { return (a.x * b.x + a.y * b.y) + (a.z * b.z + a.w * b.w); }
__device__ __forceinline__ void router_phase(const Frame& F, const float* x1, const float* gf, const float* bg, const float* br) {
    const int lane = F.lane, tid = F.tid;
    { const f32x4* src = (const f32x4*)(F.ws + WS_WRT); LAS f32x4* dst = (LAS f32x4*)F.lds;
        for (int i = tid; i < 36 * 256; i += 512) dst[i] = src[i]; }
    volatile LAS unsigned* cnt = (volatile LAS unsigned*)(F.lds + P5_CNT_OFF); volatile LAS unsigned* basew = (volatile LAS unsigned*)(F.lds + P5_BASE_OFF);
    volatile LAS unsigned* rec = (volatile LAS unsigned*)(F.lds + P5_REC_OFF);
    if (tid < 32) cnt[tid] = 0u;
    __syncthreads();
    const int RPW = NTOK / F.G, row0 = F.vcu * RPW;
    bf16* H2 = (bf16*)(F.ws + WS_H); float* rw = (float*)(F.ws + WS_RW);
    f32x4 gv[4];
#pragma unroll
    for (int j = 0; j < 4; ++j) gv[j] = *(const f32x4*)(gf + 4 * lane + 256 * j);
    const LAS f32x4* WL = (const LAS f32x4*)F.lds + lane;
    for (int lt = F.wave; lt < RPW; lt += 8) {
        const int row = row0 + lt;
        const f32x4* xr = (const f32x4*)(x1 + (size_t)row * 1024) + lane; f32x4 v[4]; float ss = 0.f;
#pragma unroll
        for (int j = 0; j < 4; ++j) { v[j] = xr[64 * j]; ss += dot4(v[j], v[j]); }
        const float rstd = 1.f / sqrtf(wave_sum(ss) * (1.f / 1024.f) + RMS_EPS);
        u32x2* o = (u32x2*)(H2 + (size_t)row * 1024) + lane;
#pragma unroll
        for (int j = 0; j < 4; ++j) { const f32x4 t = v[j] * rstd * gv[j]; u32x2 p; p.x = cvtpk(t.x, t.y); p.y = cvtpk(t.z, t.w); o[64 * j] = p; }
        float gl[4];
#pragma unroll
        for (int e = 0; e < 4; ++e) { float p = 0.f;
#pragma unroll
            for (int j = 0; j < 4; ++j) p += dot4(v[j], WL[e * 256 + 64 * j]);
            gl[e] = wave_sum(p) * rstd + bg[e]; }
        int gt = 0; float gm = gl[0];
#pragma unroll
        for (int e = 1; e < 4; ++e) if (gl[e] > gm) { gm = gl[e]; gt = e; }
        float gz = 0.f;
#pragma unroll
        for (int e = 0; e < 4; ++e) gz += __expf(gl[e] - gm);
        const float gwt = 1.f / gz;
        gt = __builtin_amdgcn_readfirstlane(gt);
        float el[8];
#pragma unroll
        for (int e = 0; e < 8; ++e) { float p = 0.f;
#pragma unroll
            for (int j = 0; j < 4; ++j) p += dot4(v[j], WL[(4 + 8 * gt + e) * 256 + 64 * j]);
            el[e] = wave_sum(p) * rstd + br[8 * gt + e]; }
        int i0 = 0; float m0 = el[0];
#pragma unroll
        for (int e = 1; e < 8; ++e) if (el[e] > m0) { m0 = el[e]; i0 = e; }
        int i1 = -1; float m1 = -INFINITY;
#pragma unroll
        for (int e = 0; e < 8; ++e) if (e != i0 && el[e] > m1) { m1 = el[e]; i1 = e; }
        if (i1 < 0) i1 = (i0 == 0) ? 1 : 0;
        const float ed = __expf(m1 - m0), w0 = 1.f / (1.f + ed), w1 = ed * w0;
        if (lane == 0) {
            const unsigned E0 = (unsigned)(8 * gt + i0), E1 = (unsigned)(8 * gt + i1);
            const unsigned r0 = __hip_atomic_fetch_add((LAS unsigned*)&cnt[E0], 1u, __ATOMIC_RELAXED, __HIP_MEMORY_SCOPE_WORKGROUP);
            const unsigned r1 = __hip_atomic_fetch_add((LAS unsigned*)&cnt[E1], 1u, __ATOMIC_RELAXED, __HIP_MEMORY_SCOPE_WORKGROUP);
            rec[lt] = E0 | (E1 << 5) | (r0 << 10) | (r1 << 20);
            rw[2 * row] = gwt * w0; rw[2 * row + 1] = gwt * w1;
        }
    }
    __syncthreads();
    if (tid < 32) basew[tid] = __hip_atomic_fetch_add(F.ctl + CW_CNT + 64 * tid, cnt[tid], RLX_AGENT);
    __syncthreads();
    unsigned* re = (unsigned*)(F.ws + WS_RE); unsigned* rrel = (unsigned*)(F.ws + WS_RREL);
    for (int lt = tid; lt < RPW; lt += 512) { const unsigned rc = rec[lt], E0 = rc & 31u, E1 = (rc >> 5) & 31u; const int row = row0 + lt;
        re[row] = E0 | (E1 << 8); rrel[2 * row] = basew[E0] + ((rc >> 10) & 1023u); rrel[2 * row + 1] = basew[E1] + ((rc >> 20) & 1023u); }
}
__device__ __forceinline__ void slots_phase(const Frame& F) {
    volatile LAS unsigned* cnt = (volatile LAS unsigned*)F.lds; volatile LAS unsigned* off = cnt + 32;
    if (F.tid < 32) cnt[F.tid] = ld_agent(F.ctl + CW_CNT + 64 * F.tid);
    __syncthreads();
    if (F.tid == 0) { unsigned o = 0; for (int e = 0; e < 32; ++e) { off[e] = o; o += (cnt[e] + 255u) & ~255u; } off[32] = o; }
    __syncthreads();
    const int RPW = NTOK / F.G, row0 = F.vcu * RPW;
    const unsigned* re = (const unsigned*)(F.ws + WS_RE); const unsigned* rrel = (const unsigned*)(F.ws + WS_RREL); const float* rw = (const float*)(F.ws + WS_RW);
    unsigned* tos = (unsigned*)(F.ws + WS_TOS); float* wos = (float*)(F.ws + WS_WOS); unsigned* sot = (unsigned*)(F.ws + WS_SOT); unsigned* pex = (unsigned*)(F.ws + WS_PEX);
    for (int lt = F.tid; lt < RPW; lt += 512) { const int row = row0 + lt; const unsigned ev = re[row], e0 = ev & 255u, e1 = ev >> 8;
        const unsigned s0 = off[e0] + rrel[2 * row], s1 = off[e1] + rrel[2 * row + 1];
        tos[s0] = (unsigned)row; tos[s1] = (unsigned)row; wos[s0] = rw[2 * row]; wos[s1] = rw[2 * row + 1]; sot[2 * row] = s0; sot[2 * row + 1] = s1; }
    for (int e = F.vcu; e < 32; e += F.G) { const unsigned c = cnt[e], pad = ((c + 255u) & ~255u) - c;
        for (unsigned i = F.tid; i < pad; i += 512) { tos[off[e] + c + i] = 0u; wos[off[e] + c + i] = 0.f; } }
    if (F.vcu == F.G - 1) { const unsigned np = off[32] >> 8;
        for (unsigned p = F.tid; p < np; p += 512) { unsigned e = 0; for (unsigned k = 0; k < 32; ++k) if (off[k] <= 256u * p && 256u * p < off[k + 1]) e = k; pex[p] = e; }
        if (F.tid == 0) pex[1023] = np; }
    __syncthreads();
}
__device__ __forceinline__ void final_phase(const Frame& F, float* out, const float* gfin) {
    const int lane = F.lane, gw = F.vcu * 8 + F.wave, NGW = F.G * 8;
    const unsigned* sot = (const unsigned*)(F.ws + WS_SOT); const bf16* ys = (const bf16*)(F.ws + WS_YS);
    f32x4 gv[4];
#pragma unroll
    for (int j = 0; j < 4; ++j) gv[j] = *(const f32x4*)(gfin + 4 * lane + 256 * j);
    for (int row = gw; row < NTOK; row += NGW) {
        const unsigned s0 = sot[2 * row], s1 = sot[2 * row + 1];
        f32x4* xr = (f32x4*)(out + (size_t)row * 1024) + lane; const u32x2* y0 = (const u32x2*)(ys + (size_t)s0 * 1024) + lane; const u32x2* y1 = (const u32x2*)(ys + (size_t)s1 * 1024) + lane;
        f32x4 v[4]; float ss = 0.f;
#pragma unroll
        for (int j = 0; j < 4; ++j) { const u32x2 p = y0[64 * j], q = y1[64 * j];
            v[j] = xr[64 * j] + (f32x4){bf_lo(p.x), bf_hi(p.x), bf_lo(p.y), bf_hi(p.y)} + (f32x4){bf_lo(q.x), bf_hi(q.x), bf_lo(q.y), bf_hi(q.y)}; ss += dot4(v[j], v[j]); }
        const float rstd = 1.f / sqrtf(wave_sum(ss) * (1.f / 1024.f) + RMS_EPS);
#pragma unroll
        for (int j = 0; j < 4; ++j) xr[64 * j] = v[j] * rstd * gv[j];
    }
}

constexpr int N_PHASES = 24;
constexpr int KA_OUT = 128, KA_WS = 136, KA_LO = 144, KA_HI = 148;
#if defined(__HIP_DEVICE_COMPILE__)
__device__ __forceinline__ unsigned long long karg64(int off) { auto k = __builtin_amdgcn_kernarg_segment_ptr(); unsigned long long v;
    asm volatile("s_load_dwordx2 %0, %1, %2\n\ts_waitcnt lgkmcnt(0)" : "=s"(v) : "s"(k), "i"(off)); return v; }
__device__ __forceinline__ int karg32(int off) { auto k = __builtin_amdgcn_kernarg_segment_ptr(); int v;
    asm volatile("s_load_dword %0, %1, %2\n\ts_waitcnt lgkmcnt(0)" : "=s"(v) : "s"(k), "i"(off)); return v; }
#else
__device__ __forceinline__ unsigned long long karg64(int) { return 0ull; }
__device__ __forceinline__ int karg32(int) { return 0; }
#endif
#define KIN(i) ((const float*)(const GAS float*)karg64(8 * (i)))
#define KPTR(T, off) ((T*)(GAS T*)karg64(off))
__device__ __forceinline__ Frame make_frame() {
    extern __shared__ __attribute__((aligned(16))) unsigned char lds_raw[];
    Frame F; int tid = threadIdx.x, bx = blockIdx.x, G = gridDim.x;
    asm volatile("" : "+v"(tid)); asm volatile("" : "+s"(bx), "+s"(G));
    F.lds = (LAS unsigned char*)lds_raw; F.MISC = (volatile LAS unsigned*)(F.lds + MISC_OFF);
    F.tid = tid; F.lane = tid & 63; F.wave = __builtin_amdgcn_readfirstlane(tid >> 6);
    F.G = G; F.bx = bx; F.vcu = (G % 8 == 0) ? (bx % 8) * (G / 8) + bx / 8 : bx;
    F.ws = KPTR(unsigned char, KA_WS); F.ctl = (unsigned*)(F.ws + WS_CTL);
    return F;
}
__global__ void __launch_bounds__(512, 2) mk_fwd(Args args_unused) {
    { Frame F = make_frame(); if (F.tid < 64) F.MISC[F.tid] = 0u; __syncthreads();
      if (MK_ONE_LAUNCH) (void)xcd_barrier_post(F.ctl + CW_BAR, F.MISC + 8); }
    const int lo = karg32(KA_LO), hi = karg32(KA_HI);
#define IN(k) (lo <= (k) && (k) < hi)
#define SEAM(k) do { if (IN(k) && IN((k) + 1)) { Frame Fb = make_frame(); XcdBarrier bar; bar.bar = Fb.ctl + CW_BAR; bar.x = xb_xcc_id(); bar.st = Fb.MISC + 8; xcd_barrier(bar); } } while (0)
    if (IN(0)) { Frame F = make_frame(); Args a{}; for (int i = 0; i < 16; ++i) a.in[i] = KIN(i); p0_prologue(F, a); } SEAM(0);
    for (int b = 0; b < NB; ++b) {
        if (IN(1 + 2 * b)) {
            Frame F = make_frame();
            if (b > 0) merge_phase(F, b - 1);
            pg8::Gemm g{(const bf16*)(F.ws + WS_H) + (size_t)b * T * 1024, (const bf16*)(F.ws + WS_WIN), T, IN_W, 1024}; pg8::StaticOrder S; S.init(T, IN_W, F.G, F.bx);
            Epi1 E{(bf16*)(F.ws + WS_QKV), (bf16*)(F.ws + WS_SGD), (bf16*)(F.ws + WS_SGS), b * T};
            pg8::gemm_phase<Epi1, pg8::StaticOrder, false>(F.lds, F.tid, g, S, E, nullptr);
        }
        SEAM(1 + 2 * b);
        if (IN(2 + 2 * b)) { Frame F = make_frame(); attn_phase(F, KIN(3), b); }
        SEAM(2 + 2 * b);
    }
    if (IN(17)) {
        Frame F = make_frame();
        merge_phase(F, NB - 1);
        { pg8::Gemm g{(const bf16*)(F.ws + WS_YSWA), (const bf16*)(F.ws + WS_WBS), NTOK, 1024, 1024}; pg8::StaticOrder S; S.init(NTOK, 1024, F.G, F.bx);
          EpiGate<false> E{(const bf16*)(F.ws + WS_SGS), (bf16*)(F.ws + WS_MIX)};
          pg8::gemm_phase<EpiGate<false>, pg8::StaticOrder, false>(F.lds, F.tid, g, S, E, nullptr); }
    }
    SEAM(17);
    if (IN(18)) {
        Frame F = make_frame();
        { pg8::Gemm g{(const bf16*)(F.ws + WS_YDIL), (const bf16*)(F.ws + WS_WBD), NTOK, 1024, 512}; pg8::StaticOrder S; S.init(NTOK, 1024, F.G, F.bx);
          EpiGate<true> E{(const bf16*)(F.ws + WS_SGD), (bf16*)(F.ws + WS_MIX)};
          pg8::gemm_phase<EpiGate<true>, pg8::StaticOrder, false>(F.lds, F.tid, g, S, E, nullptr); }
    }
    SEAM(18);
    if (IN(19)) {
        Frame F = make_frame();
        pg8::Gemm g{(const bf16*)(F.ws + WS_MIX), (const bf16*)(F.ws + WS_WOUT), NTOK, 1024, 1024}; pg8::StaticOrder S; S.init(NTOK, 1024, F.G, F.bx);
        EpiRes E{KIN(0), KPTR(float, KA_OUT)};
        pg8::gemm_phase<EpiRes, pg8::StaticOrder, false>(F.lds, F.tid, g, S, E, nullptr);
    }
    SEAM(19);
    if (IN(20)) { Frame F = make_frame(); router_phase(F, (const float*)KPTR(float, KA_OUT), KIN(7), KIN(9), KIN(11)); }
    SEAM(20);
    if (IN(21)) { Frame F = make_frame(); slots_phase(F); }
    SEAM(21);
    if (IN(22)) {
        Frame F = make_frame();
        pg8::Gemm g{(const bf16*)(F.ws + WS_H), (const bf16*)(F.ws + WS_WGU), SLOT_ROWS, 1024, 1024}; pg8::PanelOrder S; S.init((const unsigned*)(F.ws + WS_PEX), (volatile LAS int*)(F.lds + PANEL_TAB_OFF), F.G, F.vcu, F.tid);
        EpiGU E{(bf16*)(F.ws + WS_ACT)};
        pg8::gemm_phase<EpiGU, pg8::PanelOrder, true>(F.lds, F.tid, g, S, E, (const unsigned*)(F.ws + WS_TOS));
    }
    SEAM(22);
    if (IN(23)) {
        Frame F = make_frame();
        pg8::Gemm g{(const bf16*)(F.ws + WS_ACT), (const bf16*)(F.ws + WS_WD), SLOT_ROWS, 1024, 512}; pg8::PanelOrder S; S.init((const unsigned*)(F.ws + WS_PEX), (volatile LAS int*)(F.lds + PANEL_TAB_OFF), F.G, F.vcu, F.tid);
        EpiDown E{(bf16*)(F.ws + WS_YS), (const float*)(F.ws + WS_WOS)};
        pg8::gemm_phase<EpiDown, pg8::PanelOrder, false>(F.lds, F.tid, g, S, E, nullptr);
    }
    SEAM(23);
    if (IN(24)) { Frame F = make_frame(); final_phase(F, KPTR(float, KA_OUT), KIN(15)); }
#undef IN
#undef SEAM
}

extern "C" void kernel_launch(void* const* d_in, const int* in_sizes, int n_in, void* d_out, int out_size, void* d_ws, size_t ws_size, hipStream_t stream) {
    static int grid = 0;
    if (grid == 0) {
        if (n_in != 16 || in_sizes[0] != NTOK * D || out_size != NTOK * D || ws_size < WS_END) { fprintf(stderr, "kernel_launch: unexpected shapes / workspace (%d inputs, ws %zu)\n", n_in, ws_size); grid = -1; return; }
        int dev = 0, cus = 0;
        if (hipGetDevice(&dev) != hipSuccess || hipDeviceGetAttribute(&cus, hipDeviceAttributeMultiprocessorCount, dev) != hipSuccess) { grid = -1; return; }
        if (hipFuncSetAttribute((const void*)mk_fwd, hipFuncAttributeMaxDynamicSharedMemorySize, LDS_BYTES) != hipSuccess) { fprintf(stderr, "kernel_launch: hipFuncSetAttribute(%d) failed\n", LDS_BYTES); grid = -1; return; }
        int per_cu = 0;
        if (hipOccupancyMaxActiveBlocksPerMultiprocessor(&per_cu, (const void*)mk_fwd, 512, LDS_BYTES) != hipSuccess || per_cu < 1) { fprintf(stderr, "kernel_launch: occupancy query says %d\n", per_cu); }
        (void)hipGetLastError();
        int g = 64; while (g * 2 <= cus && g * 2 <= 1024) g *= 2;
        grid = g;
    }
    if (grid < 0) return;
    (void)hipMemsetAsync((char*)d_ws + WS_CTL, 0, CTL_ZERO_BYTES, stream);
    Args a{};
    for (int i = 0; i < 16; ++i) a.in[i] = (const float*)d_in[i];
    a.out = (float*)d_out; a.ws = (unsigned char*)d_ws;
#if MK_ONE_LAUNCH
    a.ph_lo = 0; a.ph_hi = N_PHASES + 1;
    hipLaunchKernelGGL(mk_fwd, dim3(grid), dim3(512), LDS_BYTES, stream, a);
#else
    for (int p = 0; p <= N_PHASES; ++p) { a.ph_lo = p; a.ph_hi = p + 1; hipLaunchKernelGGL(mk_fwd, dim3(grid), dim3(512), LDS_BYTES, stream, a); }
#endif
}
```

```cpp
#include <hip/hip_runtime.h>
#include <cstdio>
#include <cstdint>

#ifndef MK_ONE_LAUNCH
#define MK_ONE_LAUNCH 1
#endif

#define LAS __attribute__((address_space(3)))
#define GAS __attribute__((address_space(1)))
typedef unsigned short bf16;
typedef short bf16x8 __attribute__((ext_vector_type(8)));
typedef short s16x4 __attribute__((ext_vector_type(4)));
typedef float f32x4 __attribute__((ext_vector_type(4)));
typedef float f32x16 __attribute__((ext_vector_type(16)));
typedef unsigned u32x4 __attribute__((ext_vector_type(4)));
typedef unsigned u32x2 __attribute__((ext_vector_type(2)));
typedef float f32x2_t __attribute__((ext_vector_type(2)));
typedef __bf16 bf16x2_t __attribute__((ext_vector_type(2)));
typedef GAS unsigned gu32;

constexpr int NB = 8, T = 8192, D = 1024, NTOK = NB * T;
constexpr int QKV_W = 5888;
constexpr int IN_W = 7936;
constexpr int COL_KD = 1536, COL_VD = 3072, COL_QS = 4608, COL_KS = 5632, COL_VS = 5760;
constexpr int NEXP = 32, DEXP = 512;
constexpr int SLOT_ROWS = 2 * NTOK + NEXP * 256;
constexpr int MAX_PANELS = SLOT_ROWS / 256;
constexpr float RMS_EPS = 1e-6f;
constexpr float LOG2E = 1.4426950408889634f, LN2 = 0.6931471805599453f;
constexpr float QSCALE = 0.125f * LOG2E;

constexpr size_t MiB = 1u << 20;
constexpr size_t WS_CTL = 0, CTL_ZERO_BYTES = 1 * MiB;
constexpr size_t WS_WIN = 1 * MiB;
constexpr size_t WS_WBD = 17 * MiB;
constexpr size_t WS_WBS = 18 * MiB;
constexpr size_t WS_WOUT = 20 * MiB;
constexpr size_t WS_WGU = 22 * MiB;
constexpr size_t WS_WD = 86 * MiB;
constexpr size_t WS_WRT = 118 * MiB;
constexpr size_t WS_RE = 119 * MiB;
constexpr size_t WS_RREL = WS_RE + 256 * 1024;
constexpr size_t WS_RW = WS_RREL + 512 * 1024;
constexpr size_t WS_TOS = 121 * MiB;
constexpr size_t WS_WOS = 122 * MiB;
constexpr size_t WS_SOT = 123 * MiB;
constexpr size_t WS_PEX = 124 * MiB;
constexpr size_t WS_LSE = 125 * MiB;
constexpr size_t WS_H = 128 * MiB;
constexpr size_t WS_QKV = 256 * MiB;
constexpr size_t WS_OA = 352 * MiB;
constexpr size_t WS_SGD = 384 * MiB;
constexpr size_t WS_SGS = 512 * MiB;
constexpr size_t WS_YDIL = 640 * MiB;
constexpr size_t WS_YSWA = 704 * MiB;
constexpr size_t WS_MIX = 832 * MiB;
constexpr size_t WS_ACT = 256 * MiB;
constexpr size_t WS_YS = 392 * MiB;
constexpr size_t WS_END = 960 * MiB;
static_assert(WS_ACT + (size_t)SLOT_ROWS * 512 * 2 <= WS_YS && WS_YS + (size_t)SLOT_ROWS * 1024 * 2 <= WS_END, "moe overlay");
constexpr int CW_BAR = 4096;
constexpr int CW_CNT = 8192;

constexpr int LDS_BYTES = 155648;
constexpr int MISC_OFF = LDS_BYTES - 256;
constexpr int PANEL_TAB_OFF = 131072 + 1024;
constexpr int P5_CNT_OFF = 147456, P5_BASE_OFF = P5_CNT_OFF + 128, P5_REC_OFF = P5_BASE_OFF + 128;

#define RLX_AGENT __ATOMIC_RELAXED, __HIP_MEMORY_SCOPE_AGENT
#define LDS_WAIT() asm volatile("s_waitcnt lgkmcnt(0)" ::: "memory")
__device__ __forceinline__ unsigned cvtpk(float lo, float hi) { f32x2_t v = {lo, hi}; bf16x2_t b = __builtin_convertvector(v, bf16x2_t); return __builtin_bit_cast(unsigned, b); }
__device__ __forceinline__ float bf_lo(unsigned u) { return __builtin_bit_cast(float, u << 16); }
__device__ __forceinline__ float bf_hi(unsigned u) { return __builtin_bit_cast(float, u & 0xffff0000u); }
__device__ __forceinline__ unsigned ld_agent(const unsigned* p) { return __hip_atomic_load(p, RLX_AGENT); }
__device__ __forceinline__ float wave_sum(float v) {
#pragma unroll
    for (int o = 1; o < 64; o <<= 1) v += __shfl_xor(v, o);
    return v;
}

namespace pg8 {
constexpr int BM = 256, BK = 64, HALF = 128, HTB = HALF * BK * 2, STAGE_BYTES = 8 * HTB, NXCD = 8, WGM = 8;
__host__ __device__ __forceinline__ int lds_byte(int r, int c) { const int st = (r >> 4) * 2 + (c >> 5), rr = r & 15, cc = c & 31, ob = rr * 64 + cc * 2; return st * 1024 + (ob ^ (((ob >> 9) & 1) << 5)); }
__host__ __device__ __forceinline__ void stage_rc(int b, int& R, int& C) { const int st = b / 1024, sb = b % 1024, swz = sb ^ (((sb >> 9) & 1) << 5); R = (st >> 1) * 16 + swz / 64; C = (st & 1) * 32 + (swz % 64) / 2; }
__host__ __device__ __forceinline__ int perm32(int rho) { const int n = rho >> 4, i = rho & 15; return 8 * (i >> 2) + 4 * n + (i & 3); }

struct Unit { int pm, pn; };
struct Gemm { const bf16* A; const bf16* Bt; int M, N, K; };

struct StaticOrder {
    int nM, nN, nwg, G, c;
    __device__ void init(int M, int N, int G_, int c_) { nM = M / BM; nN = N / BM; nwg = nM * nN; G = G_; c = c_; }
    __device__ bool next(int i, Unit& u) const {
        const long L = (long)i * G + c; if (L >= nwg) return false;
        int wgid = (int)L; { const int q = nwg / NXCD, r = nwg % NXCD, xcd = wgid % NXCD, off = wgid / NXCD; wgid = (xcd < r ? xcd * (q + 1) : r * (q + 1) + (xcd - r) * q) + off; }
        const int nig = WGM * nN, gid = wgid / nig, fm = gid * WGM, gsz = (nM - fm) < WGM ? (nM - fm) : WGM;
        u.pm = fm + ((wgid % nig) % gsz); u.pn = (wgid % nig) / gsz; return true;
    }
};
struct PanelOrder {
    volatile LAS int* tab; int np4, G, c;
    __device__ void init(const unsigned* pex, volatile LAS int* tab_, int G_, int vcu, int tid) {
        tab = tab_; G = G_; c = vcu; np4 = 4 * __builtin_amdgcn_readfirstlane((int)ld_agent(pex + 1023));
        if (tid < 64) { const int L = tid * G_ + vcu; tab_[tid] = (L < np4) ? (int)ld_agent(pex + (L >> 2)) : 0; }
        __syncthreads();
    }
    __device__ bool next(int i, Unit& u) const {
        const int L = i * G + c; if (L >= np4 || i >= 64) return false;
        u.pm = L >> 2; u.pn = 4 * __builtin_amdgcn_readfirstlane(tab[i]) + (L & 3); return true;
    }
};

template <class Epi, class Sched, bool GATHER>
__device__ __forceinline__ void gemm_phase(LAS unsigned char* lds, const int tid, const Gemm g, const Sched& S, const Epi& E, const unsigned* rowidx) {
    const int wid = __builtin_amdgcn_readfirstlane(tid >> 6), lane = tid & 63, wr = wid >> 2, wc = wid & 3, fr = lane & 15, fq = lane >> 4;
    const int K = g.K, nt = K / BK;
    int Rr[2], Cc[2]; unsigned voffB[2];
#pragma unroll
    for (int i = 0; i < 2; ++i) { stage_rc(tid * 16 + i * 8192, Rr[i], Cc[i]); const int Rb = (Rr[i] & ~31) + perm32(Rr[i] & 31); voffB[i] = (unsigned)(Rb * K + Cc[i]) * 2u; }
    const size_t kstep = (size_t)(BK * 2);
    const size_t hstep = (size_t)HALF * K * 2;
    const size_t tstep = 2 * hstep;
    const unsigned ldsw = (unsigned)wid * 1024u;
    const int aoff = lds_byte(wr * 64 + fr, fq * 8), boff = lds_byte(wc * 32 + fr, fq * 8);
    unsigned vc[2][2], vn[2][2];
#define PG8_SA(b, h) (((b) * 2 + (h)) * HTB)
#define PG8_SB(b, h) ((4 + (b) * 2 + (h)) * HTB)
#define PG8_STAGE(bufoff, gbase, voff) do { _Pragma("unroll") for (int _i = 0; _i < 2; ++_i) \
        __builtin_amdgcn_global_load_lds((const unsigned*)((const char*)(gbase) + (voff)[_i]), (LAS unsigned*)(lds + (bufoff) + ldsw + _i * 8192), 16, 0, 0); } while (0)
#define PG8_LDA(dst, b, h) do { _Pragma("unroll") for (int m = 0; m < 4; ++m) _Pragma("unroll") for (int k = 0; k < 2; ++k) dst[m][k] = *(const LAS bf16x8*)(lds + PG8_SA(b, h) + aoff + m * 2048 + k * 1024); } while (0)
#define PG8_LDB(dst, b, h) do { _Pragma("unroll") for (int n = 0; n < 2; ++n) _Pragma("unroll") for (int k = 0; k < 2; ++k) dst[n][k] = *(const LAS bf16x8*)(lds + PG8_SB(b, h) + boff + n * 2048 + k * 1024); } while (0)
#define PG8_MMA(ai, bj, At, Bt) do { __builtin_amdgcn_s_setprio(1); _Pragma("unroll") for (int m = 0; m < 4; ++m) _Pragma("unroll") for (int n = 0; n < 2; ++n) _Pragma("unroll") for (int k = 0; k < 2; ++k) \
        acc[ai][bj][m][n] = __builtin_amdgcn_mfma_f32_16x16x32_bf16(Bt[n][k], At[m][k], acc[ai][bj][m][n], 0, 0, 0); __builtin_amdgcn_s_setprio(0); } while (0)
#define PG8_WAIT_V(n) asm volatile("s_waitcnt vmcnt(" #n ")" ::: "memory")
#define PG8_WAIT_L(n) asm volatile("s_waitcnt lgkmcnt(" #n ")" ::: "memory")
#define PG8_BAR __builtin_amdgcn_s_barrier()
#define PG8_SCHED __builtin_amdgcn_sched_barrier(0)
#define PG8_VOFFS(v, u) do { _Pragma("unroll") for (int _h = 0; _h < 2; ++_h) _Pragma("unroll") for (int _i = 0; _i < 2; ++_i) { \
        if (GATHER) { const unsigned _t = rowidx[(u).pm * BM + _h * HALF + Rr[_i]]; v[_h][_i] = _t * (unsigned)(K * 2) + (unsigned)(Cc[_i] * 2); } \
        else v[_h][_i] = (unsigned)((_h * HALF + Rr[_i]) * K + Cc[_i]) * 2u; } } while (0)
    Unit cur, nxt; int ui = 0;
    if (!S.next(0, cur)) return;
    f32x4 acc[2][2][4][2];
#pragma unroll
    for (int a = 0; a < 2; ++a)
#pragma unroll
        for (int b = 0; b < 2; ++b)
#pragma unroll
            for (int m = 0; m < 4; ++m)
#pragma unroll
                for (int n = 0; n < 2; ++n) acc[a][b][m][n] = (f32x4){0.f, 0.f, 0.f, 0.f};
    bf16x8 At[4][2], B0[2][2], B1[2][2];
    PG8_VOFFS(vc, cur);
    const char* cA = GATHER ? (const char*)g.A : (const char*)g.A + (size_t)cur.pm * tstep; const char* cB = (const char*)g.Bt + (size_t)cur.pn * tstep;
    PG8_STAGE(PG8_SB(0, 0), cB, voffB); PG8_STAGE(PG8_SB(0, 1), cB + hstep, voffB); PG8_STAGE(PG8_SA(0, 0), cA, vc[0]); PG8_STAGE(PG8_SA(0, 1), cA, vc[1]);
    if (wr == 1) PG8_BAR;
    PG8_WAIT_V(2); PG8_BAR;
    PG8_STAGE(PG8_SB(1, 0), cB + kstep, voffB); PG8_STAGE(PG8_SA(1, 0), cA + kstep, vc[0]); PG8_STAGE(PG8_SB(1, 1), cB + hstep + kstep, voffB);
    PG8_WAIT_V(6); PG8_BAR;
    for (;;) {
        const bool has_next = S.next(ui + 1, nxt);
        const char* nA = GATHER ? (const char*)g.A : (has_next ? (const char*)g.A + (size_t)nxt.pm * tstep : cA);
        const char* nB = has_next ? (const char*)g.Bt + (size_t)nxt.pn * tstep : cB;
        if constexpr (GATHER) {
            if (has_next) { PG8_VOFFS(vn, nxt); } else {
#pragma unroll
                for (int h = 0; h < 2; ++h)
#pragma unroll
                    for (int i = 0; i < 2; ++i) vn[h][i] = vc[h][i]; }
        }
        for (int t = 0; t < nt; t += 2) {
            const bool last = (t == nt - 2);
            const char* a1 = cA + (size_t)(t + 1) * kstep;
            const char* a2 = last ? nA : cA + (size_t)(t + 2) * kstep; const char* b2 = last ? nB : cB + (size_t)(t + 2) * kstep;
            const char* a3 = a2 + kstep; const char* b3 = b2 + kstep;
            unsigned v2[2][2];
#pragma unroll
            for (int h = 0; h < 2; ++h)
#pragma unroll
                for (int i = 0; i < 2; ++i) { if constexpr (GATHER) v2[h][i] = last ? vn[h][i] : vc[h][i]; else v2[h][i] = vc[h][i]; }
            PG8_LDB(B0, 0, 0); PG8_LDB(B1, 0, 1); PG8_SCHED; PG8_LDA(At, 0, 0); PG8_STAGE(PG8_SA(1, 1), a1, vc[1]);
            PG8_WAIT_V(8); PG8_WAIT_L(0); PG8_BAR; PG8_MMA(0, 0, At, B0); PG8_MMA(0, 1, At, B1); PG8_BAR; PG8_SCHED;
            PG8_LDA(At, 0, 1); PG8_STAGE(PG8_SB(0, 0), b2, voffB); PG8_STAGE(PG8_SB(0, 1), b2 + hstep, voffB); PG8_STAGE(PG8_SA(0, 0), a2, v2[0]);
            PG8_WAIT_V(8); PG8_WAIT_L(0); PG8_BAR; PG8_MMA(1, 0, At, B0); PG8_MMA(1, 1, At, B1); PG8_BAR; PG8_SCHED;
            PG8_LDB(B0, 1, 0); PG8_LDB(B1, 1, 1); PG8_SCHED; PG8_LDA(At, 1, 0); PG8_STAGE(PG8_SA(0, 1), a2, v2[1]);
            PG8_WAIT_V(8); PG8_WAIT_L(0); PG8_BAR; PG8_MMA(0, 0, At, B0); PG8_MMA(0, 1, At, B1); PG8_BAR; PG8_SCHED;
            PG8_LDA(At, 1, 1); PG8_STAGE(PG8_SB(1, 0), b3, voffB); PG8_STAGE(PG8_SB(1, 1), b3 + hstep, voffB); PG8_STAGE(PG8_SA(1, 0), a3, v2[0]);
            PG8_WAIT_V(8); PG8_WAIT_L(0); PG8_BAR; PG8_MMA(1, 0, At, B0); PG8_MMA(1, 1, At, B1); PG8_BAR; PG8_SCHED;
        }
        if (wr == 0) PG8_BAR;
        E(acc, cur, wr, wc, fr, fq);
        if (!has_next) break;
#pragma unroll
        for (int a = 0; a < 2; ++a)
#pragma unroll
            for (int b = 0; b < 2; ++b)
#pragma unroll
                for (int m = 0; m < 4; ++m)
#pragma unroll
                    for (int n = 0; n < 2; ++n) acc[a][b][m][n] = (f32x4){0.f, 0.f, 0.f, 0.f};
        cur = nxt; cA = nA; cB = nB; ++ui;
        if constexpr (GATHER) {
#pragma unroll
            for (int h = 0; h < 2; ++h)
#pragma unroll
                for (int i = 0; i < 2; ++i) vc[h][i] = vn[h][i];
        }
        if (wr == 1) PG8_BAR;
    }
    PG8_WAIT_V(0);
    PG8_BAR;
#undef PG8_SA
#undef PG8_SB
#undef PG8_STAGE
#undef PG8_LDA
#undef PG8_LDB
#undef PG8_MMA
#undef PG8_WAIT_V
#undef PG8_WAIT_L
#undef PG8_BAR
#undef PG8_SCHED
#undef PG8_VOFFS
}
}

__device__ __forceinline__ float sigmoidf_fast(float a) { return __builtin_amdgcn_rcpf(1.f + __builtin_amdgcn_exp2f(-a * LOG2E)); }
__device__ __forceinline__ u32x4 pack8(const f32x4 a, const f32x4 b) { u32x4 w; w.x = cvtpk(a[0], a[1]); w.y = cvtpk(a[2], a[3]); w.z = cvtpk(b[0], b[1]); w.w = cvtpk(b[2], b[3]); return w; }
__device__ __forceinline__ void unpack8(const u32x4 w, f32x4& a, f32x4& b) { a = (f32x4){bf_lo(w.x), bf_hi(w.x), bf_lo(w.y), bf_hi(w.y)}; b = (f32x4){bf_lo(w.z), bf_hi(w.z), bf_lo(w.w), bf_hi(w.w)}; }
typedef const f32x4 (&AccRef)[2][2][4][2];

struct Epi1 {
    bf16* qkv; bf16* sgd; bf16* sgs; int tok0;
    __device__ __forceinline__ void operator()(AccRef acc, const pg8::Unit& u, int wr, int wc, int fr, int fq) const {
        const int pn = u.pn;
        if (pn < 23) {
            int sh = 0; float sc = 1.f;
            if (pn < 18) { sh = 2 * ((pn % 6) >> 1); if (pn < 6) sc = QSCALE; } else if (pn < 22) sc = QSCALE;
            const int col0 = pn * 256 + wc * 32 + fq * 8;
#pragma unroll
            for (int ai = 0; ai < 2; ++ai)
#pragma unroll
                for (int m = 0; m < 4; ++m) {
                    const int t = u.pm * 256 + ai * 128 + wr * 64 + m * 16 + fr;
                    const int rowp = ((t & ((1 << sh) - 1)) << (13 - sh)) | (t >> sh);
                    bf16* rp = qkv + (size_t)rowp * QKV_W + col0;
#pragma unroll
                    for (int bj = 0; bj < 2; ++bj) *(u32x4*)(rp + bj * 128) = pack8(acc[ai][bj][m][0] * sc, acc[ai][bj][m][1] * sc);
                }
        } else {
            const int col0 = (pn - 23) * 128 + wc * 32 + fq * 8;
#pragma unroll
            for (int ai = 0; ai < 2; ++ai)
#pragma unroll
                for (int m = 0; m < 4; ++m) {
                    const size_t off = (size_t)(tok0 + u.pm * 256 + ai * 128 + wr * 64 + m * 16 + fr) * 1024 + col0;
#pragma unroll
                    for (int bj = 0; bj < 2; ++bj) { f32x4 a = acc[ai][bj][m][0], b = acc[ai][bj][m][1];
#pragma unroll
                        for (int i = 0; i < 4; ++i) { a[i] = sigmoidf_fast(a[i]); b[i] = sigmoidf_fast(b[i]); }
                        *(u32x4*)((bj ? sgs : sgd) + off) = pack8(a, b); }
                }
        }
    }
};
template <bool ADD> struct EpiGate {
    const bf16* sg; bf16* mix;
    __device__ __forceinline__ void operator()(AccRef acc, const pg8::Unit& u, int wr, int wc, int fr, int fq) const {
#pragma unroll
        for (int ai = 0; ai < 2; ++ai)
#pragma unroll
            for (int m = 0; m < 4; ++m) {
                const size_t off = (size_t)(u.pm * 256 + ai * 128 + wr * 64 + m * 16 + fr) * 1024 + u.pn * 256 + wc * 32 + fq * 8;
#pragma unroll
                for (int bj = 0; bj < 2; ++bj) { f32x4 ga, gb; unpack8(*(const u32x4*)(sg + off + bj * 128), ga, gb);
                    f32x4 a = ga * acc[ai][bj][m][0], b = gb * acc[ai][bj][m][1];
                    if (ADD) { f32x4 pa, pb; unpack8(*(const u32x4*)(mix + off + bj * 128), pa, pb); a += pa; b += pb; }
                    *(u32x4*)(mix + off + bj * 128) = pack8(a, b); }
            }
    }
};
struct EpiRes {
    const float* x; float* out;
    __device__ __forceinline__ void operator()(AccRef acc, const pg8::Unit& u, int wr, int wc, int fr, int fq) const {
#pragma unroll
        for (int ai = 0; ai < 2; ++ai)
#pragma unroll
            for (int m = 0; m < 4; ++m) {
                const size_t off = (size_t)(u.pm * 256 + ai * 128 + wr * 64 + m * 16 + fr) * 1024 + u.pn * 256 + wc * 32 + fq * 8;
#pragma unroll
                for (int bj = 0; bj < 2; ++bj)
#pragma unroll
                    for (int n = 0; n < 2; ++n) *(f32x4*)(out + off + bj * 128 + n * 4) = *(const f32x4*)(x + off + bj * 128 + n * 4) + acc[ai][bj][m][n];
            }
    }
};
struct EpiGU {
    bf16* act;
    __device__ __forceinline__ void operator()(AccRef acc, const pg8::Unit& u, int wr, int wc, int fr, int fq) const {
        const int col0 = (u.pn & 3) * 128 + wc * 32 + fq * 8;
#pragma unroll
        for (int ai = 0; ai < 2; ++ai)
#pragma unroll
            for (int m = 0; m < 4; ++m) {
                const size_t off = (size_t)(u.pm * 256 + ai * 128 + wr * 64 + m * 16 + fr) * DEXP + col0;
                f32x4 o[2];
#pragma unroll
                for (int n = 0; n < 2; ++n)
#pragma unroll
                    for (int i = 0; i < 4; ++i) { const float gt = acc[ai][0][m][n][i]; o[n][i] = gt * sigmoidf_fast(gt) * acc[ai][1][m][n][i]; }
                *(u32x4*)(act + off) = pack8(o[0], o[1]);
            }
    }
};
struct EpiDown {
    bf16* ys; const float* wos;
    __device__ __forceinline__ void operator()(AccRef acc, const pg8::Unit& u, int wr, int wc, int fr, int fq) const {
#pragma unroll
        for (int ai = 0; ai < 2; ++ai)
#pragma unroll
            for (int m = 0; m < 4; ++m) {
                const int row = u.pm * 256 + ai * 128 + wr * 64 + m * 16 + fr; const float wv = wos[row];
                const size_t off = (size_t)row * 1024 + (u.pn & 3) * 256 + wc * 32 + fq * 8;
#pragma unroll
                for (int bj = 0; bj < 2; ++bj) *(u32x4*)(ys + off + bj * 128) = pack8(acc[ai][bj][m][0] * wv, acc[ai][bj][m][1] * wv);
            }
    }
};

namespace att {
constexpr int KPITCH = 144, VPITCH = 128, KROWS = 384, LDS_K = 0, LDS_V = KROWS * KPITCH;
static_assert(LDS_V + KROWS * VPITCH <= 131072, "attention LDS");
#define MFMA32(a, b, c) __builtin_amdgcn_mfma_f32_32x32x16_bf16((a), (b), (c), 0, 0, 0)
typedef short v4i16_t __attribute__((ext_vector_type(4)));
__device__ __forceinline__ s16x4 vtr(const LAS unsigned char* p) { return __builtin_bit_cast(s16x4, __builtin_amdgcn_ds_read_tr16_b64_v4i16((LAS v4i16_t*)p)); }

struct UnitDesc {
    const bf16* Q; const bf16* K; const bf16* V;
    bf16* O; float* lse;
    int has_prev, nh, W, mixer, head0, dil;
    int otok0, otstride, opitch, ocol0;
};
__device__ __forceinline__ void attn_unit(LAS unsigned char* lds, const int tid, const UnitDesc& U, const float* sinks) {
    const int w = __builtin_amdgcn_readfirstlane(tid >> 6), lane = tid & 63, ql = lane & 31, h = lane >> 5;
#pragma unroll
    for (int i = 0; i < 6; ++i) {
        const int cid = tid + 512 * i, row = cid >> 3, ch = cid & 7;
        if (U.has_prev || row >= 128) {
            const u32x4 kv = *(const u32x4*)(U.K + (ptrdiff_t)(row - 128) * QKV_W + ch * 8);
            const u32x4 vv = *(const u32x4*)(U.V + (ptrdiff_t)(row - 128) * QKV_W + ch * 8);
            *(LAS u32x4*)(lds + LDS_K + row * KPITCH + ch * 16) = kv;
            *(LAS u32x4*)(lds + LDS_V + row * VPITCH + ((ch ^ (((row >> 1) & 1) << 2)) * 16)) = vv;
        }
    }
    __syncthreads();
    const int cstart = U.has_prev ? 0 : (w < 4 ? 4 - w : 0);
    const int i16 = lane & 15, q4 = i16 >> 2, p4 = i16 & 3, blk = (lane >> 4) & 1, swz = (q4 >> 1) & 1;
    for (int hh = 0; hh < U.nh; ++hh) {
        const int head = U.head0 + hh;
        const float slope = U.mixer ? __builtin_amdgcn_exp2f(-0.5f * (float)(head + 1)) : __builtin_amdgcn_exp2f((float)(head + 1) * (-8.f / 24.f));
        const float c2 = slope * (float)U.dil * LOG2E;
        const float sink2 = U.mixer ? sinks[head] * LOG2E : -INFINITY;
        const bf16* qrow = U.Q + (size_t)(32 * w + ql) * QKV_W + hh * 64 + 8 * h;
        bf16x8 qf[4];
#pragma unroll
        for (int kk = 0; kk < 4; ++kk) qf[kk] = *(const bf16x8*)(qrow + 16 * kk);
        f32x16 S[5];
        const float tl = -c2 * (float)(128 + ql - 4 * h);
#pragma unroll
        for (int c = 0; c < 5; ++c) {
            if (c >= cstart) {
                const float tc = tl + c2 * (32.f * (float)c);
#pragma unroll
                for (int r = 0; r < 16; ++r) S[c][r] = tc + c2 * (float)((r & 3) + 8 * (r >> 2));
                const LAS unsigned char* kp = lds + LDS_K + (32 * w + 32 * c + ql) * KPITCH + h * 16;
#pragma unroll
                for (int kk = 0; kk < 4; ++kk) { const bf16x8 kf = *(const LAS bf16x8*)(kp + kk * 32); S[c] = MFMA32(kf, qf[kk], S[c]); }
            } else {
#pragma unroll
                for (int r = 0; r < 16; ++r) S[c][r] = -INFINITY;
            }
        }
        const int d0 = 128 - U.W;
#pragma unroll
        for (int r = 0; r < 16; ++r) { const int kl = (r & 3) + 8 * (r >> 2) + 4 * h; if (kl < ql + d0) S[0][r] = -INFINITY; if (kl > ql) S[4][r] = -INFINITY; }
        float m = sink2;
#pragma unroll
        for (int c = 0; c < 5; ++c)
#pragma unroll
            for (int r = 0; r < 16; ++r) m = fmaxf(m, S[c][r]);
        m = fmaxf(m, __shfl_xor(m, 32));
        float l = 0.f;
#pragma unroll
        for (int c = 0; c < 5; ++c)
#pragma unroll
            for (int r = 0; r < 16; ++r) { const float p = __builtin_amdgcn_exp2f(S[c][r] - m); S[c][r] = p; l += p; }
        l += __shfl_xor(l, 32);
        l += __builtin_amdgcn_exp2f(sink2 - m);
        f32x16 O[2];
#pragma unroll
        for (int r = 0; r < 16; ++r) { O[0][r] = 0.f; O[1][r] = 0.f; }
#pragma unroll
        for (int c = 0; c < 5; ++c) {
            if (c >= cstart) {
#pragma unroll
                for (int s = 0; s < 2; ++s) {
                    u32x4 pw; pw.x = cvtpk(S[c][8 * s], S[c][8 * s + 1]); pw.y = cvtpk(S[c][8 * s + 2], S[c][8 * s + 3]); pw.z = cvtpk(S[c][8 * s + 4], S[c][8 * s + 5]); pw.w = cvtpk(S[c][8 * s + 6], S[c][8 * s + 7]);
                    const bf16x8 pf = __builtin_bit_cast(bf16x8, pw);
                    const int row0 = 32 * w + 32 * c + 16 * s + 4 * h + q4;
#pragma unroll
                    for (int dt = 0; dt < 2; ++dt) {
                        const LAS unsigned char* vp = lds + LDS_V + row0 * VPITCH + (4 * (dt ^ swz) + 2 * blk + (p4 >> 1)) * 16 + 8 * (p4 & 1);
                        const s16x4 lo = vtr(vp), hi = vtr(vp + 8 * VPITCH);
                        const bf16x8 vf = __builtin_shufflevector(lo, hi, 0, 1, 2, 3, 4, 5, 6, 7);
                        O[dt] = MFMA32(vf, pf, O[dt]);
                    }
                }
            }
        }
        const float inv = 1.f / l;
        const int qi = 32 * w + ql; const size_t orow = (size_t)(U.otok0 + qi * U.otstride);
        bf16* op = U.O + orow * U.opitch + U.ocol0 + hh * 64 + 4 * h;
#pragma unroll
        for (int dt = 0; dt < 2; ++dt)
#pragma unroll
            for (int g4 = 0; g4 < 4; ++g4) { u32x2 o2; o2.x = cvtpk(O[dt][4 * g4] * inv, O[dt][4 * g4 + 1] * inv); o2.y = cvtpk(O[dt][4 * g4 + 2] * inv, O[dt][4 * g4 + 3] * inv);
                *(u32x2*)(op + 32 * dt + 8 * g4) = o2; }
        if (U.lse && h == 0) U.lse[orow * 24 + head] = (m + __builtin_amdgcn_logf(l)) * LN2;
    }
    __syncthreads();
}
#undef MFMA32
}

#define XB_TMO      128
#define XB_XCNT(j)  (256  + 64 * (j))
#define XB_XSUB(j)  (1280 + 64 * (j))
#define XB_XGEN(j)  (2304 + 64 * (j))
#define XB_TOP      3328
#define XB_TOPGEN   3392
#define XCD_BAR_WORDS 3456
#define XB_SPIN_CAP (1u << 18)
__device__ __forceinline__ unsigned xb_ld(unsigned* p)              { return __hip_atomic_load(p, __ATOMIC_RELAXED, __HIP_MEMORY_SCOPE_AGENT); }
__device__ __forceinline__ unsigned xb_add(unsigned* p, unsigned v) { return __hip_atomic_fetch_add(p, v, __ATOMIC_RELAXED, __HIP_MEMORY_SCOPE_AGENT); }
__device__ __forceinline__ unsigned xb_xcc_id() { return (unsigned)__builtin_amdgcn_s_getreg((3 << 11) | 20) & 0xFu; }
#define XB_SPIN(cond, bar) do { unsigned _sp = 0; while (cond) { __builtin_amdgcn_s_sleep(1); \
    if ((++_sp & 255u) == 0u) { if (xb_ld(&(bar)[XB_TMO])) break; if (_sp > XB_SPIN_CAP) { atomicAdd(&(bar)[XB_TMO], 1u); break; } } } } while (0)
struct XcdBarrier { unsigned* bar; unsigned x; volatile LAS unsigned* st; };
__device__ __forceinline__ XcdBarrier xcd_barrier_post(unsigned* bar, volatile LAS unsigned* st) {
    XcdBarrier b; b.bar = bar; b.x = xb_xcc_id(); b.st = st;
    if (threadIdx.x == 0) (void)xb_add(&bar[XB_XCNT(b.x)], 1u);
    return b;
}
__device__ __forceinline__ void xcd_barrier_complete(unsigned* bar, unsigned x, unsigned& nloc, unsigned& nx) {
    const unsigned G = gridDim.x * gridDim.y * gridDim.z;
    unsigned sum, cnt, mine, sp = 0u;
    for (;;) {
        sum = 0u; cnt = 0u; mine = 0u;
#pragma unroll
        for (unsigned j = 0; j < 16; ++j) { const unsigned c = xb_ld(&bar[XB_XCNT(j)]); sum += c; cnt += (c > 0u) ? 1u : 0u; mine = (j == x) ? c : mine; }
        if (sum == G) break;
        __builtin_amdgcn_s_sleep(1);
        if ((++sp & 255u) == 0u) { if (xb_ld(&bar[XB_TMO])) break; if (sp > XB_SPIN_CAP) { atomicAdd(&bar[XB_TMO], 1u); break; } }
    }
    nloc = mine > 0u ? mine : 1u; nx = cnt > 0u ? cnt : 1u;
}
__device__ __forceinline__ void xcd_barrier(const XcdBarrier& b) {
    asm volatile("s_waitcnt vmcnt(0)" ::: "memory");
    __syncthreads();
    if (threadIdx.x == 0) {
        unsigned* bar = b.bar;
        __builtin_amdgcn_s_waitcnt(0);
        unsigned nloc = b.st[0], nx = b.st[1];
        if (nloc == 0u) { xcd_barrier_complete(bar, b.x, nloc, nx); b.st[0] = nloc; b.st[1] = nx; }
        const unsigned old = xb_add(&bar[XB_XSUB(b.x)], 1u);
        const unsigned gen = old / nloc;
        if (old + 1u == (gen + 1u) * nloc) {
            __builtin_amdgcn_fence(__ATOMIC_RELEASE, "agent");
            asm volatile("s_waitcnt vmcnt(0)" ::: "memory");
            const unsigned og = xb_add(&bar[XB_TOP], 1u);
            const unsigned tg = og / nx;
            if (og + 1u == (tg + 1u) * nx) xb_add(&bar[XB_TOPGEN], 1u);
            else XB_SPIN(xb_ld(&bar[XB_TOPGEN]) == tg, bar);
            __builtin_amdgcn_fence(__ATOMIC_ACQUIRE, "agent");
            xb_add(&bar[XB_XGEN(b.x)], 1u);
            asm volatile("s_waitcnt vmcnt(0)" ::: "memory");
        } else {
            XB_SPIN(xb_ld(&bar[XB_XGEN(b.x)]) == gen, bar);
            __builtin_amdgcn_fence(__ATOMIC_ACQUIRE, "agent");
            asm volatile("s_waitcnt vmcnt(0)" ::: "memory");
        }
    }
    __syncthreads();
}

struct Args { const float* in[16]; float* out; unsigned char* ws; int ph_lo, ph_hi; };
struct Frame {
    LAS unsigned char* lds; volatile LAS unsigned* MISC; unsigned* ctl; unsigned char* ws;
    int tid, lane, wave, vcu, G, bx;
};

__device__ __forceinline__ void tr_item(const float* W, int ldw, int k0, int src_n0, bf16* WT, int ldt, int dst_r0, LAS float* scr, int lane) {
#pragma unroll 8
    for (int i = 0; i < 32; ++i) { const int kk = 2 * i + (lane >> 5); scr[kk * 33 + (lane & 31)] = W[(size_t)(k0 + kk) * ldw + src_n0 + (lane & 31)]; }
    LDS_WAIT(); asm volatile("" ::: "memory");
    const int c = lane & 7;
#pragma unroll
    for (int j = 0; j < 4; ++j) { const int n = (lane >> 3) + 8 * j; const LAS float* sp = scr + (8 * c) * 33 + n;
        u32x4 o; o.x = cvtpk(sp[0 * 33], sp[1 * 33]); o.y = cvtpk(sp[2 * 33], sp[3 * 33]); o.z = cvtpk(sp[4 * 33], sp[5 * 33]); o.w = cvtpk(sp[6 * 33], sp[7 * 33]);
        *(u32x4*)(WT + (size_t)(dst_r0 + n) * ldt + k0 + 8 * c) = o; }
    LDS_WAIT(); asm volatile("" ::: "memory");
}
__device__ __forceinline__ void p0_prologue(const Frame& F, const Args& a) {
    LAS float* scr = (LAS float*)(F.lds + F.wave * 16384);
    const int gw = F.vcu * 8 + F.wave, NGW = F.G * 8, lane = F.lane;
    bf16* win = (bf16*)(F.ws + WS_WIN); bf16* wbd = (bf16*)(F.ws + WS_WBD); bf16* wbs = (bf16*)(F.ws + WS_WBS); bf16* wout = (bf16*)(F.ws + WS_WOUT);
    bf16* wgu = (bf16*)(F.ws + WS_WGU); bf16* wd = (bf16*)(F.ws + WS_WD);
    constexpr int I_IN = 16 * 248, I_BD = 8 * 32, I_BS = 16 * 32, I_OUT = 16 * 32, I_G = 32 * 256, I_U = 32 * 256, I_D = 32 * 256;
    constexpr int NITEMS = I_IN + I_BD + I_BS + I_OUT + I_G + I_U + I_D;
    for (int it = gw; it < NITEMS; it += NGW) {
        int r = it;
        if (r < I_IN) { const int kb = r / 248, nb = r % 248, dr = 32 * nb; int src = dr;
            if (dr >= QKV_W) { const int o = dr - QKV_W, j = o >> 8, i = o & 255; src = (i < 128) ? QKV_W + 128 * j + i : QKV_W + 1024 + 128 * j + (i - 128); }
            tr_item(a.in[2], IN_W, 64 * kb, src, win, 1024, dr, scr, lane); continue; } r -= I_IN;
        if (r < I_BD) { tr_item(a.in[4], 1024, 64 * (r >> 5), 32 * (r & 31), wbd, 512, 32 * (r & 31), scr, lane); continue; } r -= I_BD;
        if (r < I_BS) { tr_item(a.in[5], 1024, 64 * (r >> 5), 32 * (r & 31), wbs, 1024, 32 * (r & 31), scr, lane); continue; } r -= I_BS;
        if (r < I_OUT) { tr_item(a.in[6], 1024, 64 * (r >> 5), 32 * (r & 31), wout, 1024, 32 * (r & 31), scr, lane); continue; } r -= I_OUT;
        if (r < I_G + I_U) { const int up = r >= I_G; if (up) r -= I_G; const int e = r >> 8, kb = (r >> 4) & 15, nb = r & 15;
            tr_item((up ? a.in[13] : a.in[12]) + (size_t)e * 1024 * 512, 512, 64 * kb, 32 * nb, wgu, 1024, e * 1024 + 256 * (nb >> 2) + 128 * up + 32 * (nb & 3), scr, lane); continue; } r -= I_G + I_U;
        { const int e = r >> 8, kb = (r >> 5) & 7, nb = r & 31;
            tr_item(a.in[14] + (size_t)e * 512 * 1024, 1024, 64 * kb, 32 * nb, wd, 512, e * 1024 + 32 * nb, scr, lane); }
    }
    { float* wrt = (float*)(F.ws + WS_WRT); const float* gf = a.in[7]; const float* wg = a.in[8]; const float* wr = a.in[10];
        for (int i = F.vcu * 512 + F.tid; i < 36 * 1024; i += F.G * 512) { const int e = i >> 10, k = i & 1023; wrt[i] = gf[k] * (e < 4 ? wg[k * 4 + e] : wr[k * 32 + e - 4]); } }
    { const float* x = a.in[0]; const float* gm = a.in[1]; bf16* H = (bf16*)(F.ws + WS_H);
        f32x4 gv[4];
#pragma unroll
        for (int j = 0; j < 4; ++j) gv[j] = *(const f32x4*)(gm + 4 * lane + 256 * j);
        for (int row = gw; row < NTOK; row += NGW) {
            const f32x4* xr = (const f32x4*)(x + (size_t)row * 1024) + lane; f32x4 v[4]; float ss = 0.f;
#pragma unroll
            for (int j = 0; j < 4; ++j) { v[j] = xr[64 * j]; ss += (v[j].x * v[j].x + v[j].y * v[j].y) + (v[j].z * v[j].z + v[j].w * v[j].w); }
            const float rstd = 1.f / sqrtf(wave_sum(ss) * (1.f / 1024.f) + RMS_EPS);
            u32x2* o = (u32x2*)(H + (size_t)row * 1024) + lane;
#pragma unroll
            for (int j = 0; j < 4; ++j) { const f32x4 t = v[j] * rstd * gv[j]; u32x2 p; p.x = cvtpk(t.x, t.y); p.y = cvtpk(t.z, t.w); o[64 * j] = p; }
        }
    }
}

__device__ __forceinline__ void attn_phase(const Frame& F, const float* sinks, int b) {
    const bf16* qkv = (const bf16*)(F.ws + WS_QKV);
    for (int ui = F.vcu; ui < 1024; ui += F.G) {
        att::UnitDesc U;
        if (ui < 256) {
            const int pair = ui & 3, blkq = (ui >> 2) & 31, kvh = ui >> 7, head0 = kvh * 8 + pair * 2;
            const bf16* rb = qkv + (size_t)(256 * blkq) * QKV_W;
            U.Q = rb + COL_QS + head0 * 64; U.K = rb + COL_KS + kvh * 64; U.V = rb + COL_VS + kvh * 64;
            U.O = (bf16*)(F.ws + WS_YSWA) + (size_t)b * T * 1024; U.lse = nullptr;
            U.has_prev = blkq != 0; U.nh = 2; U.W = 127; U.mixer = 1; U.head0 = head0; U.dil = 1;
            U.otok0 = 256 * blkq; U.otstride = 1; U.opitch = 1024; U.ocol0 = head0 * 64;
        } else {
            const int au = ui - 256, blkq = au & 31, head = au >> 5, sh = 2 * (head >> 3), L = T >> sh;
            const int prow = 256 * blkq, r = prow >> (13 - sh), u0 = prow & (L - 1);
            const bf16* rb = qkv + (size_t)prow * QKV_W;
            U.Q = rb + head * 64; U.K = rb + COL_KD + head * 64; U.V = rb + COL_VD + head * 64;
            U.O = (bf16*)(F.ws + WS_OA); U.lse = (float*)(F.ws + WS_LSE);
            U.has_prev = u0 != 0; U.nh = 1; U.W = 128; U.mixer = 0; U.head0 = head; U.dil = 1 << sh;
            U.otok0 = (u0 << sh) + r; U.otstride = 1 << sh; U.opitch = 1536; U.ocol0 = head * 64;
        }
        att::attn_unit(F.lds, F.tid, U, sinks);
    }
}
__device__ __forceinline__ void merge_phase(const Frame& F, int b) {
    const bf16* oa = (const bf16*)(F.ws + WS_OA); const float* lse = (const float*)(F.ws + WS_LSE); bf16* yd = (bf16*)(F.ws + WS_YDIL) + (size_t)b * T * 512;
    for (int it = F.vcu * 512 + F.tid; it < T * 64; it += F.G * 512) {
        const int dc = it & 7, hs = (it >> 3) & 7, t = it >> 6;
        const float l0 = lse[t * 24 + hs], l1 = lse[t * 24 + 8 + hs], l2 = lse[t * 24 + 16 + hs];
        const float mx = fmaxf(l0, fmaxf(l1, l2));
        float w0 = __expf(l0 - mx), w1 = __expf(l1 - mx), w2 = __expf(l2 - mx); const float inv = 1.f / (w0 + w1 + w2); w0 *= inv; w1 *= inv; w2 *= inv;
        f32x4 a0, b0, a1, b1, a2, b2;
        unpack8(*(const u32x4*)(oa + (size_t)t * 1536 + hs * 64 + dc * 8), a0, b0);
        unpack8(*(const u32x4*)(oa + (size_t)t * 1536 + 512 + hs * 64 + dc * 8), a1, b1);
        unpack8(*(const u32x4*)(oa + (size_t)t * 1536 + 1024 + hs * 64 + dc * 8), a2, b2);
        *(u32x4*)(yd + (size_t)t * 512 + hs * 64 + dc * 8) = pack8(a0 * w0 + a1 * w1 + a2 * w2, b0 * w0 + b1 * w1 + b2 * w2);
    }
}

__device__ __forceinline__ float dot4(const f32x4 a, const f32x4 b) { return (a.x * b.x + a.y * b.y) + (a.z * b.z + a.w * b.w); }
__device__ __forceinline__ void router_phase(const Frame& F, const float* x1, const float* gf, const float* bg, const float* br) {
    const int lane = F.lane, tid = F.tid;
    { const f32x4* src = (const f32x4*)(F.ws + WS_WRT); LAS f32x4* dst = (LAS f32x4*)F.lds;
        for (int i = tid; i < 36 * 256; i += 512) dst[i] = src[i]; }
    volatile LAS unsigned* cnt = (volatile LAS unsigned*)(F.lds + P5_CNT_OFF); volatile LAS unsigned* basew = (volatile LAS unsigned*)(F.lds + P5_BASE_OFF);
    volatile LAS unsigned* rec = (volatile LAS unsigned*)(F.lds + P5_REC_OFF);
    if (tid < 32) cnt[tid] = 0u;
    __syncthreads();
    const int RPW = NTOK / F.G, row0 = F.vcu * RPW;
    bf16* H2 = (bf16*)(F.ws + WS_H); float* rw = (float*)(F.ws + WS_RW);
    f32x4 gv[4];
#pragma unroll
    for (int j = 0; j < 4; ++j) gv[j] = *(const f32x4*)(gf + 4 * lane + 256 * j);
    const LAS f32x4* WL = (const LAS f32x4*)F.lds + lane;
    for (int lt = F.wave; lt < RPW; lt += 8) {
        const int row = row0 + lt;
        const f32x4* xr = (const f32x4*)(x1 + (size_t)row * 1024) + lane; f32x4 v[4]; float ss = 0.f;
#pragma unroll
        for (int j = 0; j < 4; ++j) { v[j] = xr[64 * j]; ss += dot4(v[j], v[j]); }
        const float rstd = 1.f / sqrtf(wave_sum(ss) * (1.f / 1024.f) + RMS_EPS);
        u32x2* o = (u32x2*)(H2 + (size_t)row * 1024) + lane;
#pragma unroll
        for (int j = 0; j < 4; ++j) { const f32x4 t = v[j] * rstd * gv[j]; u32x2 p; p.x = cvtpk(t.x, t.y); p.y = cvtpk(t.z, t.w); o[64 * j] = p; }
        float gl[4];
#pragma unroll
        for (int e = 0; e < 4; ++e) { float p = 0.f;
#pragma unroll
            for (int j = 0; j < 4; ++j) p += dot4(v[j], WL[e * 256 + 64 * j]);
            gl[e] = wave_sum(p) * rstd + bg[e]; }
        int gt = 0; float gm = gl[0];
#pragma unroll
        for (int e = 1; e < 4; ++e) if (gl[e] > gm) { gm = gl[e]; gt = e; }
        float gz = 0.f;
#pragma unroll
        for (int e = 0; e < 4; ++e) gz += __expf(gl[e] - gm);
        const float gwt = 1.f / gz;
        gt = __builtin_amdgcn_readfirstlane(gt);
        float el[8];
#pragma unroll
        for (int e = 0; e < 8; ++e) { float p = 0.f;
#pragma unroll
            for (int j = 0; j < 4; ++j) p += dot4(v[j], WL[(4 + 8 * gt + e) * 256 + 64 * j]);
            el[e] = wave_sum(p) * rstd + br[8 * gt + e]; }
        int i0 = 0; float m0 = el[0];
#pragma unroll
        for (int e = 1; e < 8; ++e) if (el[e] > m0) { m0 = el[e]; i0 = e; }
        int i1 = -1; float m1 = -INFINITY;
#pragma unroll
        for (int e = 0; e < 8; ++e) if (e != i0 && el[e] > m1) { m1 = el[e]; i1 = e; }
        if (i1 < 0) i1 = (i0 == 0) ? 1 : 0;
        const float ed = __expf(m1 - m0), w0 = 1.f / (1.f + ed), w1 = ed * w0;
        if (lane == 0) {
            const unsigned E0 = (unsigned)(8 * gt + i0), E1 = (unsigned)(8 * gt + i1);
            const unsigned r0 = __hip_atomic_fetch_add((LAS unsigned*)&cnt[E0], 1u, __ATOMIC_RELAXED, __HIP_MEMORY_SCOPE_WORKGROUP);
            const unsigned r1 = __hip_atomic_fetch_add((LAS unsigned*)&cnt[E1], 1u, __ATOMIC_RELAXED, __HIP_MEMORY_SCOPE_WORKGROUP);
            rec[lt] = E0 | (E1 << 5) | (r0 << 10) | (r1 << 20);
            rw[2 * row] = gwt * w0; rw[2 * row + 1] = gwt * w1;
        }
    }
    __syncthreads();
    if (tid < 32) basew[tid] = __hip_atomic_fetch_add(F.ctl + CW_CNT + 64 * tid, cnt[tid], RLX_AGENT);
    __syncthreads();
    unsigned* re = (unsigned*)(F.ws + WS_RE); unsigned* rrel = (unsigned*)(F.ws + WS_RREL);
    for (int lt = tid; lt < RPW; lt += 512) { const unsigned rc = rec[lt], E0 = rc & 31u, E1 = (rc >> 5) & 31u; const int row = row0 + lt;
        re[row] = E0 | (E1 << 8); rrel[2 * row] = basew[E0] + ((rc >> 10) & 1023u); rrel[2 * row + 1] = basew[E1] + ((rc >> 20) & 1023u); }
}
__device__ __forceinline__ void slots_phase(const Frame& F) {
    volatile LAS unsigned* cnt = (volatile LAS unsigned*)F.lds; volatile LAS unsigned* off = cnt + 32;
    if (F.tid < 32) cnt[F.tid] = ld_agent(F.ctl + CW_CNT + 64 * F.tid);
    __syncthreads();
    if (F.tid == 0) { unsigned o = 0; for (int e = 0; e < 32; ++e) { off[e] = o; o += (cnt[e] + 255u) & ~255u; } off[32] = o; }
    __syncthreads();
    const int RPW = NTOK / F.G, row0 = F.vcu * RPW;
    const unsigned* re = (const unsigned*)(F.ws + WS_RE); const unsigned* rrel = (const unsigned*)(F.ws + WS_RREL); const float* rw = (const float*)(F.ws + WS_RW);
    unsigned* tos = (unsigned*)(F.ws + WS_TOS); float* wos = (float*)(F.ws + WS_WOS); unsigned* sot = (unsigned*)(F.ws + WS_SOT); unsigned* pex = (unsigned*)(F.ws + WS_PEX);
    for (int lt = F.tid; lt < RPW; lt += 512) { const int row = row0 + lt; const unsigned ev = re[row], e0 = ev & 255u, e1 = ev >> 8;
        const unsigned s0 = off[e0] + rrel[2 * row], s1 = off[e1] + rrel[2 * row + 1];
        tos[s0] = (unsigned)row; tos[s1] = (unsigned)row; wos[s0] = rw[2 * row]; wos[s1] = rw[2 * row + 1]; sot[2 * row] = s0; sot[2 * row + 1] = s1; }
    for (int e = F.vcu; e < 32; e += F.G) { const unsigned c = cnt[e], pad = ((c + 255u) & ~255u) - c;
        for (unsigned i = F.tid; i < pad; i += 512) { tos[off[e] + c + i] = 0u; wos[off[e] + c + i] = 0.f; } }
    if (F.vcu == F.G - 1) { const unsigned np = off[32] >> 8;
        for (unsigned p = F.tid; p < np; p += 512) { unsigned e = 0; for (unsigned k = 0; k < 32; ++k) if (off[k] <= 256u * p && 256u * p < off[k + 1]) e = k; pex[p] = e; }
        if (F.tid == 0) pex[1023] = np; }
    __syncthreads();
}
__device__ __forceinline__ void final_phase(const Frame& F, float* out, const float* gfin) {
    const int lane = F.lane, gw = F.vcu * 8 + F.wave, NGW = F.G * 8;
    const unsigned* sot = (const unsigned*)(F.ws + WS_SOT); const bf16* ys = (const bf16*)(F.ws + WS_YS);
    f32x4 gv[4];
#pragma unroll
    for (int j = 0; j < 4; ++j) gv[j] = *(const f32x4*)(gfin + 4 * lane + 256 * j);
    for (int row = gw; row < NTOK; row += NGW) {
        const unsigned s0 = sot[2 * row], s1 = sot[2 * row + 1];
        f32x4* xr = (f32x4*)(out + (size_t)row * 1024) + lane; const u32x2* y0 = (const u32x2*)(ys + (size_t)s0 * 1024) + lane; const u32x2* y1 = (const u32x2*)(ys + (size_t)s1 * 1024) + lane;
        f32x4 v[4]; float ss = 0.f;
#pragma unroll
        for (int j = 0; j < 4; ++j) { const u32x2 p = y0[64 * j], q = y1[64 * j];
            v[j] = xr[64 * j] + (f32x4){bf_lo(p.x), bf_hi(p.x), bf_lo(p.y), bf_hi(p.y)} + (f32x4){bf_lo(q.x), bf_hi(q.x), bf_lo(q.y), bf_hi(q.y)}; ss += dot4(v[j], v[j]); }
        const float rstd = 1.f / sqrtf(wave_sum(ss) * (1.f / 1024.f) + RMS_EPS);
#pragma unroll
        for (int j = 0; j < 4; ++j) xr[64 * j] = v[j] * rstd * gv[j];
    }
}

constexpr int N_PHASES = 24;
constexpr int KA_OUT = 128, KA_WS = 136, KA_LO = 144, KA_HI = 148;
#if defined(__HIP_DEVICE_COMPILE__)
__device__ __forceinline__ unsigned long long karg64(int off) { auto k = __builtin_amdgcn_kernarg_segment_ptr(); unsigned long long v;
    asm volatile("s_load_dwordx2 %0, %1, %2\n\ts_waitcnt lgkmcnt(0)" : "=s"(v) : "s"(k), "i"(off)); return v; }
__device__ __forceinline__ int karg32(int off) { auto k = __builtin_amdgcn_kernarg_segment_ptr(); int v;
    asm volatile("s_load_dword %0, %1, %2\n\ts_waitcnt lgkmcnt(0)" : "=s"(v) : "s"(k), "i"(off)); return v; }
#else
__device__ __forceinline__ unsigned long long karg64(int) { return 0ull; }
__device__ __forceinline__ int karg32(int) { return 0; }
#endif
#define KIN(i) ((const float*)(const GAS float*)karg64(8 * (i)))
#define KPTR(T, off) ((T*)(GAS T*)karg64(off))
__device__ __forceinline__ Frame make_frame() {
    extern __shared__ __attribute__((aligned(16))) unsigned char lds_raw[];
    Frame F; int tid = threadIdx.x, bx = blockIdx.x, G = gridDim.x;
    asm volatile("" : "+v"(tid)); asm volatile("" : "+s"(bx), "+s"(G));
    F.lds = (LAS unsigned char*)lds_raw; F.MISC = (volatile LAS unsigned*)(F.lds + MISC_OFF);
    F.tid = tid; F.lane = tid & 63; F.wave = __builtin_amdgcn_readfirstlane(tid >> 6);
    F.G = G; F.bx = bx; F.vcu = (G % 8 == 0) ? (bx % 8) * (G / 8) + bx / 8 : bx;
    F.ws = KPTR(unsigned char, KA_WS); F.ctl = (unsigned*)(F.ws + WS_CTL);
    return F;
}
__global__ void __launch_bounds__(512, 2) mk_fwd(Args args_unused) {
    { Frame F = make_frame(); if (F.tid < 64) F.MISC[F.tid] = 0u; __syncthreads();
      if (MK_ONE_LAUNCH) (void)xcd_barrier_post(F.ctl + CW_BAR, F.MISC + 8); }
    const int lo = karg32(KA_LO), hi = karg32(KA_HI);
#define IN(k) (lo <= (k) && (k) < hi)
#define SEAM(k) do { if (IN(k) && IN((k) + 1)) { Frame Fb = make_frame(); XcdBarrier bar; bar.bar = Fb.ctl + CW_BAR; bar.x = xb_xcc_id(); bar.st = Fb.MISC + 8; xcd_barrier(bar); } } while (0)
    if (IN(0)) { Frame F = make_frame(); Args a{}; for (int i = 0; i < 16; ++i) a.in[i] = KIN(i); p0_prologue(F, a); } SEAM(0);
    for (int b = 0; b < NB; ++b) {
        if (IN(1 + 2 * b)) {
            Frame F = make_frame();
            if (b > 0) merge_phase(F, b - 1);
            pg8::Gemm g{(const bf16*)(F.ws + WS_H) + (size_t)b * T * 1024, (const bf16*)(F.ws + WS_WIN), T, IN_W, 1024}; pg8::StaticOrder S; S.init(T, IN_W, F.G, F.bx);
            Epi1 E{(bf16*)(F.ws + WS_QKV), (bf16*)(F.ws + WS_SGD), (bf16*)(F.ws + WS_SGS), b * T};
            pg8::gemm_phase<Epi1, pg8::StaticOrder, false>(F.lds, F.tid, g, S, E, nullptr);
        }
        SEAM(1 + 2 * b);
        if (IN(2 + 2 * b)) { Frame F = make_frame(); attn_phase(F, KIN(3), b); }
        SEAM(2 + 2 * b);
    }
    if (IN(17)) {
        Frame F = make_frame();
        merge_phase(F, NB - 1);
        { pg8::Gemm g{(const bf16*)(F.ws + WS_YSWA), (const bf16*)(F.ws + WS_WBS), NTOK, 1024, 1024}; pg8::StaticOrder S; S.init(NTOK, 1024, F.G, F.bx);
          EpiGate<false> E{(const bf16*)(F.ws + WS_SGS), (bf16*)(F.ws + WS_MIX)};
          pg8::gemm_phase<EpiGate<false>, pg8::StaticOrder, false>(F.lds, F.tid, g, S, E, nullptr); }
    }
    SEAM(17);
    if (IN(18)) {
        Frame F = make_frame();
        { pg8::Gemm g{(const bf16*)(F.ws + WS_YDIL), (const bf16*)(F.ws + WS_WBD), NTOK, 1024, 512}; pg8::StaticOrder S; S.init(NTOK, 1024, F.G, F.bx);
          EpiGate<true> E{(const bf16*)(F.ws + WS_SGD), (bf16*)(F.ws + WS_MIX)};
          pg8::gemm_phase<EpiGate<true>, pg8::StaticOrder, false>(F.lds, F.tid, g, S, E, nullptr); }
    }
    SEAM(18);
    if (IN(19)) {
        Frame F = make_frame();
        pg8::Gemm g{(const bf16*)(F.ws + WS_MIX), (const bf16*)(F.ws + WS_WOUT), NTOK, 1024, 1024}; pg8::StaticOrder S; S.init(NTOK, 1024, F.G, F.bx);
        EpiRes E{KIN(0), KPTR(float, KA_OUT)};
        pg8::gemm_phase<EpiRes, pg8::StaticOrder, false>(F.lds, F.tid, g, S, E, nullptr);
    }
    SEAM(19);
    if (IN(20)) { Frame F = make_frame(); router_phase(F, (const float*)KPTR(float, KA_OUT), KIN(7), KIN(9), KIN(11)); }
    SEAM(20);
    if (IN(21)) { Frame F = make_frame(); slots_phase(F); }
    SEAM(21);
    if (IN(22)) {
        Frame F = make_frame();
        pg8::Gemm g{(const bf16*)(F.ws + WS_H), (const bf16*)(F.ws + WS_WGU), SLOT_ROWS, 1024, 1024}; pg8::PanelOrder S; S.init((const unsigned*)(F.ws + WS_PEX), (volatile LAS int*)(F.lds + PANEL_TAB_OFF), F.G, F.vcu, F.tid);
        EpiGU E{(bf16*)(F.ws + WS_ACT)};
        pg8::gemm_phase<EpiGU, pg8::PanelOrder, true>(F.lds, F.tid, g, S, E, (const unsigned*)(F.ws + WS_TOS));
    }
    SEAM(22);
    if (IN(23)) {
        Frame F = make_frame();
        pg8::Gemm g{(const bf16*)(F.ws + WS_ACT), (const bf16*)(F.ws + WS_WD), SLOT_ROWS, 1024, 512}; pg8::PanelOrder S; S.init((const unsigned*)(F.ws + WS_PEX), (volatile LAS int*)(F.lds + PANEL_TAB_OFF), F.G, F.vcu, F.tid);
        EpiDown E{(bf16*)(F.ws + WS_YS), (const float*)(F.ws + WS_WOS)};
        pg8::gemm_phase<EpiDown, pg8::PanelOrder, false>(F.lds, F.tid, g, S, E, nullptr);
    }
    SEAM(23);
    if (IN(24)) { Frame F = make_frame(); final_phase(F, KPTR(float, KA_OUT), KIN(15)); }
#undef IN
#undef SEAM
}

extern "C" void kernel_launch(void* const* d_in, const int* in_sizes, int n_in, void* d_out, int out_size, void* d_ws, size_t ws_size, hipStream_t stream) {
    static int grid = 0;
    if (grid == 0) {
        if (n_in != 16 || in_sizes[0] != NTOK * D || out_size != NTOK * D || ws_size < WS_END) { fprintf(stderr, "kernel_launch: unexpected shapes / workspace (%d inputs, ws %zu)\n", n_in, ws_size); grid = -1; return; }
        int dev = 0, cus = 0;
        if (hipGetDevice(&dev) != hipSuccess || hipDeviceGetAttribute(&cus, hipDeviceAttributeMultiprocessorCount, dev) != hipSuccess) { grid = -1; return; }
        if (hipFuncSetAttribute((const void*)mk_fwd, hipFuncAttributeMaxDynamicSharedMemorySize, LDS_BYTES) != hipSuccess) { fprintf(stderr, "kernel_launch: hipFuncSetAttribute(%d) failed\n", LDS_BYTES); grid = -1; return; }
        int per_cu = 0;
        if (hipOccupancyMaxActiveBlocksPerMultiprocessor(&per_cu, (const void*)mk_fwd, 512, LDS_BYTES) != hipSuccess || per_cu < 1) { fprintf(stderr, "kernel_launch: occupancy query says %d\n", per_cu); }
        (void)hipGetLastError();
        int g = 64; while (g * 2 <= cus && g * 2 <= 1024) g *= 2;
        grid = g;
    }
    if (grid < 0) return;
    (void)hipMemsetAsync((char*)d_ws + WS_CTL, 0, CTL_ZERO_BYTES, stream);
    Args a{};
    for (int i = 0; i < 16; ++i) a.in[i] = (const float*)d_in[i];
    a.out = (float*)d_out; a.ws = (unsigned char*)d_ws;
#if MK_ONE_LAUNCH
    a.ph_lo = 0; a.ph_hi = N_PHASES + 1;
    hipLaunchKernelGGL(mk_fwd, dim3(grid), dim3(512), LDS_BYTES, stream, a);
#else
    for (int p = 0; p <= N_PHASES; ++p) { a.ph_lo = p; a.ph_hi = p + 1; hipLaunchKernelGGL(mk_fwd, dim3(grid), dim3(512), LDS_BYTES, stream, a); }
#endif
}
```

```cpp
#include <hip/hip_runtime.h>
#include <cstdio>
#include <cstdint>

#ifndef PROBE_DUP
#define PROBE_DUP 0
#endif
#ifndef MK_ONE_LAUNCH
#define MK_ONE_LAUNCH 1
#endif

#define LAS __attribute__((address_space(3)))
#define GAS __attribute__((address_space(1)))
typedef unsigned short bf16;
typedef short bf16x8 __attribute__((ext_vector_type(8)));
typedef short s16x4 __attribute__((ext_vector_type(4)));
typedef float f32x4 __attribute__((ext_vector_type(4)));
typedef float f32x16 __attribute__((ext_vector_type(16)));
typedef unsigned u32x4 __attribute__((ext_vector_type(4)));
typedef unsigned u32x2 __attribute__((ext_vector_type(2)));
typedef float f32x2_t __attribute__((ext_vector_type(2)));
typedef __bf16 bf16x2_t __attribute__((ext_vector_type(2)));
typedef GAS unsigned gu32;

constexpr int NB = 8, T = 8192, D = 1024, NTOK = NB * T;
constexpr int QKV_W = 5888;
constexpr int IN_W = 7936;
constexpr int COL_KD = 1536, COL_VD = 3072, COL_QS = 4608, COL_KS = 5632, COL_VS = 5760;
constexpr int NEXP = 32, DEXP = 512;
constexpr int SLOT_ROWS = 2 * NTOK + NEXP * 256;
constexpr int MAX_PANELS = SLOT_ROWS / 256;
constexpr float RMS_EPS = 1e-6f;
constexpr float LOG2E = 1.4426950408889634f, LN2 = 0.6931471805599453f;
constexpr float QSCALE = 0.125f * LOG2E;

constexpr size_t MiB = 1u << 20;
constexpr size_t WS_CTL = 0, CTL_ZERO_BYTES = 1 * MiB;
constexpr size_t WS_WIN = 1 * MiB;
constexpr size_t WS_WBR = 17 * MiB;
constexpr size_t WS_WOUT = 20 * MiB;
constexpr size_t WS_WGU = 22 * MiB;
constexpr size_t WS_WD = 86 * MiB;
constexpr size_t WS_WRT = 118 * MiB;
constexpr size_t WS_RE = 119 * MiB;
constexpr size_t WS_RREL = WS_RE + 256 * 1024;
constexpr size_t WS_RW = WS_RREL + 512 * 1024;
constexpr size_t WS_TOS = 121 * MiB;
constexpr size_t WS_WOS = 122 * MiB;
constexpr size_t WS_SOT = 123 * MiB;
constexpr size_t WS_PEX = 124 * MiB;
constexpr size_t WS_H = 128 * MiB;
constexpr size_t WS_QKV = 256 * MiB;
constexpr size_t WS_LSE = 992 * MiB;
constexpr size_t WS_ACT = 256 * MiB;
constexpr size_t WS_YS = 392 * MiB;
constexpr size_t WS_END = 1000 * MiB;
constexpr int COL_YDIL = 1536, COL_MIX = 0;
static_assert(WS_QKV + (size_t)NTOK * QKV_W * 2 <= WS_LSE && WS_LSE + (size_t)NTOK * 24 * 4 <= WS_END, "qkv/lse map");
static_assert(WS_ACT + (size_t)SLOT_ROWS * 512 * 2 <= WS_YS && WS_YS + (size_t)SLOT_ROWS * 1024 * 2 <= WS_LSE, "moe overlay");
constexpr int CW_BAR = 4096;
constexpr int CW_CNT = 8192;

constexpr int LDS_BYTES = 155648;
constexpr int MISC_OFF = LDS_BYTES - 256;
constexpr int PANEL_TAB_OFF = 131072 + 1024;
constexpr int P5_CNT_OFF = 147456, P5_BASE_OFF = P5_CNT_OFF + 128, P5_REC_OFF = P5_BASE_OFF + 128;

#define RLX_AGENT __ATOMIC_RELAXED, __HIP_MEMORY_SCOPE_AGENT
#define LDS_WAIT() asm volatile("s_waitcnt lgkmcnt(0)" ::: "memory")
__device__ __forceinline__ unsigned cvtpk(float lo, float hi) { f32x2_t v = {lo, hi}; bf16x2_t b = __builtin_convertvector(v, bf16x2_t); return __builtin_bit_cast(unsigned, b); }
__device__ __forceinline__ float bf_lo(unsigned u) { return __builtin_bit_cast(float, u << 16); }
__device__ __forceinline__ float bf_hi(unsigned u) { return __builtin_bit_cast(float, u & 0xffff0000u); }
__device__ __forceinline__ unsigned ld_agent(const unsigned* p) { return __hip_atomic_load(p, RLX_AGENT); }
__device__ __forceinline__ float wave_sum(float v) {
#pragma unroll
    for (int o = 1; o < 64; o <<= 1) v += __shfl_xor(v, o);
    return v;
}

namespace pg8 {
constexpr int BM = 256, BK = 64, HALF = 128, HTB = HALF * BK * 2, STAGE_BYTES = 8 * HTB, NXCD = 8, WGM = 8;
__host__ __device__ __forceinline__ int lds_byte(int r, int c) { const int st = (r >> 4) * 2 + (c >> 5), rr = r & 15, cc = c & 31, ob = rr * 64 + cc * 2; return st * 1024 + (ob ^ (((ob >> 9) & 1) << 5)); }
__host__ __device__ __forceinline__ void stage_rc(int b, int& R, int& C) { const int st = b / 1024, sb = b % 1024, swz = sb ^ (((sb >> 9) & 1) << 5); R = (st >> 1) * 16 + swz / 64; C = (st & 1) * 32 + (swz % 64) / 2; }
__host__ __device__ __forceinline__ int perm32(int rho) { const int n = rho >> 4, i = rho & 15; return 8 * (i >> 2) + 4 * n + (i & 3); }

struct Unit { int pm, pn, part; };
struct Gemm { const bf16* A0; const bf16* A1; const bf16* B0; const bf16* B1; int lda, ldb, nt0, nt1; };

template <bool CHAIN> struct StaticOrder {
    int nM, nN, nwg, G, c;
    __device__ void init(int M, int N, int G_, int c_) { nM = M / BM; nN = N / BM; nwg = nM * nN; G = G_; c = c_; }
    __device__ bool next(int i, Unit& u) const {
        const int it = CHAIN ? (i >> 1) : i; u.part = CHAIN ? (i & 1) : 0;
        const long L = (long)it * G + c; if (L >= nwg) return false;
        int wgid = (int)L; { const int q = nwg / NXCD, r = nwg % NXCD, xcd = wgid % NXCD, off = wgid / NXCD; wgid = (xcd < r ? xcd * (q + 1) : r * (q + 1) + (xcd - r) * q) + off; }
        const int nig = WGM * nN, gid = wgid / nig, fm = gid * WGM, gsz = (nM - fm) < WGM ? (nM - fm) : WGM;
        u.pm = fm + ((wgid % nig) % gsz); u.pn = (wgid % nig) / gsz; return true;
    }
};
struct PanelOrder {
    volatile LAS int* tab; int np4, G, c;
    __device__ void init(const unsigned* pex, volatile LAS int* tab_, int G_, int vcu, int tid) {
        tab = tab_; G = G_; c = vcu; np4 = 4 * __builtin_amdgcn_readfirstlane((int)ld_agent(pex + 1023));
        if (tid < 64) { const int L = tid * G_ + vcu; tab_[tid] = (L < np4) ? (int)ld_agent(pex + (L >> 2)) : 0; }
        __syncthreads();
    }
    __device__ bool next(int i, Unit& u) const {
        const int L = i * G + c; if (L >= np4 || i >= 64) return false;
        u.pm = L >> 2; u.pn = 4 * __builtin_amdgcn_readfirstlane(tab[i]) + (L & 3); u.part = 0; return true;
    }
};

template <class Epi, class Sched, bool GATHER>
__device__ __forceinline__ void gemm_phase(LAS unsigned char* lds, const int tid, const Gemm g, const Sched& S, const Epi& E, const unsigned* rowidx) {
    const int wid = __builtin_amdgcn_readfirstlane(tid >> 6), lane = tid & 63, wr = wid >> 2, wc = wid & 3, fr = lane & 15, fq = lane >> 4;
    int Rr[2], Cc[2]; unsigned voffB[2];
#pragma unroll
    for (int i = 0; i < 2; ++i) { stage_rc(tid * 16 + i * 8192, Rr[i], Cc[i]); const int Rb = (Rr[i] & ~31) + perm32(Rr[i] & 31); voffB[i] = (unsigned)(Rb * g.ldb + Cc[i] * 2); }
    const size_t kstep = (size_t)(BK * 2);
    const size_t hstep = (size_t)HALF * g.ldb;
    const size_t tstepA = (size_t)BM * g.lda, tstepB = (size_t)BM * g.ldb;
    const unsigned ldsw = (unsigned)wid * 1024u;
    const int aoff = lds_byte(wr * 64 + fr, fq * 8), boff = lds_byte(wc * 32 + fr, fq * 8);
    unsigned vc[2][2], vn[2][2];
#define PG8_SA(b, h) (((b) * 2 + (h)) * HTB)
#define PG8_SB(b, h) ((4 + (b) * 2 + (h)) * HTB)
#define PG8_STAGE(bufoff, gbase, voff) do { _Pragma("unroll") for (int _i = 0; _i < 2; ++_i) \
        __builtin_amdgcn_global_load_lds((const unsigned*)((const char*)(gbase) + (voff)[_i]), (LAS unsigned*)(lds + (bufoff) + ldsw + _i * 8192), 16, 0, 0); } while (0)
#define PG8_LDA(dst, b, h) do { _Pragma("unroll") for (int m = 0; m < 4; ++m) _Pragma("unroll") for (int k = 0; k < 2; ++k) dst[m][k] = *(const LAS bf16x8*)(lds + PG8_SA(b, h) + aoff + m * 2048 + k * 1024); } while (0)
#define PG8_LDB(dst, b, h) do { _Pragma("unroll") for (int n = 0; n < 2; ++n) _Pragma("unroll") for (int k = 0; k < 2; ++k) dst[n][k] = *(const LAS bf16x8*)(lds + PG8_SB(b, h) + boff + n * 2048 + k * 1024); } while (0)
#define PG8_MMA(ai, bj, At, Bt) do { __builtin_amdgcn_s_setprio(1); _Pragma("unroll") for (int m = 0; m < 4; ++m) _Pragma("unroll") for (int n = 0; n < 2; ++n) _Pragma("unroll") for (int k = 0; k < 2; ++k) \
        acc[ai][bj][m][n] = __builtin_amdgcn_mfma_f32_16x16x32_bf16(Bt[n][k], At[m][k], acc[ai][bj][m][n], 0, 0, 0); __builtin_amdgcn_s_setprio(0); } while (0)
#define PG8_WAIT_V(n) asm volatile("s_waitcnt vmcnt(" #n ")" ::: "memory")
#define PG8_WAIT_L(n) asm volatile("s_waitcnt lgkmcnt(" #n ")" ::: "memory")
#define PG8_BAR __builtin_amdgcn_s_barrier()
#define PG8_SCHED __builtin_amdgcn_sched_barrier(0)
#define PG8_VOFFS(v, u) do { _Pragma("unroll") for (int _h = 0; _h < 2; ++_h) _Pragma("unroll") for (int _i = 0; _i < 2; ++_i) { \
        if (GATHER) { const unsigned _t = rowidx[(u).pm * BM + _h * HALF + Rr[_i]]; v[_h][_i] = _t * (unsigned)g.lda + (unsigned)(Cc[_i] * 2); } \
        else v[_h][_i] = (unsigned)((_h * HALF + Rr[_i]) * g.lda + Cc[_i] * 2); } } while (0)
#define PG8_ZERO() do { _Pragma("unroll") for (int a = 0; a < 2; ++a) _Pragma("unroll") for (int b = 0; b < 2; ++b) _Pragma("unroll") for (int m = 0; m < 4; ++m) _Pragma("unroll") for (int n = 0; n < 2; ++n) acc[a][b][m][n] = (f32x4){0.f, 0.f, 0.f, 0.f}; } while (0)
    Unit cur, nxt; int ui = 0;
    if (!S.next(0, cur)) return;
    f32x4 acc[2][2][4][2];
    PG8_ZERO();
    bf16x8 At[4][2], B0[2][2], B1[2][2];
    PG8_VOFFS(vc, cur);
    const char* cA = GATHER ? (const char*)g.A0 : (const char*)(cur.part ? g.A1 : g.A0) + (size_t)cur.pm * tstepA; const char* cB = (const char*)(cur.part ? g.B1 : g.B0) + (size_t)cur.pn * tstepB;
    int nt = cur.part ? g.nt1 : g.nt0;
    PG8_STAGE(PG8_SB(0, 0), cB, voffB); PG8_STAGE(PG8_SB(0, 1), cB + hstep, voffB); PG8_STAGE(PG8_SA(0, 0), cA, vc[0]); PG8_STAGE(PG8_SA(0, 1), cA, vc[1]);
    if (wr == 1) PG8_BAR;
    PG8_WAIT_V(2); PG8_BAR;
    PG8_STAGE(PG8_SB(1, 0), cB + kstep, voffB); PG8_STAGE(PG8_SA(1, 0), cA + kstep, vc[0]); PG8_STAGE(PG8_SB(1, 1), cB + hstep + kstep, voffB);
    PG8_WAIT_V(6); PG8_BAR;
    for (;;) {
        const bool has_next = S.next(ui + 1, nxt);
        const char* nA = GATHER ? (const char*)g.A0 : (has_next ? (const char*)(nxt.part ? g.A1 : g.A0) + (size_t)nxt.pm * tstepA : cA);
        const char* nB = has_next ? (const char*)(nxt.part ? g.B1 : g.B0) + (size_t)nxt.pn * tstepB : cB;
        if constexpr (GATHER) {
            if (has_next) { PG8_VOFFS(vn, nxt); } else {
#pragma unroll
                for (int h = 0; h < 2; ++h)
#pragma unroll
                    for (int i = 0; i < 2; ++i) vn[h][i] = vc[h][i]; }
        }
        for (int t = 0; t < nt; t += 2) {
            const bool last = (t == nt - 2);
            const char* a1 = cA + (size_t)(t + 1) * kstep;
            const char* a2 = last ? nA : cA + (size_t)(t + 2) * kstep; const char* b2 = last ? nB : cB + (size_t)(t + 2) * kstep;
            const char* a3 = a2 + kstep; const char* b3 = b2 + kstep;
            unsigned v2[2][2];
#pragma unroll
            for (int h = 0; h < 2; ++h)
#pragma unroll
                for (int i = 0; i < 2; ++i) { if constexpr (GATHER) v2[h][i] = last ? vn[h][i] : vc[h][i]; else v2[h][i] = vc[h][i]; }
            PG8_LDB(B0, 0, 0); PG8_LDB(B1, 0, 1); PG8_SCHED; PG8_LDA(At, 0, 0); PG8_STAGE(PG8_SA(1, 1), a1, vc[1]);
            PG8_WAIT_V(8); PG8_WAIT_L(0); PG8_BAR; PG8_MMA(0, 0, At, B0); PG8_MMA(0, 1, At, B1); PG8_BAR; PG8_SCHED;
            PG8_LDA(At, 0, 1); PG8_STAGE(PG8_SB(0, 0), b2, voffB); PG8_STAGE(PG8_SB(0, 1), b2 + hstep, voffB); PG8_STAGE(PG8_SA(0, 0), a2, v2[0]);
            PG8_WAIT_V(8); PG8_WAIT_L(0); PG8_BAR; PG8_MMA(1, 0, At, B0); PG8_MMA(1, 1, At, B1); PG8_BAR; PG8_SCHED;
            PG8_LDB(B0, 1, 0); PG8_LDB(B1, 1, 1); PG8_SCHED; PG8_LDA(At, 1, 0); PG8_STAGE(PG8_SA(0, 1), a2, v2[1]);
            PG8_WAIT_V(8); PG8_WAIT_L(0); PG8_BAR; PG8_MMA(0, 0, At, B0); PG8_MMA(0, 1, At, B1); PG8_BAR; PG8_SCHED;
            PG8_LDA(At, 1, 1); PG8_STAGE(PG8_SB(1, 0), b3, voffB); PG8_STAGE(PG8_SB(1, 1), b3 + hstep, voffB); PG8_STAGE(PG8_SA(1, 0), a3, v2[0]);
            PG8_WAIT_V(8); PG8_WAIT_L(0); PG8_BAR; PG8_MMA(1, 0, At, B0); PG8_MMA(1, 1, At, B1); PG8_BAR; PG8_SCHED;
        }
        if (wr == 0) PG8_BAR;
        bool mid = false;
        if constexpr (Epi::CHAINED) mid = (cur.part == 0);
        if (mid) { if constexpr (Epi::CHAINED) E.mid(acc, cur, wr, wc, fr, fq); } else E(acc, cur, wr, wc, fr, fq);
        if (!has_next) break;
        if (!mid) PG8_ZERO();
        cur = nxt; cA = nA; cB = nB; nt = cur.part ? g.nt1 : g.nt0; ++ui;
        if constexpr (GATHER) {
#pragma unroll
            for (int h = 0; h < 2; ++h)
#pragma unroll
                for (int i = 0; i < 2; ++i) vc[h][i] = vn[h][i];
        }
        if (wr == 1) PG8_BAR;
    }
    PG8_WAIT_V(0);
    PG8_BAR;
#undef PG8_SA
#undef PG8_SB
#undef PG8_STAGE
#undef PG8_LDA
#undef PG8_LDB
#undef PG8_MMA
#undef PG8_WAIT_V
#undef PG8_WAIT_L
#undef PG8_BAR
#undef PG8_SCHED
#undef PG8_VOFFS
#undef PG8_ZERO
}
}

__device__ __forceinline__ float sigmoidf_fast(float a) { return __builtin_amdgcn_rcpf(1.f + __builtin_amdgcn_exp2f(-a * LOG2E)); }
__device__ __forceinline__ u32x4 pack8(const f32x4 a, const f32x4 b) { u32x4 w; w.x = cvtpk(a[0], a[1]); w.y = cvtpk(a[2], a[3]); w.z = cvtpk(b[0], b[1]); w.w = cvtpk(b[2], b[3]); return w; }
__device__ __forceinline__ void unpack8(const u32x4 w, f32x4& a, f32x4& b) { a = (f32x4){bf_lo(w.x), bf_hi(w.x), bf_lo(w.y), bf_hi(w.y)}; b = (f32x4){bf_lo(w.z), bf_hi(w.z), bf_lo(w.w), bf_hi(w.w)}; }
typedef const f32x4 (&AccRef)[2][2][4][2];
typedef f32x4 (&AccMut)[2][2][4][2];

struct Epi1 {
    static constexpr bool CHAINED = false;
    bf16* qkv; bf16* sgd; bf16* sgs;
    __device__ __forceinline__ void operator()(AccRef acc, const pg8::Unit& u, int wr, int wc, int fr, int fq) const {
        const int pn = u.pn;
        if (pn < 23) {
            int sh = 0; float sc = 1.f;
            if (pn < 18) { sh = 2 * ((pn % 6) >> 1); if (pn < 6) sc = QSCALE; } else if (pn < 22) sc = QSCALE;
            const int col0 = pn * 256 + wc * 32 + fq * 8;
#pragma unroll
            for (int ai = 0; ai < 2; ++ai)
#pragma unroll
                for (int m = 0; m < 4; ++m) {
                    const int row = u.pm * 256 + ai * 128 + wr * 64 + m * 16 + fr, t = row & (T - 1);
                    const int rowp = (row & ~(T - 1)) | ((t & ((1 << sh) - 1)) << (13 - sh)) | (t >> sh);
                    bf16* rp = qkv + (size_t)rowp * QKV_W + col0;
#pragma unroll
                    for (int bj = 0; bj < 2; ++bj) *(u32x4*)(rp + bj * 128) = pack8(acc[ai][bj][m][0] * sc, acc[ai][bj][m][1] * sc);
                }
        } else {
            const int col0 = (pn - 23) * 128 + wc * 32 + fq * 8;
#pragma unroll
            for (int ai = 0; ai < 2; ++ai)
#pragma unroll
                for (int m = 0; m < 4; ++m) {
                    const size_t off = (size_t)(u.pm * 256 + ai * 128 + wr * 64 + m * 16 + fr) * 1024 + col0;
#pragma unroll
                    for (int bj = 0; bj < 2; ++bj) { f32x4 a = acc[ai][bj][m][0], b = acc[ai][bj][m][1];
#pragma unroll
                        for (int i = 0; i < 4; ++i) { a[i] = sigmoidf_fast(a[i]); b[i] = sigmoidf_fast(b[i]); }
                        *(u32x4*)((bj ? sgs : sgd) + off) = pack8(a, b); }
                }
        }
    }
};
struct EpiMix {
    static constexpr bool CHAINED = true;
    const bf16* sgd; const bf16* sgs; bf16* mix;
    __device__ __forceinline__ void mid(AccMut acc, const pg8::Unit& u, int wr, int wc, int fr, int fq) const {
#pragma unroll
        for (int ai = 0; ai < 2; ++ai)
#pragma unroll
            for (int m = 0; m < 4; ++m) {
                const size_t off = (size_t)(u.pm * 256 + ai * 128 + wr * 64 + m * 16 + fr) * 1024 + u.pn * 256 + wc * 32 + fq * 8;
#pragma unroll
                for (int bj = 0; bj < 2; ++bj) { f32x4 da, db, sa, sb; unpack8(*(const u32x4*)(sgd + off + bj * 128), da, db); unpack8(*(const u32x4*)(sgs + off + bj * 128), sa, sb);
#pragma unroll
                    for (int i = 0; i < 4; ++i) { acc[ai][bj][m][0][i] *= sa[i] * __builtin_amdgcn_rcpf(fmaxf(da[i], 1e-20f)); acc[ai][bj][m][1][i] *= sb[i] * __builtin_amdgcn_rcpf(fmaxf(db[i], 1e-20f)); } }
            }
    }
    __device__ __forceinline__ void operator()(AccRef acc, const pg8::Unit& u, int wr, int wc, int fr, int fq) const {
#pragma unroll
        for (int ai = 0; ai < 2; ++ai)
#pragma unroll
            for (int m = 0; m < 4; ++m) {
                const size_t row = (size_t)(u.pm * 256 + ai * 128 + wr * 64 + m * 16 + fr); const int col = u.pn * 256 + wc * 32 + fq * 8;
#pragma unroll
                for (int bj = 0; bj < 2; ++bj) { f32x4 da, db; unpack8(*(const u32x4*)(sgd + row * 1024 + col + bj * 128), da, db);
#pragma unroll
                    for (int i = 0; i < 4; ++i) { da[i] = fmaxf(da[i], 1e-20f); db[i] = fmaxf(db[i], 1e-20f); }
                    *(u32x4*)(mix + row * QKV_W + col + bj * 128) = pack8(da * acc[ai][bj][m][0], db * acc[ai][bj][m][1]); }
            }
    }
};
struct EpiRes {
    static constexpr bool CHAINED = false;
    const float* x; float* out;
    __device__ __forceinline__ void operator()(AccRef acc, const pg8::Unit& u, int wr, int wc, int fr, int fq) const {
#pragma unroll
        for (int ai = 0; ai < 2; ++ai)
#pragma unroll
            for (int m = 0; m < 4; ++m) {
                const size_t off = (size_t)(u.pm * 256 + ai * 128 + wr * 64 + m * 16 + fr) * 1024 + u.pn * 256 + wc * 32 + fq * 8;
#pragma unroll
                for (int bj = 0; bj < 2; ++bj)
#pragma unroll
                    for (int n = 0; n < 2; ++n) *(f32x4*)(out + off + bj * 128 + n * 4) = *(const f32x4*)(x + off + bj * 128 + n * 4) + acc[ai][bj][m][n];
            }
    }
};
struct EpiGU {
    static constexpr bool CHAINED = false;
    bf16* act;
    __device__ __forceinline__ void operator()(AccRef acc, const pg8::Unit& u, int wr, int wc, int fr, int fq) const {
        const int col0 = (u.pn & 3) * 128 + wc * 32 + fq * 8;
#pragma unroll
        for (int ai = 0; ai < 2; ++ai)
#pragma unroll
            for (int m = 0; m < 4; ++m) {
                const size_t off = (size_t)(u.pm * 256 + ai * 128 + wr * 64 + m * 16 + fr) * DEXP + col0;
                f32x4 o[2];
#pragma unroll
                for (int n = 0; n < 2; ++n)
#pragma unroll
                    for (int i = 0; i < 4; ++i) { const float gt = acc[ai][0][m][n][i]; o[n][i] = gt * sigmoidf_fast(gt) * acc[ai][1][m][n][i]; }
                *(u32x4*)(act + off) = pack8(o[0], o[1]);
            }
    }
};
struct EpiDown {
    static constexpr bool CHAINED = false;
    bf16* ys; const float* wos;
    __device__ __forceinline__ void operator()(AccRef acc, const pg8::Unit& u, int wr, int wc, int fr, int fq) const {
#pragma unroll
        for (int ai = 0; ai < 2; ++ai)
#pragma unroll
            for (int m = 0; m < 4; ++m) {
                const int row = u.pm * 256 + ai * 128 + wr * 64 + m * 16 + fr; const float wv = wos[row];
                const size_t off = (size_t)row * 1024 + (u.pn & 3) * 256 + wc * 32 + fq * 8;
#pragma unroll
                for (int bj = 0; bj < 2; ++bj) *(u32x4*)(ys + off + bj * 128) = pack8(acc[ai][bj][m][0] * wv, acc[ai][bj][m][1] * wv);
            }
    }
};

namespace att {
constexpr int KPITCH = 144, VPITCH = 128, KROWS = 384, LDS_K = 0, LDS_V = KROWS * KPITCH;
static_assert(LDS_V + KROWS * VPITCH <= 131072, "attention LDS");
#define MFMA32(a, b, c) __builtin_amdgcn_mfma_f32_32x32x16_bf16((a), (b), (c), 0, 0, 0)
typedef short v4i16_t __attribute__((ext_vector_type(4)));
__device__ __forceinline__ s16x4 vtr(const LAS unsigned char* p) { return __builtin_bit_cast(s16x4, __builtin_amdgcn_ds_read_tr16_b64_v4i16((LAS v4i16_t*)p)); }

struct UnitDesc {
    const bf16* Q; const bf16* K; const bf16* V;
    float* lse;
    int has_prev, nh, W, mixer, head0, dil;
    int ltok0, lstride;
};
__device__ __forceinline__ void attn_unit(LAS unsigned char* lds, const int tid, const UnitDesc& U, const float* sinks) {
    const int w = __builtin_amdgcn_readfirstlane(tid >> 6), lane = tid & 63, ql = lane & 31, h = lane >> 5;
#pragma unroll
    for (int i = 0; i < 6; ++i) {
        const int cid = tid + 512 * i, row = cid >> 3, ch = cid & 7;
        if (U.has_prev || row >= 128) {
            const u32x4 kv = *(const u32x4*)(U.K + (ptrdiff_t)(row - 128) * QKV_W + ch * 8);
            const u32x4 vv = *(const u32x4*)(U.V + (ptrdiff_t)(row - 128) * QKV_W + ch * 8);
            *(LAS u32x4*)(lds + LDS_K + row * KPITCH + ch * 16) = kv;
            *(LAS u32x4*)(lds + LDS_V + row * VPITCH + ((ch ^ (((row >> 1) & 1) << 2)) * 16)) = vv;
        }
    }
    __syncthreads();
    const int cstart = U.has_prev ? 0 : (w < 4 ? 4 - w : 0);
    const int i16 = lane & 15, q4 = i16 >> 2, p4 = i16 & 3, blk = (lane >> 4) & 1, swz = (q4 >> 1) & 1;
    for (int hh = 0; hh < U.nh; ++hh) {
        const int head = U.head0 + hh;
        const float slope = U.mixer ? __builtin_amdgcn_exp2f(-0.5f * (float)(head + 1)) : __builtin_amdgcn_exp2f((float)(head + 1) * (-8.f / 24.f));
        const float c2 = slope * (float)U.dil * LOG2E;
        const float sink2 = U.mixer ? sinks[head] * LOG2E : -INFINITY;
        const bf16* qrow = U.Q + (size_t)(32 * w + ql) * QKV_W + hh * 64 + 8 * h;
        bf16x8 qf[4];
#pragma unroll
        for (int kk = 0; kk < 4; ++kk) qf[kk] = *(const bf16x8*)(qrow + 16 * kk);
        f32x16 S[5];
        const float tl = -c2 * (float)(128 + ql - 4 * h);
#pragma unroll
        for (int c = 0; c < 5; ++c) {
            if (c >= cstart) {
                const float tc = tl + c2 * (32.f * (float)c);
#pragma unroll
                for (int r = 0; r < 16; ++r) S[c][r] = tc + c2 * (float)((r & 3) + 8 * (r >> 2));
                const LAS unsigned char* kp = lds + LDS_K + (32 * w + 32 * c + ql) * KPITCH + h * 16;
#pragma unroll
                for (int kk = 0; kk < 4; ++kk) { const bf16x8 kf = *(const LAS bf16x8*)(kp + kk * 32); S[c] = MFMA32(kf, qf[kk], S[c]); }
            } else {
#pragma unroll
                for (int r = 0; r < 16; ++r) S[c][r] = -INFINITY;
            }
        }
        const int d0 = 128 - U.W;
#pragma unroll
        for (int r = 0; r < 16; ++r) { const int kl = (r & 3) + 8 * (r >> 2) + 4 * h; if (kl < ql + d0) S[0][r] = -INFINITY; if (kl > ql) S[4][r] = -INFINITY; }
        float m = sink2;
#pragma unroll
        for (int c = 0; c < 5; ++c)
#pragma unroll
            for (int r = 0; r < 16; ++r) m = fmaxf(m, S[c][r]);
        m = fmaxf(m, __shfl_xor(m, 32));
        float l = 0.f;
#pragma unroll
        for (int c = 0; c < 5; ++c)
#pragma unroll
            for (int r = 0; r < 16; ++r) { const float p = __builtin_amdgcn_exp2f(S[c][r] - m); S[c][r] = p; l += p; }
        l += __shfl_xor(l, 32);
        l += __builtin_amdgcn_exp2f(sink2 - m);
        f32x16 O[2];
#pragma unroll
        for (int r = 0; r < 16; ++r) { O[0][r] = 0.f; O[1][r] = 0.f; }
#pragma unroll
        for (int c = 0; c < 5; ++c) {
            if (c >= cstart) {
#pragma unroll
                for (int s = 0; s < 2; ++s) {
                    u32x4 pw; pw.x = cvtpk(S[c][8 * s], S[c][8 * s + 1]); pw.y = cvtpk(S[c][8 * s + 2], S[c][8 * s + 3]); pw.z = cvtpk(S[c][8 * s + 4], S[c][8 * s + 5]); pw.w = cvtpk(S[c][8 * s + 6], S[c][8 * s + 7]);
                    const bf16x8 pf = __builtin_bit_cast(bf16x8, pw);
                    const int row0 = 32 * w + 32 * c + 16 * s + 4 * h + q4;
#pragma unroll
                    for (int dt = 0; dt < 2; ++dt) {
                        const LAS unsigned char* vp = lds + LDS_V + row0 * VPITCH + (4 * (dt ^ swz) + 2 * blk + (p4 >> 1)) * 16 + 8 * (p4 & 1);
                        const s16x4 lo = vtr(vp), hi = vtr(vp + 8 * VPITCH);
                        const bf16x8 vf = __builtin_shufflevector(lo, hi, 0, 1, 2, 3, 4, 5, 6, 7);
                        O[dt] = MFMA32(vf, pf, O[dt]);
                    }
                }
            }
        }
        const float inv = 1.f / l;
        const int qi = 32 * w + ql;
        bf16* op = const_cast<bf16*>(U.Q) + (size_t)qi * QKV_W + hh * 64 + 4 * h;
#pragma unroll
        for (int dt = 0; dt < 2; ++dt)
#pragma unroll
            for (int g4 = 0; g4 < 4; ++g4) { u32x2 o2; o2.x = cvtpk(O[dt][4 * g4] * inv, O[dt][4 * g4 + 1] * inv); o2.y = cvtpk(O[dt][4 * g4 + 2] * inv, O[dt][4 * g4 + 3] * inv);
                *(u32x2*)(op + 32 * dt + 8 * g4) = o2; }
        if (U.lse && h == 0) U.lse[(size_t)(U.ltok0 + qi * U.lstride) * 24 + head] = (m + __builtin_amdgcn_logf(l)) * LN2;
    }
    __syncthreads();
}
#undef MFMA32
}

#define XB_TMO      128
#define XB_XCNT(j)  (256  + 64 * (j))
#define XB_XSUB(j)  (1280 + 64 * (j))
#define XB_XGEN(j)  (2304 + 64 * (j))
#define XB_TOP      3328
#define XB_TOPGEN   3392
#define XCD_BAR_WORDS 3456
#define XB_SPIN_CAP (1u << 18)
__device__ __forceinline__ unsigned xb_ld(unsigned* p)              { return __hip_atomic_load(p, __ATOMIC_RELAXED, __HIP_MEMORY_SCOPE_AGENT); }
__device__ __forceinline__ unsigned xb_add(unsigned* p, unsigned v) { return __hip_atomic_fetch_add(p, v, __ATOMIC_RELAXED, __HIP_MEMORY_SCOPE_AGENT); }
__device__ __forceinline__ unsigned xb_xcc_id() { return (unsigned)__builtin_amdgcn_s_getreg((3 << 11) | 20) & 0xFu; }
#define XB_SPIN(cond, bar) do { unsigned _sp = 0; while (cond) { __builtin_amdgcn_s_sleep(1); \
    if ((++_sp & 255u) == 0u) { if (xb_ld(&(bar)[XB_TMO])) break; if (_sp > XB_SPIN_CAP) { atomicAdd(&(bar)[XB_TMO], 1u); break; } } } } while (0)
struct XcdBarrier { unsigned* bar; unsigned x; volatile LAS unsigned* st; };
__device__ __forceinline__ XcdBarrier xcd_barrier_post(unsigned* bar, volatile LAS unsigned* st) {
    XcdBarrier b; b.bar = bar; b.x = xb_xcc_id(); b.st = st;
    if (threadIdx.x == 0) (void)xb_add(&bar[XB_XCNT(b.x)], 1u);
    return b;
}
__device__ __forceinline__ void xcd_barrier_complete(unsigned* bar, unsigned x, unsigned& nloc, unsigned& nx) {
    const unsigned G = gridDim.x * gridDim.y * gridDim.z;
    unsigned sum, cnt, mine, sp = 0u;
    for (;;) {
        sum = 0u; cnt = 0u; mine = 0u;
#pragma unroll
        for (unsigned j = 0; j < 16; ++j) { const unsigned c = xb_ld(&bar[XB_XCNT(j)]); sum += c; cnt += (c > 0u) ? 1u : 0u; mine = (j == x) ? c : mine; }
        if (sum == G) break;
        __builtin_amdgcn_s_sleep(1);
        if ((++sp & 255u) == 0u) { if (xb_ld(&bar[XB_TMO])) break; if (sp > XB_SPIN_CAP) { atomicAdd(&bar[XB_TMO], 1u); break; } }
    }
    nloc = mine > 0u ? mine : 1u; nx = cnt > 0u ? cnt : 1u;
}
__device__ __forceinline__ void xcd_barrier(const XcdBarrier& b) {
    asm volatile("s_waitcnt vmcnt(0)" ::: "memory");
    __syncthreads();
    if (threadIdx.x == 0) {
        unsigned* bar = b.bar;
        __builtin_amdgcn_s_waitcnt(0);
        unsigned nloc = b.st[0], nx = b.st[1];
        if (nloc == 0u) { xcd_barrier_complete(bar, b.x, nloc, nx); b.st[0] = nloc; b.st[1] = nx; }
        const unsigned old = xb_add(&bar[XB_XSUB(b.x)], 1u);
        const unsigned gen = old / nloc;
        if (old + 1u == (gen + 1u) * nloc) {
            __builtin_amdgcn_fence(__ATOMIC_RELEASE, "agent");
            asm volatile("s_waitcnt vmcnt(0)" ::: "memory");
            const unsigned og = xb_add(&bar[XB_TOP], 1u);
            const unsigned tg = og / nx;
            if (og + 1u == (tg + 1u) * nx) xb_add(&bar[XB_TOPGEN], 1u);
            else XB_SPIN(xb_ld(&bar[XB_TOPGEN]) == tg, bar);
            __builtin_amdgcn_fence(__ATOMIC_ACQUIRE, "agent");
            xb_add(&bar[XB_XGEN(b.x)], 1u);
            asm volatile("s_waitcnt vmcnt(0)" ::: "memory");
        } else {
            XB_SPIN(xb_ld(&bar[XB_XGEN(b.x)]) == gen, bar);
            __builtin_amdgcn_fence(__ATOMIC_ACQUIRE, "agent");
            asm volatile("s_waitcnt vmcnt(0)" ::: "memory");
        }
    }
    __syncthreads();
}

struct Args { const float* in[16]; float* out; unsigned char* ws; int ph_lo, ph_hi; };
struct Frame {
    LAS unsigned char* lds; volatile LAS unsigned* MISC; unsigned* ctl; unsigned char* ws;
    int tid, lane, wave, vcu, G, bx;
};

__device__ __forceinline__ void tr_item(const float* W, int ldw, int k0, int src_n0, bf16* WT, int ldt, int dst_r0, LAS float* scr, int lane) {
#pragma unroll 8
    for (int i = 0; i < 32; ++i) { const int kk = 2 * i + (lane >> 5); scr[kk * 33 + (lane & 31)] = W[(size_t)(k0 + kk) * ldw + src_n0 + (lane & 31)]; }
    LDS_WAIT(); asm volatile("" ::: "memory");
    const int c = lane & 7;
#pragma unroll
    for (int j = 0; j < 4; ++j) { const int n = (lane >> 3) + 8 * j; const LAS float* sp = scr + (8 * c) * 33 + n;
        u32x4 o; o.x = cvtpk(sp[0 * 33], sp[1 * 33]); o.y = cvtpk(sp[2 * 33], sp[3 * 33]); o.z = cvtpk(sp[4 * 33], sp[5 * 33]); o.w = cvtpk(sp[6 * 33], sp[7 * 33]);
        *(u32x4*)(WT + (size_t)(dst_r0 + n) * ldt + k0 + 8 * c) = o; }
    LDS_WAIT(); asm volatile("" ::: "memory");
}
__device__ __forceinline__ void p0_prologue(const Frame& F, const Args& a) {
    LAS float* scr = (LAS float*)(F.lds + F.wave * 16384);
    const int gw = F.vcu * 8 + F.wave, NGW = F.G * 8, lane = F.lane;
    bf16* win = (bf16*)(F.ws + WS_WIN); bf16* wbr = (bf16*)(F.ws + WS_WBR); bf16* wout = (bf16*)(F.ws + WS_WOUT);
    bf16* wgu = (bf16*)(F.ws + WS_WGU); bf16* wd = (bf16*)(F.ws + WS_WD);
    constexpr int I_IN = 16 * 248, I_BD = 8 * 32, I_BS = 16 * 32, I_OUT = 16 * 32, I_G = 32 * 256, I_U = 32 * 256, I_D = 32 * 256;
    constexpr int NITEMS = I_IN + I_BD + I_BS + I_OUT + I_G + I_U + I_D;
    for (int it = gw; it < NITEMS; it += NGW) {
        int r = it;
        if (r < I_IN) { const int kb = r / 248, nb = r % 248, dr = 32 * nb; int src = dr;
            if (dr >= QKV_W) { const int o = dr - QKV_W, j = o >> 8, i = o & 255; src = (i < 128) ? QKV_W + 128 * j + i : QKV_W + 1024 + 128 * j + (i - 128); }
            tr_item(a.in[2], IN_W, 64 * kb, src, win, 1024, dr, scr, lane); continue; } r -= I_IN;
        if (r < I_BD) { tr_item(a.in[4], 1024, 64 * (r >> 5), 32 * (r & 31), wbr + 1024, 1536, 32 * (r & 31), scr, lane); continue; } r -= I_BD;
        if (r < I_BS) { tr_item(a.in[5], 1024, 64 * (r >> 5), 32 * (r & 31), wbr, 1536, 32 * (r & 31), scr, lane); continue; } r -= I_BS;
        if (r < I_OUT) { tr_item(a.in[6], 1024, 64 * (r >> 5), 32 * (r & 31), wout, 1024, 32 * (r & 31), scr, lane); continue; } r -= I_OUT;
        if (r < I_G + I_U) { const int up = r >= I_G; if (up) r -= I_G; const int e = r >> 8, kb = (r >> 4) & 15, nb = r & 15;
            tr_item((up ? a.in[13] : a.in[12]) + (size_t)e * 1024 * 512, 512, 64 * kb, 32 * nb, wgu, 1024, e * 1024 + 256 * (nb >> 2) + 128 * up + 32 * (nb & 3), scr, lane); continue; } r -= I_G + I_U;
        { const int e = r >> 8, kb = (r >> 5) & 7, nb = r & 31;
            tr_item(a.in[14] + (size_t)e * 512 * 1024, 1024, 64 * kb, 32 * nb, wd, 512, e * 1024 + 32 * nb, scr, lane); }
    }
    { float* wrt = (float*)(F.ws + WS_WRT); const float* gf = a.in[7]; const float* wg = a.in[8]; const float* wr = a.in[10];
        for (int i = F.vcu * 512 + F.tid; i < 36 * 1024; i += F.G * 512) { const int e = i >> 10, k = i & 1023; wrt[i] = gf[k] * (e < 4 ? wg[k * 4 + e] : wr[k * 32 + e - 4]); } }
    { const float* x = a.in[0]; const float* gm = a.in[1]; bf16* H = (bf16*)(F.ws + WS_H);
        f32x4 gv[4];
#pragma unroll
        for (int j = 0; j < 4; ++j) gv[j] = *(const f32x4*)(gm + 4 * lane + 256 * j);
        for (int row = gw; row < NTOK; row += NGW) {
            const f32x4* xr = (const f32x4*)(x + (size_t)row * 1024) + lane; f32x4 v[4]; float ss = 0.f;
#pragma unroll
            for (int j = 0; j < 4; ++j) { v[j] = xr[64 * j]; ss += (v[j].x * v[j].x + v[j].y * v[j].y) + (v[j].z * v[j].z + v[j].w * v[j].w); }
            const float rstd = 1.f / sqrtf(wave_sum(ss) * (1.f / 1024.f) + RMS_EPS);
            u32x2* o = (u32x2*)(H + (size_t)row * 1024) + lane;
#pragma unroll
            for (int j = 0; j < 4; ++j) { const f32x4 t = v[j] * rstd * gv[j]; u32x2 p; p.x = cvtpk(t.x, t.y); p.y = cvtpk(t.z, t.w); o[64 * j] = p; }
        }
    }
}

__device__ __forceinline__ void attn_phase(const Frame& F, const float* sinks) {
    const bf16* qkv = (const bf16*)(F.ws + WS_QKV);
    for (int gi = F.vcu; gi < NB * 1024; gi += F.G) {
        const int b = gi >> 10, ui = gi & 1023;
        att::UnitDesc U;
        if (ui < 256) {
            const int pair = ui & 3, blkq = (ui >> 2) & 31, kvh = ui >> 7, head0 = kvh * 8 + pair * 2;
            const bf16* rb = qkv + (size_t)(b * T + 256 * blkq) * QKV_W;
            U.Q = rb + COL_QS + head0 * 64; U.K = rb + COL_KS + kvh * 64; U.V = rb + COL_VS + kvh * 64; U.lse = nullptr;
            U.has_prev = blkq != 0; U.nh = 2; U.W = 127; U.mixer = 1; U.head0 = head0; U.dil = 1; U.ltok0 = 0; U.lstride = 0;
        } else {
            const int au = ui - 256, blkq = au & 31, head = au >> 5, sh = 2 * (head >> 3), L = T >> sh;
            const int prow = 256 * blkq, r = prow >> (13 - sh), u0 = prow & (L - 1);
            const bf16* rb = qkv + (size_t)(b * T + prow) * QKV_W;
            U.Q = rb + head * 64; U.K = rb + COL_KD + head * 64; U.V = rb + COL_VD + head * 64; U.lse = (float*)(F.ws + WS_LSE);
            U.has_prev = u0 != 0; U.nh = 1; U.W = 128; U.mixer = 0; U.head0 = head; U.dil = 1 << sh;
            U.ltok0 = b * T + (u0 << sh) + r; U.lstride = 1 << sh;
        }
        att::attn_unit(F.lds, F.tid, U, sinks);
    }
}
__device__ __forceinline__ void merge_phase(const Frame& F) {
    bf16* qkv = (bf16*)(F.ws + WS_QKV); const float* lse = (const float*)(F.ws + WS_LSE);
    for (int it = F.vcu * 512 + F.tid; it < NTOK * 64; it += F.G * 512) {
        const int dc = it & 7, hs = (it >> 3) & 7, t = it >> 6, tb = t & ~(T - 1), tl = t & (T - 1);
        const float l0 = lse[(size_t)t * 24 + hs], l1 = lse[(size_t)t * 24 + 8 + hs], l2 = lse[(size_t)t * 24 + 16 + hs];
        const float mx = fmaxf(l0, fmaxf(l1, l2));
        float w0 = __expf(l0 - mx), w1 = __expf(l1 - mx), w2 = __expf(l2 - mx); const float inv = 1.f / (w0 + w1 + w2); w0 *= inv; w1 *= inv; w2 *= inv;
        const int r1 = tb | ((tl & 3) << 11) | (tl >> 2), r2 = tb | ((tl & 15) << 9) | (tl >> 4);
        f32x4 a0, b0, a1, b1, a2, b2;
        unpack8(*(const u32x4*)(qkv + (size_t)t * QKV_W + hs * 64 + dc * 8), a0, b0);
        unpack8(*(const u32x4*)(qkv + (size_t)r1 * QKV_W + 512 + hs * 64 + dc * 8), a1, b1);
        unpack8(*(const u32x4*)(qkv + (size_t)r2 * QKV_W + 1024 + hs * 64 + dc * 8), a2, b2);
        *(u32x4*)(qkv + (size_t)t * QKV_W + COL_YDIL + hs * 64 + dc * 8) = pack8(a0 * w0 + a1 * w1 + a2 * w2, b0 * w0 + b1 * w1 + b2 * w2);
    }
}
__device__ __forceinline__ float dot4(const f32x4 a, const f32x4 b) { return (a.x * b.x + a.y * b.y) + (a.z * b.z + a.w * b.w); }
__device__ __forceinline__ void router_phase(const Frame& F, const float* x1, const float* gf, const float* bg, const float* br) {
    const int lane = F.lane, tid = F.tid;
    { const f32x4* src = (const f32x4*)(F.ws + WS_WRT); LAS f32x4* dst = (LAS f32x4*)F.lds;
        for (int i = tid; i < 36 * 256; i += 512) dst[i] = src[i]; }
    volatile LAS unsigned* cnt = (volatile LAS unsigned*)(F.lds + P5_CNT_OFF); volatile LAS unsigned* basew = (volatile LAS unsigned*)(F.lds + P5_BASE_OFF);
    volatile LAS unsigned* rec = (volatile LAS unsigned*)(F.lds + P5_REC_OFF);
    if (tid < 32) cnt[tid] = 0u;
    __syncthreads();
    const int RPW = NTOK / F.G, row0 = F.vcu * RPW;
    bf16* H2 = (bf16*)(F.ws + WS_H); float* rw = (float*)(F.ws + WS_RW);
    f32x4 gv[4];
#pragma unroll
    for (int j = 0; j < 4; ++j) gv[j] = *(const f32x4*)(gf + 4 * lane + 256 * j);
    const LAS f32x4* WL = (const LAS f32x4*)F.lds + lane;
    for (int lt = F.wave; lt < RPW; lt += 8) {
        const int row = row0 + lt;
        const f32x4* xr = (const f32x4*)(x1 + (size_t)row * 1024) + lane; f32x4 v[4]; float ss = 0.f;
#pragma unroll
        for (int j = 0; j < 4; ++j) { v[j] = xr[64 * j]; ss += dot4(v[j], v[j]); }
        const float rstd = 1.f / sqrtf(wave_sum(ss) * (1.f / 1024.f) + RMS_EPS);
        u32x2* o = (u32x2*)(H2 + (size_t)row * 1024) + lane;
#pragma unroll
        for (int j = 0; j < 4; ++j) { const f32x4 t = v[j] * rstd * gv[j]; u32x2 p; p.x = cvtpk(t.x, t.y); p.y = cvtpk(t.z, t.w); o[64 * j] = p; }
        float gl[4];
#pragma unroll
        for (int e = 0; e < 4; ++e) { float p = 0.f;
#pragma unroll
            for (int j = 0; j < 4; ++j) p += dot4(v[j], WL[e * 256 + 64 * j]);
            gl[e] = wave_sum(p) * rstd + bg[e]; }
        int gt = 0; float gm = gl[0];
#pragma unroll
        for (int e = 1; e < 4; ++e) if (gl[e] > gm) { gm = gl[e]; gt = e; }
        float gz = 0.f;
#pragma unroll
        for (int e = 0; e < 4; ++e) gz += __expf(gl[e] - gm);
        const float gwt = 1.f / gz;
        gt = __builtin_amdgcn_readfirstlane(gt);
        float el[8];
#pragma unroll
        for (int e = 0; e < 8; ++e) { float p = 0.f;
#pragma unroll
            for (int j = 0; j < 4; ++j) p += dot4(v[j], WL[(4 + 8 * gt + e) * 256 + 64 * j]);
            el[e] = wave_sum(p) * rstd + br[8 * gt + e]; }
        int i0 = 0; float m0 = el[0];
#pragma unroll
        for (int e = 1; e < 8; ++e) if (el[e] > m0) { m0 = el[e]; i0 = e; }
        int i1 = -1; float m1 = -INFINITY;
#pragma unroll
        for (int e = 0; e < 8; ++e) if (e != i0 && el[e] > m1) { m1 = el[e]; i1 = e; }
        if (i1 < 0) i1 = (i0 == 0) ? 1 : 0;
        const float ed = __expf(m1 - m0), w0 = 1.f / (1.f + ed), w1 = ed * w0;
        if (lane == 0) {
            const unsigned E0 = (unsigned)(8 * gt + i0), E1 = (unsigned)(8 * gt + i1);
            const unsigned r0 = __hip_atomic_fetch_add((LAS unsigned*)&cnt[E0], 1u, __ATOMIC_RELAXED, __HIP_MEMORY_SCOPE_WORKGROUP);
            const unsigned r1 = __hip_atomic_fetch_add((LAS unsigned*)&cnt[E1], 1u, __ATOMIC_RELAXED, __HIP_MEMORY_SCOPE_WORKGROUP);
            rec[lt] = E0 | (E1 << 5) | (r0 << 10) | (r1 << 20);
            rw[2 * row] = gwt * w0; rw[2 * row + 1] = gwt * w1;
        }
    }
    __syncthreads();
    if (tid < 32) basew[tid] = __hip_atomic_fetch_add(F.ctl + CW_CNT + 64 * tid, cnt[tid], RLX_AGENT);
    __syncthreads();
    unsigned* re = (unsigned*)(F.ws + WS_RE); unsigned* rrel = (unsigned*)(F.ws + WS_RREL);
    for (int lt = tid; lt < RPW; lt += 512) { const unsigned rc = rec[lt], E0 = rc & 31u, E1 = (rc >> 5) & 31u; const int row = row0 + lt;
        re[row] = E0 | (E1 << 8); rrel[2 * row] = basew[E0] + ((rc >> 10) & 1023u); rrel[2 * row + 1] = basew[E1] + ((rc >> 20) & 1023u); }
}
__device__ __forceinline__ void slots_phase(const Frame& F) {
    volatile LAS unsigned* cnt = (volatile LAS unsigned*)F.lds; volatile LAS unsigned* off = cnt + 32;
    if (F.tid < 32) cnt[F.tid] = ld_agent(F.ctl + CW_CNT + 64 * F.tid);
    __syncthreads();
    if (F.tid == 0) { unsigned o = 0; for (int e = 0; e < 32; ++e) { off[e] = o; o += (cnt[e] + 255u) & ~255u; } off[32] = o; }
    __syncthreads();
    const int RPW = NTOK / F.G, row0 = F.vcu * RPW;
    const unsigned* re = (const unsigned*)(F.ws + WS_RE); const unsigned* rrel = (const unsigned*)(F.ws + WS_RREL); const float* rw = (const float*)(F.ws + WS_RW);
    unsigned* tos = (unsigned*)(F.ws + WS_TOS); float* wos = (float*)(F.ws + WS_WOS); unsigned* sot = (unsigned*)(F.ws + WS_SOT); unsigned* pex = (unsigned*)(F.ws + WS_PEX);
    for (int lt = F.tid; lt < RPW; lt += 512) { const int row = row0 + lt; const unsigned ev = re[row], e0 = ev & 255u, e1 = ev >> 8;
        const unsigned s0 = off[e0] + rrel[2 * row], s1 = off[e1] + rrel[2 * row + 1];
        tos[s0] = (unsigned)row; tos[s1] = (unsigned)row; wos[s0] = rw[2 * row]; wos[s1] = rw[2 * row + 1]; sot[2 * row] = s0; sot[2 * row + 1] = s1; }
    for (int e = F.vcu; e < 32; e += F.G) { const unsigned c = cnt[e], pad = ((c + 255u) & ~255u) - c;
        for (unsigned i = F.tid; i < pad; i += 512) { tos[off[e] + c + i] = 0u; wos[off[e] + c + i] = 0.f; } }
    if (F.vcu == F.G - 1) { const unsigned np = off[32] >> 8;
        for (unsigned p = F.tid; p < np; p += 512) { unsigned e = 0; for (unsigned k = 0; k < 32; ++k) if (off[k] <= 256u * p && 256u * p < off[k + 1]) e = k; pex[p] = e; }
        if (F.tid == 0) pex[1023] = np; }
    __syncthreads();
}
__device__ __forceinline__ void final_phase(const Frame& F, float* out, const float* gfin) {
    const int lane = F.lane, gw = F.vcu * 8 + F.wave, NGW = F.G * 8;
    const unsigned* sot = (const unsigned*)(F.ws + WS_SOT); const bf16* ys = (const bf16*)(F.ws + WS_YS);
    f32x4 gv[4];
#pragma unroll
    for (int j = 0; j < 4; ++j) gv[j] = *(const f32x4*)(gfin + 4 * lane + 256 * j);
    for (int row = gw; row < NTOK; row += NGW) {
        const unsigned s0 = sot[2 * row], s1 = sot[2 * row + 1];
        f32x4* xr = (f32x4*)(out + (size_t)row * 1024) + lane; const u32x2* y0 = (const u32x2*)(ys + (size_t)s0 * 1024) + lane; const u32x2* y1 = (const u32x2*)(ys + (size_t)s1 * 1024) + lane;
        f32x4 v[4]; float ss = 0.f;
#pragma unroll
        for (int j = 0; j < 4; ++j) { const u32x2 p = y0[64 * j], q = y1[64 * j];
            v[j] = xr[64 * j] + (f32x4){bf_lo(p.x), bf_hi(p.x), bf_lo(p.y), bf_hi(p.y)} + (f32x4){bf_lo(q.x), bf_hi(q.x), bf_lo(q.y), bf_hi(q.y)}; ss += dot4(v[j], v[j]); }
        const float rstd = 1.f / sqrtf(wave_sum(ss) * (1.f / 1024.f) + RMS_EPS);
#pragma unroll
        for (int j = 0; j < 4; ++j) xr[64 * j] = v[j] * rstd * gv[j];
    }
}

constexpr int N_PHASES = 10;
constexpr int KA_OUT = 128, KA_WS = 136, KA_LO = 144, KA_HI = 148;
#if defined(__HIP_DEVICE_COMPILE__)
__device__ __forceinline__ unsigned long long karg64(int off) { auto k = __builtin_amdgcn_kernarg_segment_ptr(); unsigned long long v;
    asm volatile("s_load_dwordx2 %0, %1, %2\n\ts_waitcnt lgkmcnt(0)" : "=s"(v) : "s"(k), "i"(off)); return v; }
__device__ __forceinline__ int karg32(int off) { auto k = __builtin_amdgcn_kernarg_segment_ptr(); int v;
    asm volatile("s_load_dword %0, %1, %2\n\ts_waitcnt lgkmcnt(0)" : "=s"(v) : "s"(k), "i"(off)); return v; }
#else
__device__ __forceinline__ unsigned long long karg64(int) { return 0ull; }
__device__ __forceinline__ int karg32(int) { return 0; }
#endif
#define KIN(i) ((const float*)(const GAS float*)karg64(8 * (i)))
#define KPTR(T, off) ((T*)(GAS T*)karg64(off))
__device__ __forceinline__ Frame make_frame() {
    extern __shared__ __attribute__((aligned(16))) unsigned char lds_raw[];
    Frame F; int tid = threadIdx.x, bx = blockIdx.x, G = gridDim.x;
    asm volatile("" : "+v"(tid)); asm volatile("" : "+s"(bx), "+s"(G));
    F.lds = (LAS unsigned char*)lds_raw; F.MISC = (volatile LAS unsigned*)(F.lds + MISC_OFF);
    F.tid = tid; F.lane = tid & 63; F.wave = __builtin_amdgcn_readfirstlane(tid >> 6);
    F.G = G; F.bx = bx; F.vcu = (G % 8 == 0) ? (bx % 8) * (G / 8) + bx / 8 : bx;
    F.ws = KPTR(unsigned char, KA_WS); F.ctl = (unsigned*)(F.ws + WS_CTL);
    return F;
}
__global__ void __launch_bounds__(512, 2) mk_fwd(Args args_unused) {
    { Frame F = make_frame(); if (F.tid < 64) F.MISC[F.tid] = 0u; __syncthreads();
      if (MK_ONE_LAUNCH) (void)xcd_barrier_post(F.ctl + CW_BAR, F.MISC + 8); }
    const int lo = karg32(KA_LO), hi = karg32(KA_HI);
#define IN(k) (lo <= (k) && (k) < hi)
#define SEAM(k) do { if (IN(k) && IN((k) + 1)) { Frame Fb = make_frame(); XcdBarrier bar; bar.bar = Fb.ctl + CW_BAR; bar.x = xb_xcc_id(); bar.st = Fb.MISC + 8; xcd_barrier(bar); } } while (0)
#define GBAR() do { Frame Fb = make_frame(); XcdBarrier bar; bar.bar = Fb.ctl + CW_BAR; bar.x = xb_xcc_id(); bar.st = Fb.MISC + 8; xcd_barrier(bar); } while (0)
#define REP(k) for (int rep_ = 0; rep_ < (PROBE_DUP == (k) ? 2 : 1); ++rep_)
#define REPBAR(k) do { if (PROBE_DUP == (k) && rep_ == 0) GBAR(); } while (0)
    if (IN(0)) REP(7) { Frame F = make_frame(); Args a{}; for (int i = 0; i < 16; ++i) a.in[i] = KIN(i); p0_prologue(F, a); REPBAR(7); } SEAM(0);
    if (IN(1)) REP(1) {
        Frame F = make_frame(); bf16* gates = (bf16*)KPTR(float, KA_OUT);
        pg8::Gemm g{(const bf16*)(F.ws + WS_H), nullptr, (const bf16*)(F.ws + WS_WIN), nullptr, 2048, 2048, 16, 16}; pg8::StaticOrder<false> S; S.init(NTOK, IN_W, F.G, F.bx);
        Epi1 E{(bf16*)(F.ws + WS_QKV), gates, gates + (size_t)NTOK * 1024};
        pg8::gemm_phase<Epi1, pg8::StaticOrder<false>, false>(F.lds, F.tid, g, S, E, nullptr);
        REPBAR(1);
    }
    SEAM(1);
    if (IN(2)) REP(2) { Frame F = make_frame(); attn_phase(F, KIN(3)); REPBAR(2); }
    SEAM(2);
    if (IN(3)) REP(8) { Frame F = make_frame(); merge_phase(F); REPBAR(8); }
    SEAM(3);
    if (IN(4)) REP(3) {
        Frame F = make_frame(); const bf16* gates = (const bf16*)KPTR(float, KA_OUT); const bf16* qkv = (const bf16*)(F.ws + WS_QKV); const bf16* wbr = (const bf16*)(F.ws + WS_WBR);
        pg8::Gemm g{qkv + COL_QS, qkv + COL_YDIL, wbr, wbr + 1024, QKV_W * 2, 1536 * 2, 16, 8}; pg8::StaticOrder<true> S; S.init(NTOK, 1024, F.G, F.bx);
        EpiMix E{gates, gates + (size_t)NTOK * 1024, (bf16*)(F.ws + WS_QKV) + COL_MIX};
        pg8::gemm_phase<EpiMix, pg8::StaticOrder<true>, false>(F.lds, F.tid, g, S, E, nullptr);
        REPBAR(3);
    }
    SEAM(4);
    if (IN(5)) REP(4) {
        Frame F = make_frame();
        pg8::Gemm g{(const bf16*)(F.ws + WS_QKV) + COL_MIX, nullptr, (const bf16*)(F.ws + WS_WOUT), nullptr, QKV_W * 2, 2048, 16, 16}; pg8::StaticOrder<false> S; S.init(NTOK, 1024, F.G, F.bx);
        EpiRes E{KIN(0), KPTR(float, KA_OUT)};
        pg8::gemm_phase<EpiRes, pg8::StaticOrder<false>, false>(F.lds, F.tid, g, S, E, nullptr);
        REPBAR(4);
    }
    SEAM(5);
    if (IN(6)) { Frame F = make_frame(); router_phase(F, (const float*)KPTR(float, KA_OUT), KIN(7), KIN(9), KIN(11)); }
    SEAM(6);
    if (IN(7)) { Frame F = make_frame(); slots_phase(F); }
    SEAM(7);
    if (IN(8)) REP(5) {
        Frame F = make_frame();
        pg8::Gemm g{(const bf16*)(F.ws + WS_H), nullptr, (const bf16*)(F.ws + WS_WGU), nullptr, 2048, 2048, 16, 16}; pg8::PanelOrder S; S.init((const unsigned*)(F.ws + WS_PEX), (volatile LAS int*)(F.lds + PANEL_TAB_OFF), F.G, F.vcu, F.tid);
        EpiGU E{(bf16*)(F.ws + WS_ACT)};
        pg8::gemm_phase<EpiGU, pg8::PanelOrder, true>(F.lds, F.tid, g, S, E, (const unsigned*)(F.ws + WS_TOS));
        REPBAR(5);
    }
    SEAM(8);
    if (IN(9)) REP(6) {
        Frame F = make_frame();
        pg8::Gemm g{(const bf16*)(F.ws + WS_ACT), nullptr, (const bf16*)(F.ws + WS_WD), nullptr, 1024, 1024, 8, 8}; pg8::PanelOrder S; S.init((const unsigned*)(F.ws + WS_PEX), (volatile LAS int*)(F.lds + PANEL_TAB_OFF), F.G, F.vcu, F.tid);
        EpiDown E{(bf16*)(F.ws + WS_YS), (const float*)(F.ws + WS_WOS)};
        pg8::gemm_phase<EpiDown, pg8::PanelOrder, false>(F.lds, F.tid, g, S, E, nullptr);
        REPBAR(6);
    }
    SEAM(9);
    if (IN(10)) { Frame F = make_frame(); final_phase(F, KPTR(float, KA_OUT), KIN(15)); }
#undef IN
#undef SEAM
}

extern "C" void kernel_launch(void* const* d_in, const int* in_sizes, int n_in, void* d_out, int out_size, void* d_ws, size_t ws_size, hipStream_t stream) {
    static int grid = 0;
    if (grid == 0) {
        if (n_in != 16 || in_sizes[0] != NTOK * D || out_size != NTOK * D || ws_size < WS_END) { fprintf(stderr, "kernel_launch: unexpected shapes / workspace (%d inputs, ws %zu)\n", n_in, ws_size); grid = -1; return; }
        int dev = 0, cus = 0;
        if (hipGetDevice(&dev) != hipSuccess || hipDeviceGetAttribute(&cus, hipDeviceAttributeMultiprocessorCount, dev) != hipSuccess) { grid = -1; return; }
        if (hipFuncSetAttribute((const void*)mk_fwd, hipFuncAttributeMaxDynamicSharedMemorySize, LDS_BYTES) != hipSuccess) { fprintf(stderr, "kernel_launch: hipFuncSetAttribute(%d) failed\n", LDS_BYTES); grid = -1; return; }
        int per_cu = 0;
        if (hipOccupancyMaxActiveBlocksPerMultiprocessor(&per_cu, (const void*)mk_fwd, 512, LDS_BYTES) != hipSuccess || per_cu < 1) { fprintf(stderr, "kernel_launch: occupancy query says %d\n", per_cu); }
        (void)hipGetLastError();
        int g = 64; while (g * 2 <= cus && g * 2 <= 1024) g *= 2;
        grid = g;
    }
    if (grid < 0) return;
    (void)hipMemsetAsync((char*)d_ws + WS_CTL, 0, CTL_ZERO_BYTES, stream);
    Args a{};
    for (int i = 0; i < 16; ++i) a.in[i] = (const float*)d_in[i];
    a.out = (float*)d_out; a.ws = (unsigned char*)d_ws;
#if MK_ONE_LAUNCH
    a.ph_lo = 0; a.ph_hi = N_PHASES + 1;
    hipLaunchKernelGGL(mk_fwd, dim3(grid), dim3(512), LDS_BYTES, stream, a);
#else
    for (int p = 0; p <= N_PHASES; ++p) { a.ph_lo = p; a.ph_hi = p + 1; hipLaunchKernelGGL(mk_fwd, dim3(grid), dim3(512), LDS_BYTES, stream, a); }
#endif
}
```

```cpp
#include <hip/hip_runtime.h>
#include <cstdio>
#include <cstdint>

#ifndef PROBE_T
#define PROBE_T 0
#endif
#ifndef PROBE_EPI
#define PROBE_EPI 1
#endif
#ifndef PROBE_DUP
#define PROBE_DUP 0
#endif
#ifndef MK_ONE_LAUNCH
#define MK_ONE_LAUNCH 1
#endif

#define LAS __attribute__((address_space(3)))
#define GAS __attribute__((address_space(1)))
typedef unsigned short bf16;
typedef short bf16x8 __attribute__((ext_vector_type(8)));
typedef short s16x4 __attribute__((ext_vector_type(4)));
typedef float f32x4 __attribute__((ext_vector_type(4)));
typedef float f32x16 __attribute__((ext_vector_type(16)));
typedef unsigned u32x4 __attribute__((ext_vector_type(4)));
typedef unsigned u32x2 __attribute__((ext_vector_type(2)));
typedef float f32x2_t __attribute__((ext_vector_type(2)));
typedef __bf16 bf16x2_t __attribute__((ext_vector_type(2)));
typedef GAS unsigned gu32;

constexpr int NB = 8, T = 8192, D = 1024, NTOK = NB * T;
constexpr int QKV_W = 5888;
constexpr int IN_W = 7936;
constexpr int COL_KD = 1536, COL_VD = 3072, COL_QS = 4608, COL_KS = 5632, COL_VS = 5760;
constexpr int NEXP = 32, DEXP = 512;
constexpr int SLOT_ROWS = 2 * NTOK + NEXP * 256;
constexpr int MAX_PANELS = SLOT_ROWS / 256;
constexpr float RMS_EPS = 1e-6f;
constexpr float LOG2E = 1.4426950408889634f, LN2 = 0.6931471805599453f;
constexpr float QSCALE = 0.125f * LOG2E;

constexpr size_t MiB = 1u << 20;
constexpr size_t WS_CTL = 0, CTL_ZERO_BYTES = 128 * 1024;
constexpr size_t WS_WIN = 1 * MiB;
constexpr size_t WS_WBR = 17 * MiB;
constexpr size_t WS_WOUT = 20 * MiB;
constexpr size_t WS_WGU = 22 * MiB;
constexpr size_t WS_WD = 86 * MiB;
constexpr size_t WS_WRT = 118 * MiB;
constexpr size_t WS_RE = 119 * MiB;
constexpr size_t WS_RREL = WS_RE + 256 * 1024;
constexpr size_t WS_RW = WS_RREL + 512 * 1024;
constexpr size_t WS_RMS1 = WS_RW + 512 * 1024;
constexpr size_t WS_RSTD2 = WS_RMS1 + 256 * 1024;
constexpr size_t WS_RSS = 125 * MiB;
constexpr size_t WS_TOS = 121 * MiB;
constexpr size_t WS_WOS = 122 * MiB;
constexpr size_t WS_SOT = 123 * MiB;
constexpr size_t WS_PEX = 124 * MiB;
constexpr size_t WS_H = 128 * MiB;
constexpr size_t WS_QKV = 256 * MiB;
constexpr size_t WS_LSE = 992 * MiB;
constexpr size_t WS_ACT = 256 * MiB;
constexpr size_t WS_YS = 392 * MiB;
constexpr size_t WS_X1B = 672 * MiB;
constexpr size_t WS_END = 1000 * MiB;
constexpr int COL_YDIL = 1536, COL_MIX = 0;
constexpr size_t TS = (size_t)NTOK * 64;
static_assert(WS_QKV + (size_t)NTOK * QKV_W * 2 <= WS_LSE && WS_LSE + (size_t)NTOK * 24 * 4 <= WS_END, "qkv/lse map");
static_assert(WS_ACT + (size_t)SLOT_ROWS * 512 * 2 <= WS_YS && WS_YS + (size_t)SLOT_ROWS * 1024 * 2 <= WS_LSE, "moe overlay");
constexpr int CW_BAR = 4096;
constexpr int CW_CNT = 8192;

constexpr int LDS_BYTES = 155648;
constexpr int MISC_OFF = LDS_BYTES - 256;
constexpr int PANEL_TAB_OFF = 131072 + 1024;
constexpr int P5_CNT_OFF = 147456, P5_BASE_OFF = P5_CNT_OFF + 128, P5_REC_OFF = P5_BASE_OFF + 128;

#define RLX_AGENT __ATOMIC_RELAXED, __HIP_MEMORY_SCOPE_AGENT
#define LDS_WAIT() asm volatile("s_waitcnt lgkmcnt(0)" ::: "memory")
__device__ __forceinline__ unsigned cvtpk(float lo, float hi) { f32x2_t v = {lo, hi}; bf16x2_t b = __builtin_convertvector(v, bf16x2_t); return __builtin_bit_cast(unsigned, b); }
__device__ __forceinline__ float bf_lo(unsigned u) { return __builtin_bit_cast(float, u << 16); }
__device__ __forceinline__ float bf_hi(unsigned u) { return __builtin_bit_cast(float, u & 0xffff0000u); }
__device__ __forceinline__ unsigned ld_agent(const unsigned* p) { return __hip_atomic_load(p, RLX_AGENT); }
template <int CTRL> __device__ __forceinline__ float dpp(float x) { return __builtin_bit_cast(float, __builtin_amdgcn_mov_dpp(__builtin_bit_cast(int, x), CTRL, 0xf, 0xf, true)); }
__device__ __forceinline__ float wave_sum(float v) {
    v += dpp<0xB1>(v); v += dpp<0x4E>(v); v += dpp<0x141>(v); v += dpp<0x140>(v);
    const int iv = __builtin_bit_cast(int, v);
    const float r0 = __builtin_bit_cast(float, __builtin_amdgcn_readlane(iv, 0)), r1 = __builtin_bit_cast(float, __builtin_amdgcn_readlane(iv, 16));
    const float r2 = __builtin_bit_cast(float, __builtin_amdgcn_readlane(iv, 32)), r3 = __builtin_bit_cast(float, __builtin_amdgcn_readlane(iv, 48));
    return (r0 + r1) + (r2 + r3);
}

namespace pg8 {
constexpr int BM = 256, BK = 64, HALF = 128, HTB = HALF * BK * 2, STAGE_BYTES = 8 * HTB, NXCD = 8, WGM = 8;
__host__ __device__ __forceinline__ int lds_byte(int r, int c) { const int st = (r >> 4) * 2 + (c >> 5), rr = r & 15, cc = c & 31, ob = rr * 64 + cc * 2; return st * 1024 + (ob ^ (((ob >> 9) & 1) << 5)); }
__host__ __device__ __forceinline__ void stage_rc(int b, int& R, int& C) { const int st = b / 1024, sb = b % 1024, swz = sb ^ (((sb >> 9) & 1) << 5); R = (st >> 1) * 16 + swz / 64; C = (st & 1) * 32 + (swz % 64) / 2; }
__host__ __device__ __forceinline__ int perm32(int rho) { const int n = rho >> 4, i = rho & 15; return 8 * (i >> 2) + 4 * n + (i & 3); }

struct Unit { int pm, pn, part, skip; };
struct Gemm { const bf16* A0; const bf16* A1; const bf16* B0; const bf16* B1; int lda, ldb, nt0, nt1; size_t kstepA; };

template <bool CHAIN, bool KDUP = false> struct StaticOrder {
    int nM, nN, nwg, G, c, wgm, nmine;
    __device__ void init(int M, int N, int G_, int c_, int wgm_ = WGM, bool rev = false) { nM = M / BM; nN = N / BM; nwg = nM * nN; G = G_; c = c_; wgm = wgm_; nmine = rev ? (nwg - c_ + G_ - 1) / G_ : 0; }
    __device__ bool next(int i, Unit& u) const {
        int it = (CHAIN || KDUP) ? (i >> 1) : i; u.part = CHAIN ? (i & 1) : 0; u.skip = KDUP ? !(i & 1) : 0;
        if (nmine > 0) { if (it >= nmine) return false; it = nmine - 1 - it; }
        const long L = (long)it * G + c; if (L >= nwg) return false;
        int wgid = (int)L; { const int q = nwg / NXCD, r = nwg % NXCD, xcd = wgid % NXCD, off = wgid / NXCD; wgid = (xcd < r ? xcd * (q + 1) : r * (q + 1) + (xcd - r) * q) + off; }
        const int nig = wgm * nN, gid = wgid / nig, fm = gid * wgm, gsz = (nM - fm) < wgm ? (nM - fm) : wgm;
        u.pm = fm + ((wgid % nig) % gsz); u.pn = (wgid % nig) / gsz; return true;
    }
};
struct PanelOrder {
    volatile LAS int* tab; int np4, G, c;
    __device__ void init(const unsigned* pex, volatile LAS int* tab_, int G_, int vcu, int tid) {
        tab = tab_; G = G_; c = vcu; np4 = 4 * __builtin_amdgcn_readfirstlane((int)ld_agent(pex + 1023));
        if (tid < 64) { const int L = tid * G_ + vcu; tab_[tid] = (L < np4) ? (int)ld_agent(pex + (L >> 2)) : 0; }
        __syncthreads();
    }
    bool rev = false;
    __device__ bool next(int i0, Unit& u) const {
        int i = i0;
        if (rev) { const int n = (np4 - c + G - 1) / G; if (i0 >= n) return false; i = n - 1 - i0; }
        const int L = i * G + c; if (L >= np4 || i >= 64) return false;
        u.pm = L >> 2; u.pn = 4 * __builtin_amdgcn_readfirstlane(tab[i]) + (L & 3); u.part = 0; u.skip = 0; return true;
    }
};

template <class Epi, class Sched, bool GATHER>
__device__ __forceinline__ void gemm_phase(LAS unsigned char* lds, const int tid, const Gemm g, const Sched& S, const Epi& E, const unsigned* rowidx) {
    const int wid = __builtin_amdgcn_readfirstlane(tid >> 6), lane = tid & 63, wr = wid >> 2, wc = wid & 3, fr = lane & 15, fq = lane >> 4;
    int Rr[2], Cc[2]; unsigned voffB[2];
#pragma unroll
    for (int i = 0; i < 2; ++i) { stage_rc(tid * 16 + i * 8192, Rr[i], Cc[i]); const int Rb = (Rr[i] & ~31) + perm32(Rr[i] & 31); voffB[i] = (unsigned)(Rb * g.ldb + Cc[i] * 2); }
    const size_t kstep = (size_t)(BK * 2), kA = g.kstepA;
    const size_t hstep = (size_t)HALF * g.ldb;
    const size_t tstepA = (size_t)BM * g.lda, tstepB = (size_t)BM * g.ldb;
    const unsigned ldsw = (unsigned)wid * 1024u;
    const int aoff = lds_byte(wr * 64 + fr, fq * 8), boff = lds_byte(wc * 32 + fr, fq * 8);
    unsigned vc[2][2], vn[2][2];
#define PG8_SA(b, h) (((b) * 2 + (h)) * HTB)
#define PG8_SB(b, h) ((4 + (b) * 2 + (h)) * HTB)
#define PG8_STAGE(bufoff, gbase, voff) do { _Pragma("unroll") for (int _i = 0; _i < 2; ++_i) \
        __builtin_amdgcn_global_load_lds((const unsigned*)((const char*)(gbase) + (voff)[_i]), (LAS unsigned*)(lds + (bufoff) + ldsw + _i * 8192), 16, 0, 0); } while (0)
#define PG8_LDA(dst, b, h) do { _Pragma("unroll") for (int m = 0; m < 4; ++m) _Pragma("unroll") for (int k = 0; k < 2; ++k) dst[m][k] = *(const LAS bf16x8*)(lds + PG8_SA(b, h) + aoff + m * 2048 + k * 1024); } while (0)
#define PG8_LDB(dst, b, h) do { _Pragma("unroll") for (int n = 0; n < 2; ++n) _Pragma("unroll") for (int k = 0; k < 2; ++k) dst[n][k] = *(const LAS bf16x8*)(lds + PG8_SB(b, h) + boff + n * 2048 + k * 1024); } while (0)
#define PG8_MMA(ai, bj, At, Bt) do { __builtin_amdgcn_s_setprio(1); _Pragma("unroll") for (int m = 0; m < 4; ++m) _Pragma("unroll") for (int n = 0; n < 2; ++n) _Pragma("unroll") for (int k = 0; k < 2; ++k) \
        acc[ai][bj][m][n] = __builtin_amdgcn_mfma_f32_16x16x32_bf16(Bt[n][k], At[m][k], acc[ai][bj][m][n], 0, 0, 0); __builtin_amdgcn_s_setprio(0); } while (0)
#define PG8_WAIT_V(n) asm volatile("s_waitcnt vmcnt(" #n ")" ::: "memory")
#define PG8_WAIT_L(n) asm volatile("s_waitcnt lgkmcnt(" #n ")" ::: "memory")
#define PG8_BAR __builtin_amdgcn_s_barrier()
#define PG8_SCHED __builtin_amdgcn_sched_barrier(0)
#define PG8_VOFFS(v, u) do { _Pragma("unroll") for (int _h = 0; _h < 2; ++_h) _Pragma("unroll") for (int _i = 0; _i < 2; ++_i) { \
        if (GATHER) { const unsigned _t = rowidx[(u).pm * BM + _h * HALF + Rr[_i]]; v[_h][_i] = _t * (unsigned)g.lda + (unsigned)(Cc[_i] * 2); } \
        else v[_h][_i] = (unsigned)((_h * HALF + Rr[_i]) * g.lda + Cc[_i] * 2); } } while (0)
#define PG8_ZERO() do { _Pragma("unroll") for (int a = 0; a < 2; ++a) _Pragma("unroll") for (int b = 0; b < 2; ++b) _Pragma("unroll") for (int m = 0; m < 4; ++m) _Pragma("unroll") for (int n = 0; n < 2; ++n) acc[a][b][m][n] = (f32x4){0.f, 0.f, 0.f, 0.f}; } while (0)
    Unit cur, nxt; int ui = 0;
    if (!S.next(0, cur)) return;
#if PROBE_T
#define PT_NOW() (Epi::PROBE ? (unsigned)__builtin_amdgcn_s_memrealtime() : 0u)
    unsigned pt_first = 0, pt_rest = 0, pt_epi = 0, pt0 = 0, pt1 = 0, pt2 = 0;
    const unsigned pc_c0 = Epi::PROBE ? (unsigned)__builtin_amdgcn_s_memtime() : 0u, pc_t0 = PT_NOW();
#endif
    f32x4 acc[2][2][4][2];
    PG8_ZERO();
    bf16x8 At[4][2], B0[2][2], B1[2][2];
    PG8_VOFFS(vc, cur);
    const char* cA = GATHER ? (const char*)g.A0 : (const char*)(cur.part ? g.A1 : g.A0) + (size_t)cur.pm * tstepA; const char* cB = (const char*)(cur.part ? g.B1 : g.B0) + (size_t)cur.pn * tstepB;
    int nt = cur.part ? g.nt1 : g.nt0;
    PG8_STAGE(PG8_SB(0, 0), cB, voffB); PG8_STAGE(PG8_SB(0, 1), cB + hstep, voffB); PG8_STAGE(PG8_SA(0, 0), cA, vc[0]); PG8_STAGE(PG8_SA(0, 1), cA, vc[1]);
    if (wr == 1) PG8_BAR;
    PG8_WAIT_V(2); PG8_BAR;
    PG8_STAGE(PG8_SB(1, 0), cB + kstep, voffB); PG8_STAGE(PG8_SA(1, 0), cA + kA, vc[0]); PG8_STAGE(PG8_SB(1, 1), cB + hstep + kstep, voffB);
    PG8_WAIT_V(6); PG8_BAR;
    for (;;) {
        const bool has_next = S.next(ui + 1, nxt);
        const char* nA = GATHER ? (const char*)g.A0 : (has_next ? (const char*)(nxt.part ? g.A1 : g.A0) + (size_t)nxt.pm * tstepA : cA);
        const char* nB = has_next ? (const char*)(nxt.part ? g.B1 : g.B0) + (size_t)nxt.pn * tstepB : cB;
        if constexpr (GATHER) {
            if (has_next) { PG8_VOFFS(vn, nxt); } else {
#pragma unroll
                for (int h = 0; h < 2; ++h)
#pragma unroll
                    for (int i = 0; i < 2; ++i) vn[h][i] = vc[h][i]; }
        }
#if PROBE_T
        pt0 = PT_NOW();
#endif
        for (int t = 0; t < nt; t += 2) {
            const bool last = (t == nt - 2);
            const char* a1 = cA + (size_t)(t + 1) * kA;
            const char* a2 = last ? nA : cA + (size_t)(t + 2) * kA; const char* b2 = last ? nB : cB + (size_t)(t + 2) * kstep;
            const char* a3 = a2 + kA; const char* b3 = b2 + kstep;
            unsigned v2[2][2];
#pragma unroll
            for (int h = 0; h < 2; ++h)
#pragma unroll
                for (int i = 0; i < 2; ++i) { if constexpr (GATHER) v2[h][i] = last ? vn[h][i] : vc[h][i]; else v2[h][i] = vc[h][i]; }
            PG8_LDB(B0, 0, 0); PG8_LDB(B1, 0, 1); PG8_SCHED; PG8_LDA(At, 0, 0); PG8_STAGE(PG8_SA(1, 1), a1, vc[1]);
            PG8_WAIT_V(8); PG8_WAIT_L(0); PG8_BAR; PG8_MMA(0, 0, At, B0); PG8_MMA(0, 1, At, B1); PG8_BAR; PG8_SCHED;
            PG8_LDA(At, 0, 1); PG8_STAGE(PG8_SB(0, 0), b2, voffB); PG8_STAGE(PG8_SB(0, 1), b2 + hstep, voffB); PG8_STAGE(PG8_SA(0, 0), a2, v2[0]);
            PG8_WAIT_V(8); PG8_WAIT_L(0); PG8_BAR; PG8_MMA(1, 0, At, B0); PG8_MMA(1, 1, At, B1); PG8_BAR; PG8_SCHED;
            PG8_LDB(B0, 1, 0); PG8_LDB(B1, 1, 1); PG8_SCHED; PG8_LDA(At, 1, 0); PG8_STAGE(PG8_SA(0, 1), a2, v2[1]);
            PG8_WAIT_V(8); PG8_WAIT_L(0); PG8_BAR; PG8_MMA(0, 0, At, B0); PG8_MMA(0, 1, At, B1); PG8_BAR; PG8_SCHED;
            PG8_LDA(At, 1, 1); PG8_STAGE(PG8_SB(1, 0), b3, voffB); PG8_STAGE(PG8_SB(1, 1), b3 + hstep, voffB); PG8_STAGE(PG8_SA(1, 0), a3, v2[0]);
            PG8_WAIT_V(8); PG8_WAIT_L(0); PG8_BAR; PG8_MMA(1, 0, At, B0); PG8_MMA(1, 1, At, B1); PG8_BAR; PG8_SCHED;
        }
#if PROBE_T
        pt2 = PT_NOW(); pt_rest += pt2 - pt0;
#endif
        if (wr == 0) PG8_BAR;
        bool mid = false;
        if constexpr (Epi::CHAINED) mid = (cur.part == 0);
        if (mid) { if constexpr (Epi::CHAINED) E.mid(acc, cur, wr, wc, fr, fq); } else if (!cur.skip) { E(acc, cur, wr, wc, fr, fq); if (PROBE_DUP == 10 && Epi::PROBE10) { asm volatile("" ::: "memory"); E(acc, cur, wr, wc, fr, fq); } }
#if PROBE_T
        pt_epi += PT_NOW() - pt2;
#endif
        if (!has_next) break;
        if (!mid) PG8_ZERO();
        cur = nxt; cA = nA; cB = nB; nt = cur.part ? g.nt1 : g.nt0; ++ui;
        if constexpr (GATHER) {
#pragma unroll
            for (int h = 0; h < 2; ++h)
#pragma unroll
                for (int i = 0; i < 2; ++i) vc[h][i] = vn[h][i];
        }
        if (wr == 1) PG8_BAR;
    }
    PG8_WAIT_V(0);
    PG8_BAR;
#if PROBE_T
    if constexpr (Epi::PROBE) { if (E.probe_out && tid == 0) { E.probe_out[0] = pt_first; E.probe_out[1] = pt_rest; E.probe_out[2] = pt_epi; E.probe_out[3] = (unsigned)__builtin_amdgcn_s_memtime() - pc_c0; E.probe_out[4] = PT_NOW() - pc_t0;
        if (PROBE_T >= 8) { atomicMax(E.probe_out + 10, PT_NOW() - pc_t0); atomicMax(E.probe_out + 11, 0x7fffffffu - (PT_NOW() - pc_t0)); } } }
#endif
#undef PG8_SA
#undef PG8_SB
#undef PG8_STAGE
#undef PG8_LDA
#undef PG8_LDB
#undef PG8_MMA
#undef PG8_WAIT_V
#undef PG8_WAIT_L
#undef PG8_BAR
#undef PG8_SCHED
#undef PG8_VOFFS
#undef PG8_ZERO
}
}

__device__ __forceinline__ float sigmoidf_fast(float a) { return __builtin_amdgcn_rcpf(1.f + __builtin_amdgcn_exp2f(-a * LOG2E)); }
__device__ __forceinline__ u32x4 pack8(const f32x4 a, const f32x4 b) { u32x4 w; w.x = cvtpk(a[0], a[1]); w.y = cvtpk(a[2], a[3]); w.z = cvtpk(b[0], b[1]); w.w = cvtpk(b[2], b[3]); return w; }
__device__ __forceinline__ void unpack8(const u32x4 w, f32x4& a, f32x4& b) { a = (f32x4){bf_lo(w.x), bf_hi(w.x), bf_lo(w.y), bf_hi(w.y)}; b = (f32x4){bf_lo(w.z), bf_hi(w.z), bf_lo(w.w), bf_hi(w.w)}; }
typedef const f32x4 (&AccRef)[2][2][4][2];
typedef f32x4 (&AccMut)[2][2][4][2];

struct Epi1 {
    static constexpr bool CHAINED = false; static constexpr bool PROBE = (PROBE_T != 0 && PROBE_EPI == 1); static constexpr bool PROBE10 = true;
    bf16* qkv; bf16* sgd; bf16* sgs; unsigned* probe_out;
    __device__ __forceinline__ void operator()(AccRef acc, const pg8::Unit& u, int wr, int wc, int fr, int fq) const {
        const int pn = u.pn;
        if (pn < 23) {
            int sh = 0; float sc = 1.f;
            if (pn < 18) { sh = 2 * ((pn % 6) >> 1); if (pn < 6) sc = QSCALE; } else if (pn < 22) sc = QSCALE;
            const int col0 = pn * 256 + wc * 32 + fq * 8;
#pragma unroll
            for (int ai = 0; ai < 2; ++ai)
#pragma unroll
                for (int m = 0; m < 4; ++m) {
                    const int row = u.pm * 256 + ai * 128 + wr * 64 + m * 16 + fr, t = row & (T - 1);
                    const int rowp = (row & ~(T - 1)) | ((t & ((1 << sh) - 1)) << (13 - sh)) | (t >> sh);
                    bf16* rp = qkv + (size_t)(col0 >> 6) * TS + (size_t)rowp * 64 + (col0 & 63);
#pragma unroll
                    for (int bj = 0; bj < 2; ++bj) *(u32x4*)(rp + bj * 2 * TS) = pack8(acc[ai][bj][m][0] * sc, acc[ai][bj][m][1] * sc);
                }
        } else {
            const int col0 = (pn - 23) * 128 + wc * 32 + fq * 8;
#pragma unroll
            for (int ai = 0; ai < 2; ++ai)
#pragma unroll
                for (int m = 0; m < 4; ++m) {
                    const size_t off = (size_t)(u.pm * 256 + ai * 128 + wr * 64 + m * 16 + fr) * 1024 + col0;
#pragma unroll
                    for (int bj = 0; bj < 2; ++bj) { f32x4 a = acc[ai][bj][m][0], b = acc[ai][bj][m][1];
#pragma unroll
                        for (int i = 0; i < 4; ++i) { a[i] = sigmoidf_fast(a[i]); b[i] = sigmoidf_fast(b[i]); }
                        *(u32x4*)((bj ? sgs : sgd) + off) = pack8(a, b); }
                }
        }
    }
};
struct EpiMix {
    static constexpr bool CHAINED = true; static constexpr bool PROBE = (PROBE_T != 0 && PROBE_EPI == 4); static constexpr bool PROBE10 = false;
    const bf16* sgd; const bf16* sgs; bf16* mix; unsigned* probe_out;
    __device__ __forceinline__ void mid(AccMut acc, const pg8::Unit& u, int wr, int wc, int fr, int fq) const {
#pragma unroll
        for (int ai = 0; ai < 2; ++ai)
#pragma unroll
            for (int m = 0; m < 4; ++m) {
                const size_t off = (size_t)(u.pm * 256 + ai * 128 + wr * 64 + m * 16 + fr) * 1024 + u.pn * 256 + wc * 32 + fq * 8;
#pragma unroll
                for (int bj = 0; bj < 2; ++bj) { f32x4 da, db, sa, sb; unpack8(*(const u32x4*)(sgd + off + bj * 128), da, db); unpack8(*(const u32x4*)(sgs + off + bj * 128), sa, sb);
#pragma unroll
                    for (int i = 0; i < 4; ++i) { acc[ai][bj][m][0][i] *= sa[i] * __builtin_amdgcn_rcpf(fmaxf(da[i], 1e-20f)); acc[ai][bj][m][1][i] *= sb[i] * __builtin_amdgcn_rcpf(fmaxf(db[i], 1e-20f)); } }
            }
    }
    __device__ __forceinline__ void operator()(AccRef acc, const pg8::Unit& u, int wr, int wc, int fr, int fq) const {
        u32x4 gd[2][4][2];
#pragma unroll
        for (int ai = 0; ai < 2; ++ai)
#pragma unroll
            for (int m = 0; m < 4; ++m) {
                const size_t off = (size_t)(u.pm * 256 + ai * 128 + wr * 64 + m * 16 + fr) * 1024 + u.pn * 256 + wc * 32 + fq * 8;
#pragma unroll
                for (int bj = 0; bj < 2; ++bj) gd[ai][m][bj] = *(const u32x4*)(sgd + off + bj * 128);
            }
        __builtin_amdgcn_sched_barrier(0);
#pragma unroll
        for (int ai = 0; ai < 2; ++ai)
#pragma unroll
            for (int m = 0; m < 4; ++m) {
                const size_t row = (size_t)(u.pm * 256 + ai * 128 + wr * 64 + m * 16 + fr); const int col = u.pn * 256 + wc * 32 + fq * 8;
#pragma unroll
                for (int bj = 0; bj < 2; ++bj) { f32x4 da, db; unpack8(gd[ai][m][bj], da, db);
#pragma unroll
                    for (int i = 0; i < 4; ++i) { da[i] = fmaxf(da[i], 1e-20f); db[i] = fmaxf(db[i], 1e-20f); }
                    *(u32x4*)(mix + (size_t)((col >> 6) + 2 * bj) * TS + row * 64 + (col & 63)) = pack8(da * acc[ai][bj][m][0], db * acc[ai][bj][m][1]); }
            }
    }
};
struct EpiRes {
    static constexpr bool CHAINED = false; static constexpr bool PROBE = (PROBE_T != 0 && PROBE_EPI == 5); static constexpr bool PROBE10 = false;
    const bf16* hx; const float* rms; bf16* x1b; unsigned* probe_out;
    __device__ __forceinline__ void operator()(AccRef acc, const pg8::Unit& u, int wr, int wc, int fr, int fq) const {
        u32x4 xv[2][4][2]; float rm[2][4];
#pragma unroll
        for (int ai = 0; ai < 2; ++ai)
#pragma unroll
            for (int m = 0; m < 4; ++m) {
                const int row = u.pm * 256 + ai * 128 + wr * 64 + m * 16 + fr;
                const size_t off = (size_t)row * 1024 + u.pn * 256 + wc * 32 + fq * 8;
                rm[ai][m] = rms[row];
#pragma unroll
                for (int bj = 0; bj < 2; ++bj) xv[ai][m][bj] = *(const u32x4*)(hx + off + bj * 128);
            }
        __builtin_amdgcn_sched_barrier(0);
#pragma unroll
        for (int ai = 0; ai < 2; ++ai)
#pragma unroll
            for (int m = 0; m < 4; ++m) {
                const size_t off = (size_t)(u.pm * 256 + ai * 128 + wr * 64 + m * 16 + fr) * 1024 + u.pn * 256 + wc * 32 + fq * 8;
#pragma unroll
                for (int bj = 0; bj < 2; ++bj) { f32x4 a, b; unpack8(xv[ai][m][bj], a, b);
                    *(u32x4*)(x1b + off + bj * 128) = pack8(a * rm[ai][m] + acc[ai][bj][m][0], b * rm[ai][m] + acc[ai][bj][m][1]); }
            }
    }
};
struct EpiGU {
    static constexpr bool CHAINED = false; static constexpr bool PROBE = false; static constexpr bool PROBE10 = false;
    bf16* act; const float* rss;
    __device__ __forceinline__ void operator()(AccRef acc, const pg8::Unit& u, int wr, int wc, int fr, int fq) const {
        const int col0 = (u.pn & 3) * 128 + wc * 32 + fq * 8;
        float rs[2][4];
#pragma unroll
        for (int ai = 0; ai < 2; ++ai)
#pragma unroll
            for (int m = 0; m < 4; ++m) rs[ai][m] = rss[u.pm * 256 + ai * 128 + wr * 64 + m * 16 + fr];
        __builtin_amdgcn_sched_barrier(0);
#pragma unroll
        for (int ai = 0; ai < 2; ++ai)
#pragma unroll
            for (int m = 0; m < 4; ++m) {
                const size_t off = (size_t)(u.pm * 256 + ai * 128 + wr * 64 + m * 16 + fr) * DEXP + col0;
                f32x4 o[2];
#pragma unroll
                for (int n = 0; n < 2; ++n)
#pragma unroll
                    for (int i = 0; i < 4; ++i) { const float gt = acc[ai][0][m][n][i] * rs[ai][m]; o[n][i] = gt * sigmoidf_fast(gt) * (acc[ai][1][m][n][i] * rs[ai][m]); }
                *(u32x4*)(act + off) = pack8(o[0], o[1]);
            }
    }
};
struct EpiDown {
    static constexpr bool CHAINED = false; static constexpr bool PROBE = (PROBE_T != 0 && PROBE_EPI == 9); static constexpr bool PROBE10 = false;
    bf16* ys; const float* wos; unsigned* probe_out;
    __device__ __forceinline__ void operator()(AccRef acc, const pg8::Unit& u, int wr, int wc, int fr, int fq) const {
        float wv[2][4];
#pragma unroll
        for (int ai = 0; ai < 2; ++ai)
#pragma unroll
            for (int m = 0; m < 4; ++m) wv[ai][m] = wos[u.pm * 256 + ai * 128 + wr * 64 + m * 16 + fr];
        __builtin_amdgcn_sched_barrier(0);
#pragma unroll
        for (int ai = 0; ai < 2; ++ai)
#pragma unroll
            for (int m = 0; m < 4; ++m) {
                const int row = u.pm * 256 + ai * 128 + wr * 64 + m * 16 + fr;
                const size_t off = (size_t)row * 1024 + (u.pn & 3) * 256 + wc * 32 + fq * 8;
#pragma unroll
                for (int bj = 0; bj < 2; ++bj) *(u32x4*)(ys + off + bj * 128) = pack8(acc[ai][bj][m][0] * wv[ai][m], acc[ai][bj][m][1] * wv[ai][m]);
            }
    }
};

namespace att {
constexpr int VPITCH = 128, KROWS = 384, LDS_K = 0, LDS_V = KROWS * 128;
static_assert(LDS_V + 2 * KROWS * VPITCH <= 147456, "attention LDS: K image + two V images");
#define MFMA32(a, b, c) __builtin_amdgcn_mfma_f32_32x32x16_bf16((a), (b), (c), 0, 0, 0)
typedef short v4i16_t __attribute__((ext_vector_type(4)));
__device__ __forceinline__ s16x4 vtr(const LAS unsigned char* p) { return __builtin_bit_cast(s16x4, __builtin_amdgcn_ds_read_tr16_b64_v4i16((LAS v4i16_t*)p)); }

struct UnitDesc {
    const bf16* rb;
    int qcol, kcol, vcol;
    int has_prev, nh, mixer, head0, dil;
    int ltok0, lstride;
};
template <bool ISV> __device__ __forceinline__ void dma_image(LAS unsigned char* img, const bf16* g0  , const int w, const int lane, const bool has_prev) {
#pragma unroll
    for (int j = 0; j < 6; ++j) {
        if (j >= 2 || has_prev) {
            const int pi = w + 8 * j, r = 8 * pi + (lane >> 3), cp = lane & 7, c = ISV ? (cp ^ (((r >> 1) & 1) << 2)) : (cp ^ ((r >> 1) & 7));
            __builtin_amdgcn_global_load_lds((const unsigned*)(g0 + (ptrdiff_t)(r - 128) * 64 + c * 8), (LAS unsigned*)(img + pi * 1024), 16, 0, 0);
        }
    }
}
#define ATT_WAIT_V(n) asm volatile("s_waitcnt vmcnt(" #n ")" ::: "memory")
#define ATT_BAR() do { asm volatile("s_waitcnt lgkmcnt(0)" ::: "memory"); __builtin_amdgcn_s_barrier(); asm volatile("" ::: "memory"); } while (0)
__device__ __forceinline__ void attn_unit(LAS unsigned char* lds, const int tid, const UnitDesc& U, const float* sinks, float* lse, const bool has_next, const UnitDesc& Un, bf16x8 (&qn)[4], const int vpar, unsigned (&pt)[6]) {
#define APT(i) do { if (PROBE_T >= 40) { const unsigned _n = (unsigned)__builtin_amdgcn_s_memrealtime(); pt[i] += _n - ptl; ptl = _n; } } while (0)
    unsigned ptl = (PROBE_T >= 40) ? (unsigned)__builtin_amdgcn_s_memrealtime() : 0u;
    const int w = __builtin_amdgcn_readfirstlane(tid >> 6), lane = tid & 63, ql = lane & 31, h = lane >> 5;
    const int cstart = U.has_prev ? 0 : (w < 4 ? 4 - w : 0);
    const int i16 = lane & 15, q4 = i16 >> 2, p4 = i16 & 3, blk = (lane >> 4) & 1, swz = (q4 >> 1) & 1, kswz = (ql >> 1) & 7;
    float skl = 0.f;
    if (U.mixer) { const int hs = U.head0 + (lane & 7); skl = sinks[hs < 16 ? hs : 15]; }
    ATT_WAIT_V(0);
#pragma unroll
    for (int kk = 0; kk < 4; ++kk) asm volatile("" : "+v"(qn[kk]));
    asm volatile("" : "+v"(skl));
    ATT_BAR();
    APT(0);
    LAS unsigned char* const vimg = lds + LDS_V + vpar * (KROWS * VPITCH);
    const unsigned vbl = (unsigned)reinterpret_cast<__SIZE_TYPE__>(vimg) + (unsigned)((32 * w + 4 * h + q4) * VPITCH + (2 * blk + (p4 >> 1)) * 16 + 8 * (p4 & 1));
    const unsigned vb0 = vbl + (unsigned)(64 * swz), vb1 = vbl + (unsigned)(64 * (swz ^ 1));
    unsigned kbase[4];
#pragma unroll
    for (int kk = 0; kk < 4; ++kk) kbase[kk] = (unsigned)reinterpret_cast<__SIZE_TYPE__>(lds + LDS_K) + (unsigned)((32 * w + ql) * 128 + (((2 * kk + h) ^ kswz) * 16));
    for (int hh = 0; hh < U.nh; ++hh) {
        const int head = U.head0 + hh;
        const float slope = U.mixer ? __builtin_amdgcn_exp2f(-0.5f * (float)(head + 1)) : __builtin_amdgcn_exp2f((float)(head + 1) * (-8.f / 24.f));
        const float c2 = slope * (float)U.dil * LOG2E;
        const float sink2 = U.mixer ? __builtin_bit_cast(float, __builtin_amdgcn_readlane(__builtin_bit_cast(int, skl), hh)) * LOG2E : -INFINITY;
        bf16x8 qf[4];
#pragma unroll
        for (int kk = 0; kk < 4; ++kk) qf[kk] = qn[kk];
        if (hh == 0 && has_next) dma_image<true>(lds + LDS_V + (vpar ^ 1) * (KROWS * VPITCH), Un.rb + (size_t)Un.vcol * TS, w, lane, Un.has_prev != 0);
        f32x16 S[5];
        const float tl = -c2 * (float)(128 + ql - 4 * h);
        bf16x8 ka[4];
#define QK_READ(set, c) do { _Pragma("unroll") for (int kk = 0; kk < 4; ++kk) \
            asm volatile("ds_read_b128 %0, %1 offset:%c2" : "=&v"(set[kk]) : "v"(kbase[kk]), "i"((32 * (c)) * 128) : "memory"); } while (0)
#define QK_STEP(cur, nxt, c) do { if ((c) >= cstart) { \
            QK_READ(cur, c); \
            const float tc = tl + c2 * (32.f * (float)(c)); \
            _Pragma("unroll") for (int r = 0; r < 16; ++r) S[c][r] = tc + c2 * (float)((r & 3) + 8 * (r >> 2)); \
            asm volatile("s_waitcnt lgkmcnt(0)" : "+v"(cur[0]), "+v"(cur[1]), "+v"(cur[2]), "+v"(cur[3]) :: "memory"); \
            _Pragma("unroll") for (int kk = 0; kk < 4; ++kk) S[c] = MFMA32(cur[kk], qf[kk], S[c]); \
        } else { _Pragma("unroll") for (int r = 0; r < 16; ++r) S[c][r] = -INFINITY; } } while (0)
        QK_STEP(ka, ka, 0); QK_STEP(ka, ka, 1); QK_STEP(ka, ka, 2); QK_STEP(ka, ka, 3); QK_STEP(ka, ka, 4);
#undef QK_READ
#undef QK_STEP
        APT(1);
        if (hh + 1 < U.nh) {
            const bf16* qrow = U.rb + (size_t)(U.qcol + hh + 1) * TS + (32 * w + ql) * 64 + 8 * h;
#pragma unroll
            for (int kk = 0; kk < 4; ++kk) qn[kk] = *(const bf16x8*)(qrow + 16 * kk);
        }
        if (hh == U.nh - 1) {
            ATT_BAR();
            if (has_next) {
                dma_image<false>(lds + LDS_K, Un.rb + (size_t)Un.kcol * TS, w, lane, Un.has_prev != 0);
                const bf16* qrow = Un.rb + (size_t)Un.qcol * TS + (32 * w + ql) * 64 + 8 * h;
#pragma unroll
                for (int kk = 0; kk < 4; ++kk) qn[kk] = *(const bf16x8*)(qrow + 16 * kk);
            }
        }
        const int d0 = U.mixer;
#pragma unroll
        for (int r = 0; r < 16; ++r) { const int kl = (r & 3) + 8 * (r >> 2) + 4 * h; if (kl < ql + d0) S[0][r] = -INFINITY; if (kl > ql) S[4][r] = -INFINITY; }
        float m = sink2;
#pragma unroll
        for (int c = 0; c < 5; ++c)
#pragma unroll
            for (int r = 0; r < 16; ++r) m = fmaxf(m, S[c][r]);
        m = fmaxf(m, __shfl_xor(m, 32));
        float l = 0.f;
        APT(2);
        APT(3);
        f32x16 O[2];
#pragma unroll
        for (int r = 0; r < 16; ++r) { O[0][r] = 0.f; O[1][r] = 0.f; }
        s16x4 ra[4], rb[4];
#define PV_READ(set, k) do { \
            asm volatile("ds_read_b64_tr_b16 %0, %1 offset:%c2" : "=&v"(set[0]) : "v"(vb0), "i"((16 * (k)) * VPITCH) : "memory"); \
            asm volatile("ds_read_b64_tr_b16 %0, %1 offset:%c2" : "=&v"(set[1]) : "v"(vb0), "i"((16 * (k) + 8) * VPITCH) : "memory"); \
            asm volatile("ds_read_b64_tr_b16 %0, %1 offset:%c2" : "=&v"(set[2]) : "v"(vb1), "i"((16 * (k)) * VPITCH) : "memory"); \
            asm volatile("ds_read_b64_tr_b16 %0, %1 offset:%c2" : "=&v"(set[3]) : "v"(vb1), "i"((16 * (k) + 8) * VPITCH) : "memory"); } while (0)
#define PV_EXP(k) do { _Pragma("unroll") for (int r = 0; r < 8; ++r) { const float p = __builtin_amdgcn_exp2f(S[(k) >> 1][8 * ((k) & 1) + r] - m); S[(k) >> 1][8 * ((k) & 1) + r] = p; l += p; } } while (0)
#define PV_STEP(cur, nxt, k) do { if (((k) >> 1) >= cstart) { \
            if ((k) == 2 * cstart) { PV_READ(cur, k); PV_EXP(k); } \
            asm volatile("s_waitcnt lgkmcnt(0)" : "+v"(cur[0]), "+v"(cur[1]), "+v"(cur[2]), "+v"(cur[3]) :: "memory"); \
            if ((k) + 1 < 10) PV_READ(nxt, (k) + 1); \
            u32x4 pw; pw.x = cvtpk(S[(k) >> 1][8 * ((k) & 1)], S[(k) >> 1][8 * ((k) & 1) + 1]); pw.y = cvtpk(S[(k) >> 1][8 * ((k) & 1) + 2], S[(k) >> 1][8 * ((k) & 1) + 3]); \
            pw.z = cvtpk(S[(k) >> 1][8 * ((k) & 1) + 4], S[(k) >> 1][8 * ((k) & 1) + 5]); pw.w = cvtpk(S[(k) >> 1][8 * ((k) & 1) + 6], S[(k) >> 1][8 * ((k) & 1) + 7]); \
            const bf16x8 pf = __builtin_bit_cast(bf16x8, pw); \
            O[0] = MFMA32(__builtin_shufflevector(cur[0], cur[1], 0, 1, 2, 3, 4, 5, 6, 7), pf, O[0]); \
            O[1] = MFMA32(__builtin_shufflevector(cur[2], cur[3], 0, 1, 2, 3, 4, 5, 6, 7), pf, O[1]); \
            if ((k) + 1 < 10) PV_EXP((k) + 1);     } } while (0)
        PV_STEP(ra, rb, 0); PV_STEP(rb, ra, 1); PV_STEP(ra, rb, 2); PV_STEP(rb, ra, 3); PV_STEP(ra, rb, 4);
        PV_STEP(rb, ra, 5); PV_STEP(ra, rb, 6); PV_STEP(rb, ra, 7); PV_STEP(ra, rb, 8); PV_STEP(rb, ra, 9);
#undef PV_READ
#undef PV_STEP
#undef PV_EXP
        l += __shfl_xor(l, 32);
        l += __builtin_amdgcn_exp2f(sink2 - m);
        APT(4);
        const float inv = 1.f / l;
        const int qi = 32 * w + ql;
        bf16* op = const_cast<bf16*>(U.rb) + (size_t)(U.qcol + hh) * TS + qi * 64 + 8 * h;
#pragma unroll
        for (int dt = 0; dt < 2; ++dt)
#pragma unroll
            for (int j = 0; j < 2; ++j) {
                const int ga = 2 * j, gb = 2 * j + 1;
                const unsigned ax = cvtpk(O[dt][4 * ga] * inv, O[dt][4 * ga + 1] * inv), ay = cvtpk(O[dt][4 * ga + 2] * inv, O[dt][4 * ga + 3] * inv);
                const unsigned bx_ = cvtpk(O[dt][4 * gb] * inv, O[dt][4 * gb + 1] * inv), by = cvtpk(O[dt][4 * gb + 2] * inv, O[dt][4 * gb + 3] * inv);
                const auto sx = __builtin_amdgcn_permlane32_swap(ax, bx_, false, false), sy = __builtin_amdgcn_permlane32_swap(ay, by, false, false);
                u32x4 o4; o4.x = sx[0]; o4.y = sy[0]; o4.z = sx[1]; o4.w = sy[1];
                *(u32x4*)(op + 32 * dt + 16 * j) = o4; }
        if (!U.mixer && h == 0) lse[(size_t)(U.ltok0 + qi * U.lstride) * 24 + head] = (m + __builtin_amdgcn_logf(l)) * LN2;
        APT(5);
    }
#undef APT
}
#undef ATT_WAIT_V
#undef ATT_BAR
#undef MFMA32
}

#define XB_TMO      128
#define XB_XCNT(j)  (256  + 64 * (j))
#define XB_XSUB(j)  (1280 + 64 * (j))
#define XB_XGEN(j)  (2304 + 64 * (j))
#define XB_TOP      3328
#define XB_TOPGEN   3392
#define XCD_BAR_WORDS 3456
#define XB_SPIN_CAP (1u << 18)
__device__ __forceinline__ unsigned xb_ld(unsigned* p)              { return __hip_atomic_load(p, __ATOMIC_RELAXED, __HIP_MEMORY_SCOPE_AGENT); }
__device__ __forceinline__ unsigned xb_add(unsigned* p, unsigned v) { return __hip_atomic_fetch_add(p, v, __ATOMIC_RELAXED, __HIP_MEMORY_SCOPE_AGENT); }
__device__ __forceinline__ unsigned xb_xcc_id() { return (unsigned)__builtin_amdgcn_s_getreg((3 << 11) | 20) & 0xFu; }
#define XB_SPIN(cond, bar) do { unsigned _sp = 0; while (cond) { __builtin_amdgcn_s_sleep(1); \
    if ((++_sp & 255u) == 0u) { if (xb_ld(&(bar)[XB_TMO])) break; if (_sp > XB_SPIN_CAP) { atomicAdd(&(bar)[XB_TMO], 1u); break; } } } } while (0)
struct XcdBarrier { unsigned* bar; unsigned x; volatile LAS unsigned* st; };
__device__ __forceinline__ XcdBarrier xcd_barrier_post(unsigned* bar, volatile LAS unsigned* st) {
    XcdBarrier b; b.bar = bar; b.x = xb_xcc_id(); b.st = st;
    if (threadIdx.x == 0) (void)xb_add(&bar[XB_XCNT(b.x)], 1u);
    return b;
}
__device__ __forceinline__ void xcd_barrier_complete(unsigned* bar, unsigned x, unsigned& nloc, unsigned& nx) {
    const unsigned G = gridDim.x * gridDim.y * gridDim.z;
    unsigned sum, cnt, mine, sp = 0u;
    for (;;) {
        sum = 0u; cnt = 0u; mine = 0u;
#pragma unroll
        for (unsigned j = 0; j < 16; ++j) { const unsigned c = xb_ld(&bar[XB_XCNT(j)]); sum += c; cnt += (c > 0u) ? 1u : 0u; mine = (j == x) ? c : mine; }
        if (sum == G) break;
        __builtin_amdgcn_s_sleep(1);
        if ((++sp & 255u) == 0u) { if (xb_ld(&bar[XB_TMO])) break; if (sp > XB_SPIN_CAP) { atomicAdd(&bar[XB_TMO], 1u); break; } }
    }
    nloc = mine > 0u ? mine : 1u; nx = cnt > 0u ? cnt : 1u;
}
__device__ __forceinline__ void xcd_barrier(const XcdBarrier& b) {
    asm volatile("s_waitcnt vmcnt(0)" ::: "memory");
    __syncthreads();
    if (threadIdx.x == 0) {
        unsigned* bar = b.bar;
        __builtin_amdgcn_s_waitcnt(0);
        unsigned nloc = b.st[0], nx = b.st[1];
        if (nloc == 0u) { xcd_barrier_complete(bar, b.x, nloc, nx); b.st[0] = nloc; b.st[1] = nx; }
        const unsigned old = xb_add(&bar[XB_XSUB(b.x)], 1u);
        const unsigned gen = old / nloc;
        if (old + 1u == (gen + 1u) * nloc) {
            __builtin_amdgcn_fence(__ATOMIC_RELEASE, "agent");
            asm volatile("s_waitcnt vmcnt(0)" ::: "memory");
            const unsigned og = xb_add(&bar[XB_TOP], 1u);
            const unsigned tg = og / nx;
            if (og + 1u == (tg + 1u) * nx) xb_add(&bar[XB_TOPGEN], 1u);
            else XB_SPIN(xb_ld(&bar[XB_TOPGEN]) == tg, bar);
            __builtin_amdgcn_fence(__ATOMIC_ACQUIRE, "agent");
            xb_add(&bar[XB_XGEN(b.x)], 1u);
            asm volatile("s_waitcnt vmcnt(0)" ::: "memory");
        } else {
            XB_SPIN(xb_ld(&bar[XB_XGEN(b.x)]) == gen, bar);
            __builtin_amdgcn_fence(__ATOMIC_ACQUIRE, "agent");
            asm volatile("s_waitcnt vmcnt(0)" ::: "memory");
        }
    }
    __syncthreads();
}

struct Args { const float* in[16]; float* out; unsigned char* ws; int ph_lo, ph_hi; };
struct Frame {
    LAS unsigned char* lds; volatile LAS unsigned* MISC; unsigned* ctl; unsigned char* ws;
    int tid, lane, wave, vcu, G, bx;
};

template <bool GAIN>
__device__ __forceinline__ void tr_item(const float* W, int ldw, int k0, int src_n0, bf16* WT, int ldt, int dst_r0, LAS float* scr, int lane, const float* gk = nullptr) {
#pragma unroll 8
    for (int i = 0; i < 32; ++i) { const int kk = 2 * i + (lane >> 5); float w = W[(size_t)(k0 + kk) * ldw + src_n0 + (lane & 31)]; if (GAIN) w *= gk[k0 + kk]; scr[kk * 33 + (lane & 31)] = w; }
    LDS_WAIT(); asm volatile("" ::: "memory");
    const int c = lane & 7;
#pragma unroll
    for (int j = 0; j < 4; ++j) { const int n = (lane >> 3) + 8 * j; const LAS float* sp = scr + (8 * c) * 33 + n;
        u32x4 o; o.x = cvtpk(sp[0 * 33], sp[1 * 33]); o.y = cvtpk(sp[2 * 33], sp[3 * 33]); o.z = cvtpk(sp[4 * 33], sp[5 * 33]); o.w = cvtpk(sp[6 * 33], sp[7 * 33]);
        *(u32x4*)(WT + (size_t)(dst_r0 + n) * ldt + k0 + 8 * c) = o; }
    LDS_WAIT(); asm volatile("" ::: "memory");
}
__device__ __forceinline__ void p0_prologue(const Frame& F, const Args& a) {
    LAS float* scr = (LAS float*)(F.lds + F.wave * 16384);
    const int gw = F.vcu * 8 + F.wave, NGW = F.G * 8, lane = F.lane;
    bf16* win = (bf16*)(F.ws + WS_WIN); bf16* wbr = (bf16*)(F.ws + WS_WBR); bf16* wout = (bf16*)(F.ws + WS_WOUT);
    bf16* wgu = (bf16*)(F.ws + WS_WGU); bf16* wd = (bf16*)(F.ws + WS_WD);
    constexpr int I_IN = 16 * 248, I_BD = 8 * 32, I_BS = 16 * 32, I_OUT = 16 * 32, I_G = 32 * 256, I_U = 32 * 256, I_D = 32 * 256;
    constexpr int NITEMS = I_IN + I_BD + I_BS + I_OUT + I_G + I_U + I_D;
    for (int it = gw; it < NITEMS; it += NGW) {
        int r = it;
        if (r < I_IN) { const int kb = r / 248, nb = r % 248, dr = 32 * nb; int src = dr;
            if (dr >= QKV_W) { const int o = dr - QKV_W, j = o >> 8, i = o & 255; src = (i < 128) ? QKV_W + 128 * j + i : QKV_W + 1024 + 128 * j + (i - 128); }
            tr_item<true>(a.in[2], IN_W, 64 * kb, src, win, 1024, dr, scr, lane, a.in[1]); continue; } r -= I_IN;
        if (r < I_BD) { tr_item<false>(a.in[4], 1024, 64 * (r >> 5), 32 * (r & 31), wbr + 1024, 1536, 32 * (r & 31), scr, lane); continue; } r -= I_BD;
        if (r < I_BS) { tr_item<false>(a.in[5], 1024, 64 * (r >> 5), 32 * (r & 31), wbr, 1536, 32 * (r & 31), scr, lane); continue; } r -= I_BS;
        if (r < I_OUT) { tr_item<false>(a.in[6], 1024, 64 * (r >> 5), 32 * (r & 31), wout, 1024, 32 * (r & 31), scr, lane); continue; } r -= I_OUT;
        if (r < I_G + I_U) { const int up = r >= I_G; if (up) r -= I_G; const int e = r >> 8, kb = (r >> 4) & 15, nb = r & 15;
            tr_item<true>((up ? a.in[13] : a.in[12]) + (size_t)e * 1024 * 512, 512, 64 * kb, 32 * nb, wgu, 1024, e * 1024 + 256 * (nb >> 2) + 128 * up + 32 * (nb & 3), scr, lane, a.in[7]); continue; } r -= I_G + I_U;
        { const int e = r >> 8, kb = (r >> 5) & 7, nb = r & 31;
            tr_item<false>(a.in[14] + (size_t)e * 512 * 1024, 1024, 64 * kb, 32 * nb, wd, 512, e * 1024 + 32 * nb, scr, lane); }
    }
    { float* wrt = (float*)(F.ws + WS_WRT); const float* gf = a.in[7]; const float* wg = a.in[8]; const float* wr = a.in[10];
        for (int i = F.vcu * 512 + F.tid; i < 36 * 1024; i += F.G * 512) { const int e = i >> 10, k = i & 1023; wrt[i] = gf[k] * (e < 4 ? wg[k * 4 + e] : wr[k * 32 + e - 4]); } }
    { const float* x = a.in[0]; bf16* H = (bf16*)(F.ws + WS_H); float* rms1 = (float*)(F.ws + WS_RMS1);
        f32x4 vnx[4];
        if (gw < NTOK) { const f32x4* xr0 = (const f32x4*)(x + (size_t)gw * 1024) + lane;
#pragma unroll
            for (int j = 0; j < 4; ++j) vnx[j] = xr0[64 * j]; }
        for (int row = gw; row < NTOK; row += NGW) {
            f32x4 v[4]; float ss = 0.f;
#pragma unroll
            for (int j = 0; j < 4; ++j) v[j] = vnx[j];
            if (row + NGW < NTOK) { const f32x4* xrn = (const f32x4*)(x + (size_t)(row + NGW) * 1024) + lane;
#pragma unroll
                for (int j = 0; j < 4; ++j) vnx[j] = xrn[64 * j]; }
#pragma unroll
            for (int j = 0; j < 4; ++j) ss += (v[j].x * v[j].x + v[j].y * v[j].y) + (v[j].z * v[j].z + v[j].w * v[j].w);
            const float rms = sqrtf(wave_sum(ss) * (1.f / 1024.f) + RMS_EPS), rstd = 1.f / rms;
            if (lane == 0) rms1[row] = rms;
            u32x2* o = (u32x2*)(H + (size_t)row * 1024) + lane;
#pragma unroll
            for (int j = 0; j < 4; ++j) { const f32x4 t = v[j] * rstd; u32x2 p; p.x = cvtpk(t.x, t.y); p.y = cvtpk(t.z, t.w); o[64 * j] = p; }
        }
    }
}

#ifndef ATT_REVERSE
#define ATT_REVERSE 1
#endif
#ifndef SWA_NH
#define SWA_NH 8
#endif
constexpr int ATT_NSWA = 2 * 32 * (8 / SWA_NH), ATT_UPB = ATT_NSWA + 24 * 32;
__device__ __forceinline__ void attn_make_unit(const Frame& F, const int gi, att::UnitDesc& U) {
    const bf16* qkv = (const bf16*)(F.ws + WS_QKV);
    const int gr = ATT_REVERSE ? (NB * ATT_UPB - 1 - gi) : gi;
    const int b = gr / ATT_UPB, ui = gr - b * ATT_UPB;
    if (ui < ATT_NSWA) {
        const int grp = ui % (8 / SWA_NH), blkq = (ui / (8 / SWA_NH)) & 31, kvh = ui / (32 * (8 / SWA_NH)), head0 = kvh * 8 + grp * SWA_NH;
        U.rb = qkv + (size_t)(b * T + 256 * blkq) * 64;
        U.qcol = COL_QS / 64 + head0; U.kcol = COL_KS / 64 + kvh; U.vcol = COL_VS / 64 + kvh;
        U.has_prev = blkq != 0; U.nh = SWA_NH; U.mixer = 1; U.head0 = head0; U.dil = 1; U.ltok0 = 0; U.lstride = 0;
    } else {
        const int au = ui - ATT_NSWA, blkq = au & 31, head = au >> 5, sh = 2 * (head >> 3), L = T >> sh;
        const int prow = 256 * blkq, r = prow >> (13 - sh), u0 = prow & (L - 1);
        U.rb = qkv + (size_t)(b * T + prow) * 64;
        U.qcol = head; U.kcol = COL_KD / 64 + head; U.vcol = COL_VD / 64 + head;
        U.has_prev = u0 != 0; U.nh = 1; U.mixer = 0; U.head0 = head; U.dil = 1 << sh;
        U.ltok0 = b * T + (u0 << sh) + r; U.lstride = 1 << sh;
    }
}
__device__ __forceinline__ void attn_phase(const Frame& F, const float* sinks) {
    int gi = F.vcu;
    if (gi >= NB * ATT_UPB) return;
    att::UnitDesc U, Un; bf16x8 qn[4]; unsigned pt[6] = {0u, 0u, 0u, 0u, 0u, 0u};
    attn_make_unit(F, gi, U);
    { const int w = F.wave, lane = F.lane;
      att::dma_image<false>(F.lds + att::LDS_K, U.rb + (size_t)U.kcol * TS, w, lane, U.has_prev != 0);
      att::dma_image<true>(F.lds + att::LDS_V, U.rb + (size_t)U.vcol * TS, w, lane, U.has_prev != 0);
      const bf16* qrow = U.rb + (size_t)U.qcol * TS + (32 * w + (lane & 31)) * 64 + 8 * (lane >> 5);
#pragma unroll
      for (int kk = 0; kk < 4; ++kk) qn[kk] = *(const bf16x8*)(qrow + 16 * kk); }
    int vpar = 0;
    for (;;) {
        const bool has_next = gi + F.G < NB * ATT_UPB;
        attn_make_unit(F, has_next ? gi + F.G : gi, Un);
        att::attn_unit(F.lds, F.tid, U, sinks, (float*)(F.ws + WS_LSE), has_next, Un, qn, vpar, pt);
        if (!has_next) break;
        gi += F.G; U = Un; vpar ^= 1;
    }
    asm volatile("s_waitcnt vmcnt(0)" ::: "memory");
    __syncthreads();
    if (PROBE_T >= 40 && F.vcu == 5 && F.tid == 0) { for (int i = 0; i < 6; ++i) F.ctl[20040 + i] = pt[i]; }
}
__device__ __forceinline__ void merge_phase(const Frame& F) {
    bf16* qkv = (bf16*)(F.ws + WS_QKV); const float* lse = (const float*)(F.ws + WS_LSE);
    for (int it = F.vcu * 512 + F.tid; it < NTOK * 64; it += F.G * 512) {
        const int dc = it & 7, hs = (it >> 3) & 7, t = it >> 6, tb = t & ~(T - 1), tl = t & (T - 1);
        const float l0 = lse[(size_t)t * 24 + hs], l1 = lse[(size_t)t * 24 + 8 + hs], l2 = lse[(size_t)t * 24 + 16 + hs];
        const float mx = fmaxf(l0, fmaxf(l1, l2));
        float w0 = __expf(l0 - mx), w1 = __expf(l1 - mx), w2 = __expf(l2 - mx); const float inv = 1.f / (w0 + w1 + w2); w0 *= inv; w1 *= inv; w2 *= inv;
        const int r1 = tb | ((tl & 3) << 11) | (tl >> 2), r2 = tb | ((tl & 15) << 9) | (tl >> 4);
        f32x4 a0, b0, a1, b1, a2, b2;
        unpack8(*(const u32x4*)(qkv + (size_t)hs * TS + (size_t)t * 64 + dc * 8), a0, b0);
        unpack8(*(const u32x4*)(qkv + (size_t)(8 + hs) * TS + (size_t)r1 * 64 + dc * 8), a1, b1);
        unpack8(*(const u32x4*)(qkv + (size_t)(16 + hs) * TS + (size_t)r2 * 64 + dc * 8), a2, b2);
        *(u32x4*)(qkv + (size_t)(COL_YDIL / 64 + hs) * TS + (size_t)t * 64 + dc * 8) = pack8(a0 * w0 + a1 * w1 + a2 * w2, b0 * w0 + b1 * w1 + b2 * w2);
    }
}
__device__ __forceinline__ float dot4(const f32x4 a, const f32x4 b) { return (a.x * b.x + a.y * b.y) + (a.z * b.z + a.w * b.w); }
struct RouteCtx { const LAS f32x4* WL; volatile LAS unsigned* cnt; volatile LAS unsigned* rec; float* rstd2; float* rw; const float* bg; const float* br; int lane; };
__device__ __forceinline__ void route_row(const RouteCtx& C, const f32x4 (&v)[4], const int row, const int lt) {
    float ss = 0.f;
#pragma unroll
    for (int j = 0; j < 4; ++j) ss += dot4(v[j], v[j]);
    const float rstd = 1.f / sqrtf(wave_sum(ss) * (1.f / 1024.f) + RMS_EPS);
    float gl[4];
#pragma unroll
    for (int e = 0; e < 4; ++e) { float p = 0.f;
#pragma unroll
        for (int j = 0; j < 4; ++j) p += dot4(v[j], C.WL[e * 256 + 64 * j]);
        gl[e] = wave_sum(p) * rstd + C.bg[e]; }
    int gt = 0; float gm = gl[0];
#pragma unroll
    for (int e = 1; e < 4; ++e) if (gl[e] > gm) { gm = gl[e]; gt = e; }
    float gz = 0.f;
#pragma unroll
    for (int e = 0; e < 4; ++e) gz += __expf(gl[e] - gm);
    const float gwt = 1.f / gz;
    gt = __builtin_amdgcn_readfirstlane(gt);
    float el[8];
#pragma unroll
    for (int e = 0; e < 8; ++e) { float p = 0.f;
#pragma unroll
        for (int j = 0; j < 4; ++j) p += dot4(v[j], C.WL[(4 + 8 * gt + e) * 256 + 64 * j]);
        el[e] = wave_sum(p) * rstd + C.br[8 * gt + e]; }
    int i0 = 0; float m0 = el[0];
#pragma unroll
    for (int e = 1; e < 8; ++e) if (el[e] > m0) { m0 = el[e]; i0 = e; }
    int i1 = -1; float m1 = -INFINITY;
#pragma unroll
    for (int e = 0; e < 8; ++e) if (e != i0 && el[e] > m1) { m1 = el[e]; i1 = e; }
    if (i1 < 0) i1 = (i0 == 0) ? 1 : 0;
    const float ed = __expf(m1 - m0), w0 = 1.f / (1.f + ed), w1 = ed * w0;
    if (C.lane == 0) {
        const unsigned E0 = (unsigned)(8 * gt + i0), E1 = (unsigned)(8 * gt + i1);
        const unsigned r0 = __hip_atomic_fetch_add((LAS unsigned*)&C.cnt[E0], 1u, __ATOMIC_RELAXED, __HIP_MEMORY_SCOPE_WORKGROUP);
        const unsigned r1 = __hip_atomic_fetch_add((LAS unsigned*)&C.cnt[E1], 1u, __ATOMIC_RELAXED, __HIP_MEMORY_SCOPE_WORKGROUP);
        C.rec[lt] = E0 | (E1 << 5) | (r0 << 10) | (r1 << 20);
        C.rw[2 * row] = gwt * w0; C.rw[2 * row + 1] = gwt * w1; C.rstd2[row] = rstd;
    }
}
__device__ __forceinline__ void router_phase(const Frame& F, const bf16* x1, const float* gf, const float* bg, const float* br) {
    const int lane = F.lane, tid = F.tid;
    { const f32x4* src = (const f32x4*)(F.ws + WS_WRT); LAS f32x4* dst = (LAS f32x4*)F.lds;
        for (int i = tid; i < 36 * 256; i += 512) dst[i] = src[i]; }
    volatile LAS unsigned* cnt = (volatile LAS unsigned*)(F.lds + P5_CNT_OFF); volatile LAS unsigned* basew = (volatile LAS unsigned*)(F.lds + P5_BASE_OFF);
    volatile LAS unsigned* rec = (volatile LAS unsigned*)(F.lds + P5_REC_OFF);
    if (tid < 32) cnt[tid] = 0u;
    __syncthreads();
    const int RPW = NTOK / F.G, row0 = F.vcu * RPW;
    RouteCtx C{(const LAS f32x4*)F.lds + lane, cnt, rec, (float*)(F.ws + WS_RSTD2), (float*)(F.ws + WS_RW), bg, br, lane};
    u32x2 va[4], vb[4], vc[4];
#define RT_LOAD(buf, l) do { if ((l) < RPW) { const u32x2* _x = (const u32x2*)(x1 + (size_t)(row0 + (l)) * 1024) + lane; _Pragma("unroll") for (int j = 0; j < 4; ++j) buf[j] = _x[64 * j]; } } while (0)
#define RT_CVT(buf) (f32x4){bf_lo(buf[j].x), bf_hi(buf[j].x), bf_lo(buf[j].y), bf_hi(buf[j].y)}
    RT_LOAD(va, F.wave); RT_LOAD(vb, F.wave + 8); RT_LOAD(vc, F.wave + 16);
    for (int lt = F.wave; lt < RPW; lt += 24) {
        { f32x4 v[4];
#pragma unroll
          for (int j = 0; j < 4; ++j) v[j] = RT_CVT(va);
          RT_LOAD(va, lt + 24); route_row(C, v, row0 + lt, lt); }
        if (lt + 8 < RPW) { f32x4 v[4];
#pragma unroll
          for (int j = 0; j < 4; ++j) v[j] = RT_CVT(vb);
          RT_LOAD(vb, lt + 32); route_row(C, v, row0 + lt + 8, lt + 8); }
        if (lt + 16 < RPW) { f32x4 v[4];
#pragma unroll
          for (int j = 0; j < 4; ++j) v[j] = RT_CVT(vc);
          RT_LOAD(vc, lt + 40); route_row(C, v, row0 + lt + 16, lt + 16); }
    }
#undef RT_LOAD
#undef RT_CVT
    __syncthreads();
    if (tid < 32) basew[tid] = __hip_atomic_fetch_add(F.ctl + CW_CNT + 64 * tid, cnt[tid], RLX_AGENT);
    __syncthreads();
    unsigned* re = (unsigned*)(F.ws + WS_RE); unsigned* rrel = (unsigned*)(F.ws + WS_RREL);
    for (int lt = tid; lt < RPW; lt += 512) { const unsigned rc = rec[lt], E0 = rc & 31u, E1 = (rc >> 5) & 31u; const int row = row0 + lt;
        re[row] = E0 | (E1 << 8); rrel[2 * row] = basew[E0] + ((rc >> 10) & 1023u); rrel[2 * row + 1] = basew[E1] + ((rc >> 20) & 1023u); }
}
__device__ __forceinline__ void slots_phase(const Frame& F) {
    volatile LAS unsigned* cnt = (volatile LAS unsigned*)F.lds; volatile LAS unsigned* off = cnt + 32;
    if (F.tid < 32) cnt[F.tid] = ld_agent(F.ctl + CW_CNT + 64 * F.tid);
    __syncthreads();
    if (F.tid == 0) { unsigned o = 0; for (int e = 0; e < 32; ++e) { off[e] = o; o += (cnt[e] + 255u) & ~255u; } off[32] = o; }
    __syncthreads();
    const int RPW = NTOK / F.G, row0 = F.vcu * RPW;
    const unsigned* re = (const unsigned*)(F.ws + WS_RE); const unsigned* rrel = (const unsigned*)(F.ws + WS_RREL); const float* rw = (const float*)(F.ws + WS_RW);
    unsigned* tos = (unsigned*)(F.ws + WS_TOS); float* wos = (float*)(F.ws + WS_WOS); float* rss = (float*)(F.ws + WS_RSS); const float* rstd2 = (const float*)(F.ws + WS_RSTD2); unsigned* sot = (unsigned*)(F.ws + WS_SOT); unsigned* pex = (unsigned*)(F.ws + WS_PEX);
    for (int lt = F.tid; lt < RPW; lt += 512) { const int row = row0 + lt; const unsigned ev = re[row], e0 = ev & 255u, e1 = ev >> 8;
        const unsigned s0 = off[e0] + rrel[2 * row], s1 = off[e1] + rrel[2 * row + 1];
        tos[s0] = (unsigned)row; tos[s1] = (unsigned)row; wos[s0] = rw[2 * row]; wos[s1] = rw[2 * row + 1]; { const float r2 = rstd2[row]; rss[s0] = r2; rss[s1] = r2; } sot[2 * row] = s0; sot[2 * row + 1] = s1; }
    for (int e = F.vcu; e < 32; e += F.G) { const unsigned c = cnt[e], pad = ((c + 255u) & ~255u) - c;
        for (unsigned i = F.tid; i < pad; i += 512) { tos[off[e] + c + i] = 0u; wos[off[e] + c + i] = 0.f; rss[off[e] + c + i] = 0.f; } }
    if (F.vcu == F.G - 1) { const unsigned np = off[32] >> 8;
        for (unsigned p = F.tid; p < np; p += 512) { unsigned e = 0; for (unsigned k = 0; k < 32; ++k) if (off[k] <= 256u * p && 256u * p < off[k + 1]) e = k; pex[p] = e; }
        if (F.tid == 0) pex[1023] = np; }
    __syncthreads();
}
__device__ __forceinline__ void final_phase(const Frame& F, float* out, const float* gfin) {
    const bf16* x1b = (const bf16*)(F.ws + WS_X1B);
    const int lane = F.lane, gw = F.vcu * 8 + F.wave, NGW = F.G * 8;
    const unsigned* sot = (const unsigned*)(F.ws + WS_SOT); const bf16* ys = (const bf16*)(F.ws + WS_YS);
    f32x4 gv[4];
#pragma unroll
    for (int j = 0; j < 4; ++j) gv[j] = *(const f32x4*)(gfin + 4 * lane + 256 * j);
    u32x2 xn[4], y0n[4], y1n[4];
#define FIN_LOAD(r) do { const unsigned _s0 = sot[2 * (r)], _s1 = sot[2 * (r) + 1]; const u32x2* _x = (const u32x2*)(x1b + (size_t)(r) * 1024) + lane; \
        const u32x2* _y0 = (const u32x2*)(ys + (size_t)_s0 * 1024) + lane; const u32x2* _y1 = (const u32x2*)(ys + (size_t)_s1 * 1024) + lane; \
        _Pragma("unroll") for (int j = 0; j < 4; ++j) { xn[j] = _x[64 * j]; y0n[j] = _y0[64 * j]; y1n[j] = _y1[64 * j]; } } while (0)
    if (gw < NTOK) FIN_LOAD(gw);
    for (int row = gw; row < NTOK; row += NGW) {
        f32x4* xr = (f32x4*)(out + (size_t)row * 1024) + lane;
        f32x4 v[4]; float ss = 0.f;
#pragma unroll
        for (int j = 0; j < 4; ++j) { const u32x2 p = y0n[j], q = y1n[j], xw = xn[j];
            v[j] = (f32x4){bf_lo(xw.x), bf_hi(xw.x), bf_lo(xw.y), bf_hi(xw.y)} + (f32x4){bf_lo(p.x), bf_hi(p.x), bf_lo(p.y), bf_hi(p.y)} + (f32x4){bf_lo(q.x), bf_hi(q.x), bf_lo(q.y), bf_hi(q.y)}; ss += dot4(v[j], v[j]); }
        if (row + NGW < NTOK) FIN_LOAD(row + NGW);
        const float rstd = 1.f / sqrtf(wave_sum(ss) * (1.f / 1024.f) + RMS_EPS);
#pragma unroll
        for (int j = 0; j < 4; ++j) xr[64 * j] = v[j] * rstd * gv[j];
    }
#undef FIN_LOAD
}

__device__ __forceinline__ void stagger_delay(unsigned ticks) {
    if (ticks == 0u) return;
    const unsigned long long t0 = __builtin_amdgcn_s_memrealtime();
    while ((unsigned long long)__builtin_amdgcn_s_memrealtime() - t0 < (unsigned long long)ticks) __builtin_amdgcn_s_sleep(16);
}
#ifndef GEMM1_WGM
#define GEMM1_WGM 4
#endif
#ifndef STAG5
#define STAG5 400
#endif
#ifndef STAG1
#define STAG1 0
#endif
constexpr int N_PHASES = 10;
constexpr int KA_OUT = 128, KA_WS = 136, KA_LO = 144, KA_HI = 148;
#if defined(__HIP_DEVICE_COMPILE__)
__device__ __forceinline__ unsigned long long karg64(int off) { auto k = __builtin_amdgcn_kernarg_segment_ptr(); unsigned long long v;
    asm volatile("s_load_dwordx2 %0, %1, %2\n\ts_waitcnt lgkmcnt(0)" : "=s"(v) : "s"(k), "i"(off)); return v; }
__device__ __forceinline__ int karg32(int off) { auto k = __builtin_amdgcn_kernarg_segment_ptr(); int v;
    asm volatile("s_load_dword %0, %1, %2\n\ts_waitcnt lgkmcnt(0)" : "=s"(v) : "s"(k), "i"(off)); return v; }
#else
__device__ __forceinline__ unsigned long long karg64(int) { return 0ull; }
__device__ __forceinline__ int karg32(int) { return 0; }
#endif
#define KIN(i) ((const float*)(const GAS float*)karg64(8 * (i)))
#define KPTR(T, off) ((T*)(GAS T*)karg64(off))
__device__ __forceinline__ Frame make_frame(int wv) {
    extern __shared__ __attribute__((aligned(16))) unsigned char lds_raw[];
    Frame F; int bx = blockIdx.x, G = gridDim.x;
    asm volatile("" : "+s"(bx), "+s"(G), "+s"(wv));
    int tid = wv * 64 + (int)__builtin_amdgcn_mbcnt_hi(~0u, __builtin_amdgcn_mbcnt_lo(~0u, 0u));
    asm volatile("" : "+v"(tid));
    F.lds = (LAS unsigned char*)lds_raw; F.MISC = (volatile LAS unsigned*)(F.lds + MISC_OFF);
    F.tid = tid; F.lane = tid & 63; F.wave = __builtin_amdgcn_readfirstlane(tid >> 6);
    F.G = G; F.bx = bx; F.vcu = (G % 8 == 0) ? (bx % 8) * (G / 8) + bx / 8 : bx;
    F.ws = KPTR(unsigned char, KA_WS); F.ctl = (unsigned*)(F.ws + WS_CTL);
    return F;
}
__global__ void __launch_bounds__(512, 2) mk_fwd(Args args_unused) {
    const int wv = __builtin_amdgcn_readfirstlane((int)threadIdx.x >> 6);
    { Frame F = make_frame(wv); if (F.tid < 64) F.MISC[F.tid] = 0u; __syncthreads();
      if (MK_ONE_LAUNCH) (void)xcd_barrier_post(F.ctl + CW_BAR, F.MISC + 8); }
    const int lo = karg32(KA_LO), hi = karg32(KA_HI);
    if (PROBE_T >= 20) { Frame Fp = make_frame(wv); if (Fp.vcu == 5 && Fp.tid == 0) Fp.ctl[20020] = (unsigned)__builtin_amdgcn_s_memrealtime(); }
#define IN(k) (lo <= (k) && (k) < hi)
#define SEAM(k) do { if (IN(k) && IN((k) + 1)) { Frame Fb = make_frame(wv); XcdBarrier bar; bar.bar = Fb.ctl + CW_BAR; bar.x = xb_xcc_id(); bar.st = Fb.MISC + 8; xcd_barrier(bar); \
        if (PROBE_T >= 20 && Fb.vcu == 5 && Fb.tid == 0) Fb.ctl[20021 + (k)] = (unsigned)__builtin_amdgcn_s_memrealtime(); } } while (0)
#define GBAR() do { Frame Fb = make_frame(wv); XcdBarrier bar; bar.bar = Fb.ctl + CW_BAR; bar.x = xb_xcc_id(); bar.st = Fb.MISC + 8; xcd_barrier(bar); } while (0)
#define REP(k) for (int rep_ = 0; rep_ < (PROBE_DUP == (k) ? 2 : 1); ++rep_)
#define REPBAR(k) do { if (PROBE_DUP == (k) && rep_ == 0) GBAR(); } while (0)
    if (IN(0)) REP(7) { Frame F = make_frame(wv); Args a{}; for (int i = 0; i < 16; ++i) a.in[i] = KIN(i); p0_prologue(F, a); REPBAR(7); } SEAM(0);
    if (IN(1)) REP(1) {
        Frame F = make_frame(wv); bf16* gates = (bf16*)KPTR(float, KA_OUT);
        pg8::Gemm g{(const bf16*)(F.ws + WS_H), nullptr, (const bf16*)(F.ws + WS_WIN), nullptr, 2048, 2048, 16, 16, 128}; pg8::StaticOrder<false, PROBE_DUP == 9> S; S.init(NTOK, IN_W, F.G, F.bx, GEMM1_WGM);
        Epi1 E{(bf16*)(F.ws + WS_QKV), gates, gates + (size_t)NTOK * 1024, (PROBE_T && (F.vcu == 5 || PROBE_T >= 8)) ? (unsigned*)(F.ctl + 20000) : nullptr};
        stagger_delay(xb_xcc_id() * (unsigned)STAG1);
        pg8::gemm_phase<Epi1, pg8::StaticOrder<false, PROBE_DUP == 9>, false>(F.lds, F.tid, g, S, E, nullptr);
        REPBAR(1);
    }
    SEAM(1);
    if (IN(2)) REP(2) { Frame F = make_frame(wv); attn_phase(F, KIN(3)); REPBAR(2); }
    SEAM(2);
    if (IN(3)) REP(8) { Frame F = make_frame(wv); merge_phase(F); REPBAR(8); }
    SEAM(3);
    if (IN(4)) REP(3) {
        Frame F = make_frame(wv); const bf16* gates = (const bf16*)KPTR(float, KA_OUT); const bf16* qkv = (const bf16*)(F.ws + WS_QKV); const bf16* wbr = (const bf16*)(F.ws + WS_WBR);
        pg8::Gemm g{qkv + (COL_QS / 64) * TS, qkv + (COL_YDIL / 64) * TS, wbr, wbr + 1024, 128, 1536 * 2, 16, 8, TS * 2}; pg8::StaticOrder<true> S; S.init(NTOK, 1024, F.G, F.bx);
        EpiMix E{gates, gates + (size_t)NTOK * 1024, (bf16*)(F.ws + WS_QKV) + (COL_MIX / 64) * TS, (PROBE_T && F.vcu == 5) ? (unsigned*)(F.ctl + 20000) : nullptr};
        pg8::gemm_phase<EpiMix, pg8::StaticOrder<true>, false>(F.lds, F.tid, g, S, E, nullptr);
        REPBAR(3);
    }
    SEAM(4);
    if (IN(5)) REP(4) {
        Frame F = make_frame(wv);
        pg8::Gemm g{(const bf16*)(F.ws + WS_QKV) + (COL_MIX / 64) * TS, nullptr, (const bf16*)(F.ws + WS_WOUT), nullptr, 128, 2048, 16, 16, TS * 2}; pg8::StaticOrder<false> S; S.init(NTOK, 1024, F.G, F.bx, pg8::WGM, true);
        EpiRes E{(const bf16*)(F.ws + WS_H), (const float*)(F.ws + WS_RMS1), (bf16*)(F.ws + WS_X1B), (PROBE_T && F.vcu == 5) ? (unsigned*)(F.ctl + 20000) : nullptr};
        pg8::gemm_phase<EpiRes, pg8::StaticOrder<false>, false>(F.lds, F.tid, g, S, E, nullptr);
        REPBAR(4);
    }
    SEAM(5);
    if (IN(6)) { Frame F = make_frame(wv); router_phase(F, (const bf16*)(F.ws + WS_X1B), KIN(7), KIN(9), KIN(11)); }
    SEAM(6);
    if (IN(7)) { Frame F = make_frame(wv); slots_phase(F); }
    SEAM(7);
    if (IN(8)) REP(5) {
        Frame F = make_frame(wv);
        pg8::Gemm g{(const bf16*)(F.ws + WS_X1B), nullptr, (const bf16*)(F.ws + WS_WGU), nullptr, 2048, 2048, 16, 16, 128}; pg8::PanelOrder S; S.init((const unsigned*)(F.ws + WS_PEX), (volatile LAS int*)(F.lds + PANEL_TAB_OFF), F.G, F.vcu, F.tid);
        EpiGU E{(bf16*)(F.ws + WS_ACT), (const float*)(F.ws + WS_RSS)};
        pg8::gemm_phase<EpiGU, pg8::PanelOrder, true>(F.lds, F.tid, g, S, E, (const unsigned*)(F.ws + WS_TOS));
        REPBAR(5);
    }
    SEAM(8);
    if (IN(9)) REP(6) {
        Frame F = make_frame(wv);
        pg8::Gemm g{(const bf16*)(F.ws + WS_ACT), nullptr, (const bf16*)(F.ws + WS_WD), nullptr, 1024, 1024, 8, 8, 128}; pg8::PanelOrder S; S.init((const unsigned*)(F.ws + WS_PEX), (volatile LAS int*)(F.lds + PANEL_TAB_OFF), F.G, F.vcu, F.tid);
        S.rev = true;
        EpiDown E{(bf16*)(F.ws + WS_YS), (const float*)(F.ws + WS_WOS), (PROBE_T && F.vcu == 5) ? (unsigned*)(F.ctl + 20000) : nullptr};
        pg8::gemm_phase<EpiDown, pg8::PanelOrder, false>(F.lds, F.tid, g, S, E, nullptr);
        REPBAR(6);
    }
    SEAM(9);
    if (IN(10)) { Frame F = make_frame(wv); final_phase(F, KPTR(float, KA_OUT), KIN(15)); }
#if PROBE_T
    { Frame F = make_frame(wv);
      if (F.vcu == 5) { const unsigned kl = ld_agent(F.ctl + 20001), ep = ld_agent(F.ctl + 20002), cyc = ld_agent(F.ctl + 20003), tk = ld_agent(F.ctl + 20004);
        unsigned d = 0;
        if (PROBE_T == 5) d = (unsigned)((float)cyc / (float)tk * 100.f * 25.f);
        if (PROBE_T == 6) d = ep * 2u;
        if (PROBE_T == 7) d = kl;
        if (PROBE_T >= 20 && PROBE_T < 40) { const unsigned t1 = (PROBE_T - 20 == 10) ? (unsigned)__builtin_amdgcn_s_memrealtime() : ld_agent(F.ctl + 20021 + (PROBE_T - 20)); d = t1 - ld_agent(F.ctl + 20020 + (PROBE_T - 20)); }
        if (PROBE_T >= 40 && PROBE_T < 46) d = 4u * ld_agent(F.ctl + 20040 + (PROBE_T - 40));
        if (PROBE_T == 8) d = ld_agent(F.ctl + 20010);
        if (PROBE_T == 9) d = 0x7fffffffu - ld_agent(F.ctl + 20011);
        stagger_delay(d > 200000u ? 200000u : d); } }
#endif
#undef IN
#undef SEAM
}

extern "C" void kernel_launch(void* const* d_in, const int* in_sizes, int n_in, void* d_out, int out_size, void* d_ws, size_t ws_size, hipStream_t stream) {
    static int grid = 0;
    if (grid == 0) {
        if (n_in != 16 || in_sizes[0] != NTOK * D || out_size != NTOK * D || ws_size < WS_END) { fprintf(stderr, "kernel_launch: unexpected shapes / workspace (%d inputs, ws %zu)\n", n_in, ws_size); grid = -1; return; }
        int dev = 0, cus = 0;
        if (hipGetDevice(&dev) != hipSuccess || hipDeviceGetAttribute(&cus, hipDeviceAttributeMultiprocessorCount, dev) != hipSuccess) { grid = -1; return; }
        if (hipFuncSetAttribute((const void*)mk_fwd, hipFuncAttributeMaxDynamicSharedMemorySize, LDS_BYTES) != hipSuccess) { fprintf(stderr, "kernel_launch: hipFuncSetAttribute(%d) failed\n", LDS_BYTES); grid = -1; return; }
        int per_cu = 0;
        if (hipOccupancyMaxActiveBlocksPerMultiprocessor(&per_cu, (const void*)mk_fwd, 512, LDS_BYTES) != hipSuccess || per_cu < 1) { fprintf(stderr, "kernel_launch: occupancy query says %d\n", per_cu); }
        (void)hipGetLastError();
        int g = 64; while (g * 2 <= cus && g * 2 <= 1024) g *= 2;
        grid = g;
    }
    if (grid < 0) return;
    (void)hipMemsetAsync((char*)d_ws + WS_CTL, 0, CTL_ZERO_BYTES, stream);
    Args a{};
    for (int i = 0; i < 16; ++i) a.in[i] = (const float*)d_in[i];
    a.out = (float*)d_out; a.ws = (unsigned char*)d_ws;
#if MK_ONE_LAUNCH
    a.ph_lo = 0; a.ph_hi = N_PHASES + 1;
    hipLaunchKernelGGL(mk_fwd, dim3(grid), dim3(512), LDS_BYTES, stream, a);
#else
    for (int p = 0; p <= N_PHASES; ++p) { a.ph_lo = p; a.ph_hi = p + 1; hipLaunchKernelGGL(mk_fwd, dim3(grid), dim3(512), LDS_BYTES, stream, a); }
#endif
}
```

```cpp
#include <hip/hip_runtime.h>
#include <cstdio>
#include <cstdint>

#ifndef PROBE_T
#define PROBE_T 0
#endif
#ifndef PROBE_EPI
#define PROBE_EPI 1
#endif
#ifndef PROBE_DUP
#define PROBE_DUP 0
#endif
#ifndef MK_ONE_LAUNCH
#define MK_ONE_LAUNCH 1
#endif

#define LAS __attribute__((address_space(3)))
#define GAS __attribute__((address_space(1)))
typedef unsigned short bf16;
typedef short bf16x8 __attribute__((ext_vector_type(8)));
typedef short s16x4 __attribute__((ext_vector_type(4)));
typedef float f32x4 __attribute__((ext_vector_type(4)));
typedef float f32x16 __attribute__((ext_vector_type(16)));
typedef unsigned u32x4 __attribute__((ext_vector_type(4)));
typedef unsigned u32x2 __attribute__((ext_vector_type(2)));
typedef float f32x2_t __attribute__((ext_vector_type(2)));
typedef __bf16 bf16x2_t __attribute__((ext_vector_type(2)));
typedef GAS unsigned gu32;

constexpr int NB = 8, T = 8192, D = 1024, NTOK = NB * T;
constexpr int QKV_W = 5888;
constexpr int IN_W = 7936;
constexpr int COL_KD = 1536, COL_VD = 3072, COL_QS = 4608, COL_KS = 5632, COL_VS = 5760;
constexpr int NEXP = 32, DEXP = 512;
constexpr int SLOT_ROWS = 2 * NTOK + NEXP * 256;
constexpr int MAX_PANELS = SLOT_ROWS / 256;
constexpr float RMS_EPS = 1e-6f;
constexpr float LOG2E = 1.4426950408889634f, LN2 = 0.6931471805599453f;
constexpr float QSCALE = 0.125f * LOG2E;

constexpr size_t MiB = 1u << 20;
constexpr size_t WS_CTL = 0, CTL_ZERO_BYTES = 128 * 1024;
constexpr size_t WS_WIN = 1 * MiB;
constexpr size_t WS_WBR = 17 * MiB;
constexpr size_t WS_WOUT = 20 * MiB;
constexpr size_t WS_WGU = 22 * MiB;
constexpr size_t WS_WD = 86 * MiB;
constexpr size_t WS_WRT = 118 * MiB;
constexpr size_t WS_RE = 119 * MiB;
constexpr size_t WS_RREL = WS_RE + 256 * 1024;
constexpr size_t WS_RW = WS_RREL + 512 * 1024;
constexpr size_t WS_RMS1 = WS_RW + 512 * 1024;
constexpr size_t WS_RSTD2 = WS_RMS1 + 256 * 1024;
constexpr size_t WS_RSS = 125 * MiB;
constexpr size_t WS_TOS = 121 * MiB;
constexpr size_t WS_WOS = 122 * MiB;
constexpr size_t WS_SOT = 123 * MiB;
constexpr size_t WS_PEX = 124 * MiB;
constexpr size_t WS_H = 128 * MiB;
constexpr size_t WS_QKV = 256 * MiB;
constexpr size_t WS_LSE = 992 * MiB;
constexpr size_t WS_ACT = 256 * MiB;
constexpr size_t WS_YS = 392 * MiB;
constexpr size_t WS_X1B = 672 * MiB;
constexpr size_t WS_END = 1000 * MiB;
constexpr int COL_YDIL = 1536, COL_MIX = 0;
constexpr size_t TS = (size_t)NTOK * 64;
static_assert(WS_QKV + (size_t)NTOK * QKV_W * 2 <= WS_LSE && WS_LSE + (size_t)NTOK * 24 * 4 <= WS_END, "qkv/lse map");
static_assert(WS_ACT + (size_t)SLOT_ROWS * 512 * 2 <= WS_YS && WS_YS + (size_t)SLOT_ROWS * 1024 * 2 <= WS_LSE, "moe overlay");
constexpr int CW_BAR = 4096;
constexpr int CW_CNT = 8192;

constexpr int LDS_BYTES = 155648;
constexpr int MISC_OFF = LDS_BYTES - 256;
constexpr int PANEL_TAB_OFF = 131072 + 1024;
constexpr int P5_CNT_OFF = 147456, P5_BASE_OFF = P5_CNT_OFF + 128, P5_REC_OFF = P5_BASE_OFF + 128;

#define RLX_AGENT __ATOMIC_RELAXED, __HIP_MEMORY_SCOPE_AGENT
#define LDS_WAIT() asm volatile("s_waitcnt lgkmcnt(0)" ::: "memory")
__device__ __forceinline__ unsigned cvtpk(float lo, float hi) { f32x2_t v = {lo, hi}; bf16x2_t b = __builtin_convertvector(v, bf16x2_t); return __builtin_bit_cast(unsigned, b); }
__device__ __forceinline__ float bf_lo(unsigned u) { return __builtin_bit_cast(float, u << 16); }
__device__ __forceinline__ float bf_hi(unsigned u) { return __builtin_bit_cast(float, u & 0xffff0000u); }
__device__ __forceinline__ unsigned ld_agent(const unsigned* p) { return __hip_atomic_load(p, RLX_AGENT); }
template <int CTRL> __device__ __forceinline__ float dpp(float x) { return __builtin_bit_cast(float, __builtin_amdgcn_mov_dpp(__builtin_bit_cast(int, x), CTRL, 0xf, 0xf, true)); }
__device__ __forceinline__ float wave_sum(float v) {
    v += dpp<0xB1>(v); v += dpp<0x4E>(v); v += dpp<0x141>(v); v += dpp<0x140>(v);
    const int iv = __builtin_bit_cast(int, v);
    const float r0 = __builtin_bit_cast(float, __builtin_amdgcn_readlane(iv, 0)), r1 = __builtin_bit_cast(float, __builtin_amdgcn_readlane(iv, 16));
    const float r2 = __builtin_bit_cast(float, __builtin_amdgcn_readlane(iv, 32)), r3 = __builtin_bit_cast(float, __builtin_amdgcn_readlane(iv, 48));
    return (r0 + r1) + (r2 + r3);
}

namespace pg8 {
constexpr int BM = 256, BK = 64, HALF = 128, HTB = HALF * BK * 2, STAGE_BYTES = 8 * HTB, NXCD = 8, WGM = 8;
__host__ __device__ __forceinline__ int lds_byte(int r, int c) { const int st = (r >> 4) * 2 + (c >> 5), rr = r & 15, cc = c & 31, ob = rr * 64 + cc * 2; return st * 1024 + (ob ^ (((ob >> 9) & 1) << 5)); }
__host__ __device__ __forceinline__ void stage_rc(int b, int& R, int& C) { const int st = b / 1024, sb = b % 1024, swz = sb ^ (((sb >> 9) & 1) << 5); R = (st >> 1) * 16 + swz / 64; C = (st & 1) * 32 + (swz % 64) / 2; }
__host__ __device__ __forceinline__ int perm32(int rho) { const int n = rho >> 4, i = rho & 15; return 8 * (i >> 2) + 4 * n + (i & 3); }

struct Unit { int pm, pn, part, skip; };
struct Gemm { const bf16* A0; const bf16* A1; const bf16* B0; const bf16* B1; int lda, ldb, nt0, nt1; size_t kstepA; };

template <bool CHAIN, bool KDUP = false> struct StaticOrder {
    int nM, nN, nwg, G, c, wgm, nmine;
    __device__ void init(int M, int N, int G_, int c_, int wgm_ = WGM, bool rev = false) { nM = M / BM; nN = N / BM; nwg = nM * nN; G = G_; c = c_; wgm = wgm_; nmine = rev ? (nwg - c_ + G_ - 1) / G_ : 0; }
    __device__ bool next(int i, Unit& u) const {
        int it = (CHAIN || KDUP) ? (i >> 1) : i; u.part = CHAIN ? (i & 1) : 0; u.skip = KDUP ? !(i & 1) : 0;
        if (nmine > 0) { if (it >= nmine) return false; it = nmine - 1 - it; }
        const long L = (long)it * G + c; if (L >= nwg) return false;
        int wgid = (int)L; { const int q = nwg / NXCD, r = nwg % NXCD, xcd = wgid % NXCD, off = wgid / NXCD; wgid = (xcd < r ? xcd * (q + 1) : r * (q + 1) + (xcd - r) * q) + off; }
        const int nig = wgm * nN, gid = wgid / nig, fm = gid * wgm, gsz = (nM - fm) < wgm ? (nM - fm) : wgm;
        u.pm = fm + ((wgid % nig) % gsz); u.pn = (wgid % nig) / gsz; return true;
    }
};
struct PanelOrder {
    volatile LAS int* tab; int np4, G, c;
    __device__ void init(const unsigned* pex, volatile LAS int* tab_, int G_, int vcu, int tid) {
        tab = tab_; G = G_; c = vcu; np4 = 4 * __builtin_amdgcn_readfirstlane((int)ld_agent(pex + 1023));
        if (tid < 64) { const int L = tid * G_ + vcu; tab_[tid] = (L < np4) ? (int)ld_agent(pex + (L >> 2)) : 0; }
        __syncthreads();
    }
    bool rev = false;
    __device__ bool next(int i0, Unit& u) const {
        int i = i0;
        if (rev) { const int n = (np4 - c + G - 1) / G; if (i0 >= n) return false; i = n - 1 - i0; }
        const int L = i * G + c; if (L >= np4 || i >= 64) return false;
        u.pm = L >> 2; u.pn = 4 * __builtin_amdgcn_readfirstlane(tab[i]) + (L & 3); u.part = 0; u.skip = 0; return true;
    }
};

template <class Epi, class Sched, bool GATHER>
__device__ __forceinline__ void gemm_phase(LAS unsigned char* lds, const int tid, const Gemm g, const Sched& S, const Epi& E, const unsigned* rowidx) {
    const int wid = __builtin_amdgcn_readfirstlane(tid >> 6), lane = tid & 63, wr = wid >> 2, wc = wid & 3, fr = lane & 15, fq = lane >> 4;
    int Rr[2], Cc[2]; unsigned voffB[2];
#pragma unroll
    for (int i = 0; i < 2; ++i) { stage_rc(tid * 16 + i * 8192, Rr[i], Cc[i]); const int Rb = (Rr[i] & ~31) + perm32(Rr[i] & 31); voffB[i] = (unsigned)(Rb * g.ldb + Cc[i] * 2); }
    const size_t kstep = (size_t)(BK * 2), kA = g.kstepA;
    const size_t hstep = (size_t)HALF * g.ldb;
    const size_t tstepA = (size_t)BM * g.lda, tstepB = (size_t)BM * g.ldb;
    const unsigned ldsw = (unsigned)wid * 1024u;
    const int aoff = lds_byte(wr * 64 + fr, fq * 8), boff = lds_byte(wc * 32 + fr, fq * 8);
    unsigned vc[2][2], vn[2][2];
#define PG8_SA(b, h) (((b) * 2 + (h)) * HTB)
#define PG8_SB(b, h) ((4 + (b) * 2 + (h)) * HTB)
#define PG8_STAGE(bufoff, gbase, voff) do { _Pragma("unroll") for (int _i = 0; _i < 2; ++_i) \
        __builtin_amdgcn_global_load_lds((const unsigned*)((const char*)(gbase) + (voff)[_i]), (LAS unsigned*)(lds + (bufoff) + ldsw + _i * 8192), 16, 0, 0); } while (0)
#define PG8_LDA(dst, b, h) do { _Pragma("unroll") for (int m = 0; m < 4; ++m) _Pragma("unroll") for (int k = 0; k < 2; ++k) dst[m][k] = *(const LAS bf16x8*)(lds + PG8_SA(b, h) + aoff + m * 2048 + k * 1024); } while (0)
#define PG8_LDB(dst, b, h) do { _Pragma("unroll") for (int n = 0; n < 2; ++n) _Pragma("unroll") for (int k = 0; k < 2; ++k) dst[n][k] = *(const LAS bf16x8*)(lds + PG8_SB(b, h) + boff + n * 2048 + k * 1024); } while (0)
#define PG8_MMA(ai, bj, At, Bt) do { __builtin_amdgcn_s_setprio(1); _Pragma("unroll") for (int m = 0; m < 4; ++m) _Pragma("unroll") for (int n = 0; n < 2; ++n) _Pragma("unroll") for (int k = 0; k < 2; ++k) \
        acc[ai][bj][m][n] = __builtin_amdgcn_mfma_f32_16x16x32_bf16(Bt[n][k], At[m][k], acc[ai][bj][m][n], 0, 0, 0); __builtin_amdgcn_s_setprio(0); } while (0)
#define PG8_WAIT_V(n) asm volatile("s_waitcnt vmcnt(" #n ")" ::: "memory")
#define PG8_WAIT_L(n) asm volatile("s_waitcnt lgkmcnt(" #n ")" ::: "memory")
#define PG8_BAR __builtin_amdgcn_s_barrier()
#define PG8_SCHED __builtin_amdgcn_sched_barrier(0)
#define PG8_VOFFS(v, u) do { _Pragma("unroll") for (int _h = 0; _h < 2; ++_h) _Pragma("unroll") for (int _i = 0; _i < 2; ++_i) { \
        if (GATHER) { const unsigned _t = rowidx[(u).pm * BM + _h * HALF + Rr[_i]]; v[_h][_i] = _t * (unsigned)g.lda + (unsigned)(Cc[_i] * 2); } \
        else v[_h][_i] = (unsigned)((_h * HALF + Rr[_i]) * g.lda + Cc[_i] * 2); } } while (0)
#define PG8_ZERO() do { _Pragma("unroll") for (int a = 0; a < 2; ++a) _Pragma("unroll") for (int b = 0; b < 2; ++b) _Pragma("unroll") for (int m = 0; m < 4; ++m) _Pragma("unroll") for (int n = 0; n < 2; ++n) acc[a][b][m][n] = (f32x4){0.f, 0.f, 0.f, 0.f}; } while (0)
    Unit cur, nxt; int ui = 0;
    if (!S.next(0, cur)) return;
#if PROBE_T
#define PT_NOW() (Epi::PROBE ? (unsigned)__builtin_amdgcn_s_memrealtime() : 0u)
    unsigned pt_first = 0, pt_rest = 0, pt_epi = 0, pt0 = 0, pt1 = 0, pt2 = 0;
    const unsigned pc_c0 = Epi::PROBE ? (unsigned)__builtin_amdgcn_s_memtime() : 0u, pc_t0 = PT_NOW();
#endif
    f32x4 acc[2][2][4][2];
    PG8_ZERO();
    bf16x8 At[4][2], B0[2][2], B1[2][2];
    PG8_VOFFS(vc, cur);
    const char* cA = GATHER ? (const char*)g.A0 : (const char*)(cur.part ? g.A1 : g.A0) + (size_t)cur.pm * tstepA; const char* cB = (const char*)(cur.part ? g.B1 : g.B0) + (size_t)cur.pn * tstepB;
    int nt = cur.part ? g.nt1 : g.nt0;
    PG8_STAGE(PG8_SB(0, 0), cB, voffB); PG8_STAGE(PG8_SB(0, 1), cB + hstep, voffB); PG8_STAGE(PG8_SA(0, 0), cA, vc[0]); PG8_STAGE(PG8_SA(0, 1), cA, vc[1]);
    if (wr == 1) PG8_BAR;
    PG8_WAIT_V(2); PG8_BAR;
    PG8_STAGE(PG8_SB(1, 0), cB + kstep, voffB); PG8_STAGE(PG8_SA(1, 0), cA + kA, vc[0]); PG8_STAGE(PG8_SB(1, 1), cB + hstep + kstep, voffB);
    PG8_WAIT_V(6); PG8_BAR;
    for (;;) {
        const bool has_next = S.next(ui + 1, nxt);
        const char* nA = GATHER ? (const char*)g.A0 : (has_next ? (const char*)(nxt.part ? g.A1 : g.A0) + (size_t)nxt.pm * tstepA : cA);
        const char* nB = has_next ? (const char*)(nxt.part ? g.B1 : g.B0) + (size_t)nxt.pn * tstepB : cB;
        if constexpr (GATHER) {
            if (has_next) { PG8_VOFFS(vn, nxt); } else {
#pragma unroll
                for (int h = 0; h < 2; ++h)
#pragma unroll
                    for (int i = 0; i < 2; ++i) vn[h][i] = vc[h][i]; }
        }
#if PROBE_T
        pt0 = PT_NOW();
#endif
        for (int t = 0; t < nt; t += 2) {
            const bool last = (t == nt - 2);
            const char* a1 = cA + (size_t)(t + 1) * kA;
            const char* a2 = last ? nA : cA + (size_t)(t + 2) * kA; const char* b2 = last ? nB : cB + (size_t)(t + 2) * kstep;
            const char* a3 = a2 + kA; const char* b3 = b2 + kstep;
            unsigned v2[2][2];
#pragma unroll
            for (int h = 0; h < 2; ++h)
#pragma unroll
                for (int i = 0; i < 2; ++i) { if constexpr (GATHER) v2[h][i] = last ? vn[h][i] : vc[h][i]; else v2[h][i] = vc[h][i]; }
            PG8_LDB(B0, 0, 0); PG8_LDB(B1, 0, 1); PG8_SCHED; PG8_LDA(At, 0, 0); PG8_STAGE(PG8_SA(1, 1), a1, vc[1]);
            PG8_WAIT_V(8); PG8_WAIT_L(0); PG8_BAR; PG8_MMA(0, 0, At, B0); PG8_MMA(0, 1, At, B1); PG8_BAR; PG8_SCHED;
            PG8_LDA(At, 0, 1); PG8_STAGE(PG8_SB(0, 0), b2, voffB); PG8_STAGE(PG8_SB(0, 1), b2 + hstep, voffB); PG8_STAGE(PG8_SA(0, 0), a2, v2[0]);
            PG8_WAIT_V(8); PG8_WAIT_L(0); PG8_BAR; PG8_MMA(1, 0, At, B0); PG8_MMA(1, 1, At, B1); PG8_BAR; PG8_SCHED;
            PG8_LDB(B0, 1, 0); PG8_LDB(B1, 1, 1); PG8_SCHED; PG8_LDA(At, 1, 0); PG8_STAGE(PG8_SA(0, 1), a2, v2[1]);
            PG8_WAIT_V(8); PG8_WAIT_L(0); PG8_BAR; PG8_MMA(0, 0, At, B0); PG8_MMA(0, 1, At, B1); PG8_BAR; PG8_SCHED;
            PG8_LDA(At, 1, 1); PG8_STAGE(PG8_SB(1, 0), b3, voffB); PG8_STAGE(PG8_SB(1, 1), b3 + hstep, voffB); PG8_STAGE(PG8_SA(1, 0), a3, v2[0]);
            PG8_WAIT_V(8); PG8_WAIT_L(0); PG8_BAR; PG8_MMA(1, 0, At, B0); PG8_MMA(1, 1, At, B1); PG8_BAR; PG8_SCHED;
        }
#if PROBE_T
        pt2 = PT_NOW(); pt_rest += pt2 - pt0;
#endif
        if (wr == 0) PG8_BAR;
        bool mid = false;
        if constexpr (Epi::CHAINED) mid = (cur.part == 0);
        if (mid) { if constexpr (Epi::CHAINED) E.mid(acc, cur, wr, wc, fr, fq); } else if (!cur.skip) { E(acc, cur, wr, wc, fr, fq); if (PROBE_DUP == 10 && Epi::PROBE10) { asm volatile("" ::: "memory"); E(acc, cur, wr, wc, fr, fq); } }
#if PROBE_T
        pt_epi += PT_NOW() - pt2;
#endif
        if (!has_next) break;
        if (!mid) PG8_ZERO();
        cur = nxt; cA = nA; cB = nB; nt = cur.part ? g.nt1 : g.nt0; ++ui;
        if constexpr (GATHER) {
#pragma unroll
            for (int h = 0; h < 2; ++h)
#pragma unroll
                for (int i = 0; i < 2; ++i) vc[h][i] = vn[h][i];
        }
        if (wr == 1) PG8_BAR;
    }
    PG8_WAIT_V(0);
    PG8_BAR;
#if PROBE_T
    if constexpr (Epi::PROBE) { if (E.probe_out && tid == 0) { E.probe_out[0] = pt_first; E.probe_out[1] = pt_rest; E.probe_out[2] = pt_epi; E.probe_out[3] = (unsigned)__builtin_amdgcn_s_memtime() - pc_c0; E.probe_out[4] = PT_NOW() - pc_t0;
        if (PROBE_T >= 8) { atomicMax(E.probe_out + 10, PT_NOW() - pc_t0); atomicMax(E.probe_out + 11, 0x7fffffffu - (PT_NOW() - pc_t0)); } } }
#endif
#undef PG8_SA
#undef PG8_SB
#undef PG8_STAGE
#undef PG8_LDA
#undef PG8_LDB
#undef PG8_MMA
#undef PG8_WAIT_V
#undef PG8_WAIT_L
#undef PG8_BAR
#undef PG8_SCHED
#undef PG8_VOFFS
#undef PG8_ZERO
}
}

__device__ __forceinline__ float sigmoidf_fast(float a) { return __builtin_amdgcn_rcpf(1.f + __builtin_amdgcn_exp2f(-a * LOG2E)); }
__device__ __forceinline__ u32x4 pack8(const f32x4 a, const f32x4 b) { u32x4 w; w.x = cvtpk(a[0], a[1]); w.y = cvtpk(a[2], a[3]); w.z = cvtpk(b[0], b[1]); w.w = cvtpk(b[2], b[3]); return w; }
__device__ __forceinline__ void unpack8(const u32x4 w, f32x4& a, f32x4& b) { a = (f32x4){bf_lo(w.x), bf_hi(w.x), bf_lo(w.y), bf_hi(w.y)}; b = (f32x4){bf_lo(w.z), bf_hi(w.z), bf_lo(w.w), bf_hi(w.w)}; }
typedef const f32x4 (&AccRef)[2][2][4][2];
typedef f32x4 (&AccMut)[2][2][4][2];

struct Epi1 {
    static constexpr bool CHAINED = false; static constexpr bool PROBE = (PROBE_T != 0 && PROBE_EPI == 1); static constexpr bool PROBE10 = true;
    bf16* qkv; bf16* sgd; bf16* sgs; unsigned* probe_out;
    __device__ __forceinline__ void operator()(AccRef acc, const pg8::Unit& u, int wr, int wc, int fr, int fq) const {
        const int pn = u.pn;
        if (pn < 23) {
            int sh = 0; float sc = 1.f;
            if (pn < 18) { sh = 2 * ((pn % 6) >> 1); if (pn < 6) sc = QSCALE; } else if (pn < 22) sc = QSCALE;
            const int col0 = pn * 256 + wc * 32 + fq * 8;
#pragma unroll
            for (int ai = 0; ai < 2; ++ai)
#pragma unroll
                for (int m = 0; m < 4; ++m) {
                    const int row = u.pm * 256 + ai * 128 + wr * 64 + m * 16 + fr, t = row & (T - 1);
                    const int rowp = (row & ~(T - 1)) | ((t & ((1 << sh) - 1)) << (13 - sh)) | (t >> sh);
                    bf16* rp = qkv + (size_t)(col0 >> 6) * TS + (size_t)rowp * 64 + (col0 & 63);
#pragma unroll
                    for (int bj = 0; bj < 2; ++bj) *(u32x4*)(rp + bj * 2 * TS) = pack8(acc[ai][bj][m][0] * sc, acc[ai][bj][m][1] * sc);
                }
        } else {
            const int col0 = (pn - 23) * 128 + wc * 32 + fq * 8;
#pragma unroll
            for (int ai = 0; ai < 2; ++ai)
#pragma unroll
                for (int m = 0; m < 4; ++m) {
                    const size_t off = (size_t)(u.pm * 256 + ai * 128 + wr * 64 + m * 16 + fr) * 1024 + col0;
#pragma unroll
                    for (int bj = 0; bj < 2; ++bj) { f32x4 a = acc[ai][bj][m][0], b = acc[ai][bj][m][1];
#pragma unroll
                        for (int i = 0; i < 4; ++i) { a[i] = sigmoidf_fast(a[i]); b[i] = sigmoidf_fast(b[i]); }
                        *(u32x4*)((bj ? sgs : sgd) + off) = pack8(a, b); }
                }
        }
    }
};
struct EpiMix {
    static constexpr bool CHAINED = true; static constexpr bool PROBE = (PROBE_T != 0 && PROBE_EPI == 4); static constexpr bool PROBE10 = false;
    const bf16* sgd; const bf16* sgs; bf16* mix; unsigned* probe_out;
    __device__ __forceinline__ void mid(AccMut acc, const pg8::Unit& u, int wr, int wc, int fr, int fq) const {
#pragma unroll
        for (int ai = 0; ai < 2; ++ai)
#pragma unroll
            for (int m = 0; m < 4; ++m) {
                const size_t off = (size_t)(u.pm * 256 + ai * 128 + wr * 64 + m * 16 + fr) * 1024 + u.pn * 256 + wc * 32 + fq * 8;
#pragma unroll
                for (int bj = 0; bj < 2; ++bj) { f32x4 da, db, sa, sb; unpack8(*(const u32x4*)(sgd + off + bj * 128), da, db); unpack8(*(const u32x4*)(sgs + off + bj * 128), sa, sb);
#pragma unroll
                    for (int i = 0; i < 4; ++i) { acc[ai][bj][m][0][i] *= sa[i] * __builtin_amdgcn_rcpf(fmaxf(da[i], 1e-20f)); acc[ai][bj][m][1][i] *= sb[i] * __builtin_amdgcn_rcpf(fmaxf(db[i], 1e-20f)); } }
            }
    }
    __device__ __forceinline__ void operator()(AccRef acc, const pg8::Unit& u, int wr, int wc, int fr, int fq) const {
        u32x4 gd[2][4][2];
#pragma unroll
        for (int ai = 0; ai < 2; ++ai)
#pragma unroll
            for (int m = 0; m < 4; ++m) {
                const size_t off = (size_t)(u.pm * 256 + ai * 128 + wr * 64 + m * 16 + fr) * 1024 + u.pn * 256 + wc * 32 + fq * 8;
#pragma unroll
                for (int bj = 0; bj < 2; ++bj) gd[ai][m][bj] = *(const u32x4*)(sgd + off + bj * 128);
            }
        __builtin_amdgcn_sched_barrier(0);
#pragma unroll
        for (int ai = 0; ai < 2; ++ai)
#pragma unroll
            for (int m = 0; m < 4; ++m) {
                const size_t row = (size_t)(u.pm * 256 + ai * 128 + wr * 64 + m * 16 + fr); const int col = u.pn * 256 + wc * 32 + fq * 8;
#pragma unroll
                for (int bj = 0; bj < 2; ++bj) { f32x4 da, db; unpack8(gd[ai][m][bj], da, db);
#pragma unroll
                    for (int i = 0; i < 4; ++i) { da[i] = fmaxf(da[i], 1e-20f); db[i] = fmaxf(db[i], 1e-20f); }
                    *(u32x4*)(mix + (size_t)((col >> 6) + 2 * bj) * TS + row * 64 + (col & 63)) = pack8(da * acc[ai][bj][m][0], db * acc[ai][bj][m][1]); }
            }
    }
};
struct EpiRes {
    static constexpr bool CHAINED = false; static constexpr bool PROBE = (PROBE_T != 0 && PROBE_EPI == 5); static constexpr bool PROBE10 = false;
    const bf16* hx; const float* rms; bf16* x1b; unsigned* probe_out;
    __device__ __forceinline__ void operator()(AccRef acc, const pg8::Unit& u, int wr, int wc, int fr, int fq) const {
        u32x4 xv[2][4][2]; float rm[2][4];
#pragma unroll
        for (int ai = 0; ai < 2; ++ai)
#pragma unroll
            for (int m = 0; m < 4; ++m) {
                const int row = u.pm * 256 + ai * 128 + wr * 64 + m * 16 + fr;
                const size_t off = (size_t)row * 1024 + u.pn * 256 + wc * 32 + fq * 8;
                rm[ai][m] = rms[row];
#pragma unroll
                for (int bj = 0; bj < 2; ++bj) xv[ai][m][bj] = *(const u32x4*)(hx + off + bj * 128);
            }
        __builtin_amdgcn_sched_barrier(0);
#pragma unroll
        for (int ai = 0; ai < 2; ++ai)
#pragma unroll
            for (int m = 0; m < 4; ++m) {
                const size_t off = (size_t)(u.pm * 256 + ai * 128 + wr * 64 + m * 16 + fr) * 1024 + u.pn * 256 + wc * 32 + fq * 8;
#pragma unroll
                for (int bj = 0; bj < 2; ++bj) { f32x4 a, b; unpack8(xv[ai][m][bj], a, b);
                    *(u32x4*)(x1b + off + bj * 128) = pack8(a * rm[ai][m] + acc[ai][bj][m][0], b * rm[ai][m] + acc[ai][bj][m][1]); }
            }
    }
};
struct EpiGU {
    static constexpr bool CHAINED = false; static constexpr bool PROBE = false; static constexpr bool PROBE10 = false;
    bf16* act; const float* rss;
    __device__ __forceinline__ void operator()(AccRef acc, const pg8::Unit& u, int wr, int wc, int fr, int fq) const {
        const int col0 = (u.pn & 3) * 128 + wc * 32 + fq * 8;
        float rs[2][4];
#pragma unroll
        for (int ai = 0; ai < 2; ++ai)
#pragma unroll
            for (int m = 0; m < 4; ++m) rs[ai][m] = rss[u.pm * 256 + ai * 128 + wr * 64 + m * 16 + fr];
        __builtin_amdgcn_sched_barrier(0);
#pragma unroll
        for (int ai = 0; ai < 2; ++ai)
#pragma unroll
            for (int m = 0; m < 4; ++m) {
                const size_t off = (size_t)(u.pm * 256 + ai * 128 + wr * 64 + m * 16 + fr) * DEXP + col0;
                f32x4 o[2];
#pragma unroll
                for (int n = 0; n < 2; ++n)
#pragma unroll
                    for (int i = 0; i < 4; ++i) { const float gt = acc[ai][0][m][n][i] * rs[ai][m]; o[n][i] = gt * sigmoidf_fast(gt) * (acc[ai][1][m][n][i] * rs[ai][m]); }
                *(u32x4*)(act + off) = pack8(o[0], o[1]);
            }
    }
};
struct EpiDown {
    static constexpr bool CHAINED = false; static constexpr bool PROBE = (PROBE_T != 0 && PROBE_EPI == 9); static constexpr bool PROBE10 = false;
    bf16* ys; const float* wos; unsigned* probe_out;
    __device__ __forceinline__ void operator()(AccRef acc, const pg8::Unit& u, int wr, int wc, int fr, int fq) const {
        float wv[2][4];
#pragma unroll
        for (int ai = 0; ai < 2; ++ai)
#pragma unroll
            for (int m = 0; m < 4; ++m) wv[ai][m] = wos[u.pm * 256 + ai * 128 + wr * 64 + m * 16 + fr];
        __builtin_amdgcn_sched_barrier(0);
#pragma unroll
        for (int ai = 0; ai < 2; ++ai)
#pragma unroll
            for (int m = 0; m < 4; ++m) {
                const int row = u.pm * 256 + ai * 128 + wr * 64 + m * 16 + fr;
                const size_t off = (size_t)row * 1024 + (u.pn & 3) * 256 + wc * 32 + fq * 8;
#pragma unroll
                for (int bj = 0; bj < 2; ++bj) *(u32x4*)(ys + off + bj * 128) = pack8(acc[ai][bj][m][0] * wv[ai][m], acc[ai][bj][m][1] * wv[ai][m]);
            }
    }
};

namespace att {
constexpr int VPITCH = 128, KROWS = 384, LDS_K = 0, LDS_V = KROWS * 128;
static_assert(LDS_V + 2 * KROWS * VPITCH <= 147456, "attention LDS: K image + two V images");
#define MFMA32(a, b, c) __builtin_amdgcn_mfma_f32_32x32x16_bf16((a), (b), (c), 0, 0, 0)
typedef short v4i16_t __attribute__((ext_vector_type(4)));
__device__ __forceinline__ s16x4 vtr(const LAS unsigned char* p) { return __builtin_bit_cast(s16x4, __builtin_amdgcn_ds_read_tr16_b64_v4i16((LAS v4i16_t*)p)); }

struct UnitDesc {
    const bf16* rb;
    int qcol, kcol, vcol;
    int has_prev, nh, mixer, head0, dil;
    int ltok0, lstride;
};
template <bool ISV> __device__ __forceinline__ void dma_image(LAS unsigned char* img, const bf16* g0  , const int w, const int lane, const bool has_prev) {
#pragma unroll
    for (int j = 0; j < 6; ++j) {
        if (j >= 2 || has_prev) {
            const int pi = w + 8 * j, r = 8 * pi + (lane >> 3), cp = lane & 7, c = ISV ? (cp ^ (((r >> 1) & 1) << 2)) : (cp ^ ((r >> 1) & 7));
            __builtin_amdgcn_global_load_lds((const unsigned*)(g0 + (ptrdiff_t)(r - 128) * 64 + c * 8), (LAS unsigned*)(img + pi * 1024), 16, 0, 0);
        }
    }
}
#define ATT_WAIT_V(n) asm volatile("s_waitcnt vmcnt(" #n ")" ::: "memory")
#define ATT_BAR() do { asm volatile("s_waitcnt lgkmcnt(0)" ::: "memory"); __builtin_amdgcn_s_barrier(); asm volatile("" ::: "memory"); } while (0)
__device__ __forceinline__ void attn_unit(LAS unsigned char* lds, const int tid, const UnitDesc& U, const float* sinks, float* lse, const bool has_next, const UnitDesc& Un, bf16x8 (&qn)[4], const int vpar, unsigned (&pt)[6]) {
#define APT(i) do { if (PROBE_T >= 40) { const unsigned _n = (unsigned)__builtin_amdgcn_s_memrealtime(); pt[i] += _n - ptl; ptl = _n; } } while (0)
    unsigned ptl = (PROBE_T >= 40) ? (unsigned)__builtin_amdgcn_s_memrealtime() : 0u;
    const int w = __builtin_amdgcn_readfirstlane(tid >> 6), lane = tid & 63, ql = lane & 31, h = lane >> 5;
    const int cstart = U.has_prev ? 0 : (w < 4 ? 4 - w : 0);
    const int i16 = lane & 15, q4 = i16 >> 2, p4 = i16 & 3, blk = (lane >> 4) & 1, swz = (q4 >> 1) & 1, kswz = (ql >> 1) & 7;
    float skl = 0.f;
    if (U.mixer) { const int hs = U.head0 + (lane & 7); skl = sinks[hs < 16 ? hs : 15]; }
    ATT_WAIT_V(0);
#pragma unroll
    for (int kk = 0; kk < 4; ++kk) asm volatile("" : "+v"(qn[kk]));
    asm volatile("" : "+v"(skl));
    ATT_BAR();
    APT(0);
    LAS unsigned char* const vimg = lds + LDS_V + vpar * (KROWS * VPITCH);
    const unsigned vbl = (unsigned)reinterpret_cast<__SIZE_TYPE__>(vimg) + (unsigned)((32 * w + 4 * h + q4) * VPITCH + (2 * blk + (p4 >> 1)) * 16 + 8 * (p4 & 1));
    const unsigned vb0 = vbl + (unsigned)(64 * swz), vb1 = vbl + (unsigned)(64 * (swz ^ 1));
    unsigned kbase[4];
#pragma unroll
    for (int kk = 0; kk < 4; ++kk) kbase[kk] = (unsigned)reinterpret_cast<__SIZE_TYPE__>(lds + LDS_K) + (unsigned)((32 * w + ql) * 128 + (((2 * kk + h) ^ kswz) * 16));
    for (int hh = 0; hh < U.nh; ++hh) {
        const int head = U.head0 + hh;
        const float slope = U.mixer ? __builtin_amdgcn_exp2f(-0.5f * (float)(head + 1)) : __builtin_amdgcn_exp2f((float)(head + 1) * (-8.f / 24.f));
        const float c2 = slope * (float)U.dil * LOG2E;
        const float sink2 = U.mixer ? __builtin_bit_cast(float, __builtin_amdgcn_readlane(__builtin_bit_cast(int, skl), hh)) * LOG2E : -INFINITY;
        bf16x8 qf[4];
#pragma unroll
        for (int kk = 0; kk < 4; ++kk) qf[kk] = qn[kk];
        if (hh == 0 && has_next) dma_image<true>(lds + LDS_V + (vpar ^ 1) * (KROWS * VPITCH), Un.rb + (size_t)Un.vcol * TS, w, lane, Un.has_prev != 0);
        f32x16 S[5];
        const float tl = -c2 * (float)(128 + ql - 4 * h);
        bf16x8 ka[4];
#define QK_READ(set, c) do { _Pragma("unroll") for (int kk = 0; kk < 4; ++kk) \
            asm volatile("ds_read_b128 %0, %1 offset:%c2" : "=&v"(set[kk]) : "v"(kbase[kk]), "i"((32 * (c)) * 128) : "memory"); } while (0)
#define QK_STEP(cur, nxt, c) do { if ((c) >= cstart) { \
            QK_READ(cur, c); \
            const float tc = tl + c2 * (32.f * (float)(c)); \
            _Pragma("unroll") for (int r = 0; r < 16; ++r) S[c][r] = tc + c2 * (float)((r & 3) + 8 * (r >> 2)); \
            asm volatile("s_waitcnt lgkmcnt(0)" : "+v"(cur[0]), "+v"(cur[1]), "+v"(cur[2]), "+v"(cur[3]) :: "memory"); \
            _Pragma("unroll") for (int kk = 0; kk < 4; ++kk) S[c] = MFMA32(cur[kk], qf[kk], S[c]); \
        } else { _Pragma("unroll") for (int r = 0; r < 16; ++r) S[c][r] = -INFINITY; } } while (0)
        QK_STEP(ka, ka, 0); QK_STEP(ka, ka, 1); QK_STEP(ka, ka, 2); QK_STEP(ka, ka, 3); QK_STEP(ka, ka, 4);
#undef QK_READ
#undef QK_STEP
        APT(1);
        if (hh + 1 < U.nh) {
            const bf16* qrow = U.rb + (size_t)(U.qcol + hh + 1) * TS + (32 * w + ql) * 64 + 8 * h;
#pragma unroll
            for (int kk = 0; kk < 4; ++kk) qn[kk] = *(const bf16x8*)(qrow + 16 * kk);
        }
        if (hh == U.nh - 1) {
            ATT_BAR();
            if (has_next) {
                dma_image<false>(lds + LDS_K, Un.rb + (size_t)Un.kcol * TS, w, lane, Un.has_prev != 0);
                const bf16* qrow = Un.rb + (size_t)Un.qcol * TS + (32 * w + ql) * 64 + 8 * h;
#pragma unroll
                for (int kk = 0; kk < 4; ++kk) qn[kk] = *(const bf16x8*)(qrow + 16 * kk);
            }
        }
        const int d0 = U.mixer;
#pragma unroll
        for (int r = 0; r < 16; ++r) { const int kl = (r & 3) + 8 * (r >> 2) + 4 * h; if (kl < ql + d0) S[0][r] = -INFINITY; if (kl > ql) S[4][r] = -INFINITY; }
        float m = sink2;
#pragma unroll
        for (int c = 0; c < 5; ++c)
#pragma unroll
            for (int r = 0; r < 16; ++r) m = fmaxf(m, S[c][r]);
        m = fmaxf(m, __shfl_xor(m, 32));
        float l = 0.f;
        APT(2);
        APT(3);
        f32x16 O[2];
#pragma unroll
        for (int r = 0; r < 16; ++r) { O[0][r] = 0.f; O[1][r] = 0.f; }
        s16x4 ra[4], rb[4];
#define PV_READ(set, k) do { \
            asm volatile("ds_read_b64_tr_b16 %0, %1 offset:%c2" : "=&v"(set[0]) : "v"(vb0), "i"((16 * (k)) * VPITCH) : "memory"); \
            asm volatile("ds_read_b64_tr_b16 %0, %1 offset:%c2" : "=&v"(set[1]) : "v"(vb0), "i"((16 * (k) + 8) * VPITCH) : "memory"); \
            asm volatile("ds_read_b64_tr_b16 %0, %1 offset:%c2" : "=&v"(set[2]) : "v"(vb1), "i"((16 * (k)) * VPITCH) : "memory"); \
            asm volatile("ds_read_b64_tr_b16 %0, %1 offset:%c2" : "=&v"(set[3]) : "v"(vb1), "i"((16 * (k) + 8) * VPITCH) : "memory"); } while (0)
#define PV_EXP(k) do { _Pragma("unroll") for (int r = 0; r < 8; ++r) { const float p = __builtin_amdgcn_exp2f(S[(k) >> 1][8 * ((k) & 1) + r] - m); S[(k) >> 1][8 * ((k) & 1) + r] = p; l += p; } } while (0)
#define PV_STEP(cur, nxt, k) do { if (((k) >> 1) >= cstart) { \
            if ((k) == 2 * cstart) { PV_READ(cur, k); PV_EXP(k); } \
            asm volatile("s_waitcnt lgkmcnt(0)" : "+v"(cur[0]), "+v"(cur[1]), "+v"(cur[2]), "+v"(cur[3]) :: "memory"); \
            if ((k) + 1 < 10) PV_READ(nxt, (k) + 1); \
            u32x4 pw; pw.x = cvtpk(S[(k) >> 1][8 * ((k) & 1)], S[(k) >> 1][8 * ((k) & 1) + 1]); pw.y = cvtpk(S[(k) >> 1][8 * ((k) & 1) + 2], S[(k) >> 1][8 * ((k) & 1) + 3]); \
            pw.z = cvtpk(S[(k) >> 1][8 * ((k) & 1) + 4], S[(k) >> 1][8 * ((k) & 1) + 5]); pw.w = cvtpk(S[(k) >> 1][8 * ((k) & 1) + 6], S[(k) >> 1][8 * ((k) & 1) + 7]); \
            const bf16x8 pf = __builtin_bit_cast(bf16x8, pw); \
            O[0] = MFMA32(__builtin_shufflevector(cur[0], cur[1], 0, 1, 2, 3, 4, 5, 6, 7), pf, O[0]); \
            O[1] = MFMA32(__builtin_shufflevector(cur[2], cur[3], 0, 1, 2, 3, 4, 5, 6, 7), pf, O[1]); \
            if ((k) + 1 < 10) PV_EXP((k) + 1);     } } while (0)
        PV_STEP(ra, rb, 0); PV_STEP(rb, ra, 1); PV_STEP(ra, rb, 2); PV_STEP(rb, ra, 3); PV_STEP(ra, rb, 4);
        PV_STEP(rb, ra, 5); PV_STEP(ra, rb, 6); PV_STEP(rb, ra, 7); PV_STEP(ra, rb, 8); PV_STEP(rb, ra, 9);
#undef PV_READ
#undef PV_STEP
#undef PV_EXP
        l += __shfl_xor(l, 32);
        l += __builtin_amdgcn_exp2f(sink2 - m);
        APT(4);
        const float inv = 1.f / l;
        const int qi = 32 * w + ql;
        bf16* op = const_cast<bf16*>(U.rb) + (size_t)(U.qcol + hh) * TS + qi * 64 + 8 * h;
#pragma unroll
        for (int dt = 0; dt < 2; ++dt)
#pragma unroll
            for (int j = 0; j < 2; ++j) {
                const int ga = 2 * j, gb = 2 * j + 1;
                const unsigned ax = cvtpk(O[dt][4 * ga] * inv, O[dt][4 * ga + 1] * inv), ay = cvtpk(O[dt][4 * ga + 2] * inv, O[dt][4 * ga + 3] * inv);
                const unsigned bx_ = cvtpk(O[dt][4 * gb] * inv, O[dt][4 * gb + 1] * inv), by = cvtpk(O[dt][4 * gb + 2] * inv, O[dt][4 * gb + 3] * inv);
                const auto sx = __builtin_amdgcn_permlane32_swap(ax, bx_, false, false), sy = __builtin_amdgcn_permlane32_swap(ay, by, false, false);
                u32x4 o4; o4.x = sx[0]; o4.y = sy[0]; o4.z = sx[1]; o4.w = sy[1];
                *(u32x4*)(op + 32 * dt + 16 * j) = o4; }
        if (!U.mixer && h == 0) lse[(size_t)(U.ltok0 + qi * U.lstride) * 24 + head] = (m + __builtin_amdgcn_logf(l)) * LN2;
        APT(5);
    }
#undef APT
}
#undef ATT_WAIT_V
#undef ATT_BAR
#undef MFMA32
}

#define XB_TMO      128
#define XB_XCNT(j)  (256  + 64 * (j))
#define XB_XSUB(j)  (1280 + 64 * (j))
#define XB_XGEN(j)  (2304 + 64 * (j))
#define XB_TOP      3328
#define XB_TOPGEN   3392
#define XCD_BAR_WORDS 3456
#define XB_SPIN_CAP (1u << 18)
__device__ __forceinline__ unsigned xb_ld(unsigned* p)              { return __hip_atomic_load(p, __ATOMIC_RELAXED, __HIP_MEMORY_SCOPE_AGENT); }
__device__ __forceinline__ unsigned xb_add(unsigned* p, unsigned v) { return __hip_atomic_fetch_add(p, v, __ATOMIC_RELAXED, __HIP_MEMORY_SCOPE_AGENT); }
__device__ __forceinline__ unsigned xb_xcc_id() { return (unsigned)__builtin_amdgcn_s_getreg((3 << 11) | 20) & 0xFu; }
#define XB_SPIN(cond, bar) do { unsigned _sp = 0; while (cond) { __builtin_amdgcn_s_sleep(1); \
    if ((++_sp & 255u) == 0u) { if (xb_ld(&(bar)[XB_TMO])) break; if (_sp > XB_SPIN_CAP) { atomicAdd(&(bar)[XB_TMO], 1u); break; } } } } while (0)
struct XcdBarrier { unsigned* bar; unsigned x; volatile LAS unsigned* st; };
__device__ __forceinline__ XcdBarrier xcd_barrier_post(unsigned* bar, volatile LAS unsigned* st) {
    XcdBarrier b; b.bar = bar; b.x = xb_xcc_id(); b.st = st;
    if (threadIdx.x == 0) (void)xb_add(&bar[XB_XCNT(b.x)], 1u);
    return b;
}
__device__ __forceinline__ void xcd_barrier_complete(unsigned* bar, unsigned x, unsigned& nloc, unsigned& nx) {
    const unsigned G = gridDim.x * gridDim.y * gridDim.z;
    unsigned sum, cnt, mine, sp = 0u;
    for (;;) {
        sum = 0u; cnt = 0u; mine = 0u;
#pragma unroll
        for (unsigned j = 0; j < 16; ++j) { const unsigned c = xb_ld(&bar[XB_XCNT(j)]); sum += c; cnt += (c > 0u) ? 1u : 0u; mine = (j == x) ? c : mine; }
        if (sum == G) break;
        __builtin_amdgcn_s_sleep(1);
        if ((++sp & 255u) == 0u) { if (xb_ld(&bar[XB_TMO])) break; if (sp > XB_SPIN_CAP) { atomicAdd(&bar[XB_TMO], 1u); break; } }
    }
    nloc = mine > 0u ? mine : 1u; nx = cnt > 0u ? cnt : 1u;
}
__device__ __forceinline__ void xcd_barrier(const XcdBarrier& b) {
    asm volatile("s_waitcnt vmcnt(0)" ::: "memory");
    __syncthreads();
    if (threadIdx.x == 0) {
        unsigned* bar = b.bar;
        __builtin_amdgcn_s_waitcnt(0);
        unsigned nloc = b.st[0], nx = b.st[1];
        if (nloc == 0u) { xcd_barrier_complete(bar, b.x, nloc, nx); b.st[0] = nloc; b.st[1] = nx; }
        const unsigned old = xb_add(&bar[XB_XSUB(b.x)], 1u);
        const unsigned gen = old / nloc;
        if (old + 1u == (gen + 1u) * nloc) {
            __builtin_amdgcn_fence(__ATOMIC_RELEASE, "agent");
            asm volatile("s_waitcnt vmcnt(0)" ::: "memory");
            const unsigned og = xb_add(&bar[XB_TOP], 1u);
            const unsigned tg = og / nx;
            if (og + 1u == (tg + 1u) * nx) xb_add(&bar[XB_TOPGEN], 1u);
            else XB_SPIN(xb_ld(&bar[XB_TOPGEN]) == tg, bar);
            __builtin_amdgcn_fence(__ATOMIC_ACQUIRE, "agent");
            xb_add(&bar[XB_XGEN(b.x)], 1u);
            asm volatile("s_waitcnt vmcnt(0)" ::: "memory");
        } else {
            XB_SPIN(xb_ld(&bar[XB_XGEN(b.x)]) == gen, bar);
            __builtin_amdgcn_fence(__ATOMIC_ACQUIRE, "agent");
            asm volatile("s_waitcnt vmcnt(0)" ::: "memory");
        }
    }
    __syncthreads();
}

struct Args { const float* in[16]; float* out; unsigned char* ws; int ph_lo, ph_hi; };
struct Frame {
    LAS unsigned char* lds; volatile LAS unsigned* MISC; unsigned* ctl; unsigned char* ws;
    int tid, lane, wave, vcu, G, bx;
};

template <bool GAIN>
__device__ __forceinline__ void tr_item(const float* W, int ldw, int k0, int src_n0, bf16* WT, int ldt, int dst_r0, LAS float* scr, int lane, const float* gk = nullptr) {
#pragma unroll 8
    for (int i = 0; i < 32; ++i) { const int kk = 2 * i + (lane >> 5); float w = W[(size_t)(k0 + kk) * ldw + src_n0 + (lane & 31)]; if (GAIN) w *= gk[k0 + kk]; scr[kk * 33 + (lane & 31)] = w; }
    LDS_WAIT(); asm volatile("" ::: "memory");
    const int c = lane & 7;
#pragma unroll
    for (int j = 0; j < 4; ++j) { const int n = (lane >> 3) + 8 * j; const LAS float* sp = scr + (8 * c) * 33 + n;
        u32x4 o; o.x = cvtpk(sp[0 * 33], sp[1 * 33]); o.y = cvtpk(sp[2 * 33], sp[3 * 33]); o.z = cvtpk(sp[4 * 33], sp[5 * 33]); o.w = cvtpk(sp[6 * 33], sp[7 * 33]);
        *(u32x4*)(WT + (size_t)(dst_r0 + n) * ldt + k0 + 8 * c) = o; }
    LDS_WAIT(); asm volatile("" ::: "memory");
}
__device__ __forceinline__ void p0_prologue(const Frame& F, const Args& a) {
    LAS float* scr = (LAS float*)(F.lds + F.wave * 16384);
    const int gw = F.vcu * 8 + F.wave, NGW = F.G * 8, lane = F.lane;
    bf16* win = (bf16*)(F.ws + WS_WIN); bf16* wbr = (bf16*)(F.ws + WS_WBR); bf16* wout = (bf16*)(F.ws + WS_WOUT);
    bf16* wgu = (bf16*)(F.ws + WS_WGU); bf16* wd = (bf16*)(F.ws + WS_WD);
    constexpr int I_IN = 16 * 248, I_BD = 8 * 32, I_BS = 16 * 32, I_OUT = 16 * 32, I_G = 32 * 256, I_U = 32 * 256, I_D = 32 * 256;
    constexpr int NITEMS = I_IN + I_BD + I_BS + I_OUT + I_G + I_U + I_D;
    for (int it = gw; it < NITEMS; it += NGW) {
        int r = it;
        if (r < I_IN) { const int kb = r / 248, nb = r % 248, dr = 32 * nb; int src = dr;
            if (dr >= QKV_W) { const int o = dr - QKV_W, j = o >> 8, i = o & 255; src = (i < 128) ? QKV_W + 128 * j + i : QKV_W + 1024 + 128 * j + (i - 128); }
            tr_item<true>(a.in[2], IN_W, 64 * kb, src, win, 1024, dr, scr, lane, a.in[1]); continue; } r -= I_IN;
        if (r < I_BD) { tr_item<false>(a.in[4], 1024, 64 * (r >> 5), 32 * (r & 31), wbr + 1024, 1536, 32 * (r & 31), scr, lane); continue; } r -= I_BD;
        if (r < I_BS) { tr_item<false>(a.in[5], 1024, 64 * (r >> 5), 32 * (r & 31), wbr, 1536, 32 * (r & 31), scr, lane); continue; } r -= I_BS;
        if (r < I_OUT) { tr_item<false>(a.in[6], 1024, 64 * (r >> 5), 32 * (r & 31), wout, 1024, 32 * (r & 31), scr, lane); continue; } r -= I_OUT;
        if (r < I_G + I_U) { const int up = r >= I_G; if (up) r -= I_G; const int e = r >> 8, kb = (r >> 4) & 15, nb = r & 15;
            tr_item<true>((up ? a.in[13] : a.in[12]) + (size_t)e * 1024 * 512, 512, 64 * kb, 32 * nb, wgu, 1024, e * 1024 + 256 * (nb >> 2) + 128 * up + 32 * (nb & 3), scr, lane, a.in[7]); continue; } r -= I_G + I_U;
        { const int e = r >> 8, kb = (r >> 5) & 7, nb = r & 31;
            tr_item<false>(a.in[14] + (size_t)e * 512 * 1024, 1024, 64 * kb, 32 * nb, wd, 512, e * 1024 + 32 * nb, scr, lane); }
    }
    { u32x4* img = (u32x4*)(F.ws + WS_WRT); const float* gf = a.in[7]; const float* wg = a.in[8]; const float* wr = a.in[10];
        for (int i = F.vcu * 512 + F.tid; i < 2 * 32 * 3 * 64; i += F.G * 512) {
            const int ln = i & 63, q = i >> 6, b = q % 3, t = (q / 3) & 31, half = q / 96, n = ln & 31;
            const int k0 = 512 * half + 64 * (t >> 2) + 32 * (ln >> 5) + 8 * (t & 3);
            const bool want_lo = (b == 1) || (b == 2 && n >= 4);
            float w[8];
#pragma unroll
            for (int j = 0; j < 8; ++j) { const int k = k0 + j; float v = 0.f;
                if (b < 2) v = gf[k] * wr[k * 32 + n]; else if (n < 8) v = gf[k] * wg[k * 4 + (n & 3)];
                const float hi = bf_lo(cvtpk(v, 0.f));
                w[j] = want_lo ? v - hi : hi; }
            u32x4 o; o.x = cvtpk(w[0], w[1]); o.y = cvtpk(w[2], w[3]); o.z = cvtpk(w[4], w[5]); o.w = cvtpk(w[6], w[7]);
            img[i] = o; } }
    { const float* x = a.in[0]; bf16* H = (bf16*)(F.ws + WS_H); float* rms1 = (float*)(F.ws + WS_RMS1);
        f32x4 vnx[4];
        if (gw < NTOK) { const f32x4* xr0 = (const f32x4*)(x + (size_t)gw * 1024) + lane;
#pragma unroll
            for (int j = 0; j < 4; ++j) vnx[j] = xr0[64 * j]; }
        for (int row = gw; row < NTOK; row += NGW) {
            f32x4 v[4]; float ss = 0.f;
#pragma unroll
            for (int j = 0; j < 4; ++j) v[j] = vnx[j];
            if (row + NGW < NTOK) { const f32x4* xrn = (const f32x4*)(x + (size_t)(row + NGW) * 1024) + lane;
#pragma unroll
                for (int j = 0; j < 4; ++j) vnx[j] = xrn[64 * j]; }
#pragma unroll
            for (int j = 0; j < 4; ++j) ss += (v[j].x * v[j].x + v[j].y * v[j].y) + (v[j].z * v[j].z + v[j].w * v[j].w);
            const float rms = sqrtf(wave_sum(ss) * (1.f / 1024.f) + RMS_EPS), rstd = 1.f / rms;
            if (lane == 0) rms1[row] = rms;
            u32x2* o = (u32x2*)(H + (size_t)row * 1024) + lane;
#pragma unroll
            for (int j = 0; j < 4; ++j) { const f32x4 t = v[j] * rstd; u32x2 p; p.x = cvtpk(t.x, t.y); p.y = cvtpk(t.z, t.w); o[64 * j] = p; }
        }
    }
}

#ifndef ATT_REVERSE
#define ATT_REVERSE 1
#endif
#ifndef SWA_NH
#define SWA_NH 8
#endif
constexpr int ATT_NSWA = 2 * 32 * (8 / SWA_NH), ATT_UPB = ATT_NSWA + 24 * 32;
__device__ __forceinline__ void attn_make_unit(const Frame& F, const int gi, att::UnitDesc& U) {
    const bf16* qkv = (const bf16*)(F.ws + WS_QKV);
    const int gr = ATT_REVERSE ? (NB * ATT_UPB - 1 - gi) : gi;
    const int b = gr / ATT_UPB, ui = gr - b * ATT_UPB;
    if (ui < ATT_NSWA) {
        const int grp = ui % (8 / SWA_NH), blkq = (ui / (8 / SWA_NH)) & 31, kvh = ui / (32 * (8 / SWA_NH)), head0 = kvh * 8 + grp * SWA_NH;
        U.rb = qkv + (size_t)(b * T + 256 * blkq) * 64;
        U.qcol = COL_QS / 64 + head0; U.kcol = COL_KS / 64 + kvh; U.vcol = COL_VS / 64 + kvh;
        U.has_prev = blkq != 0; U.nh = SWA_NH; U.mixer = 1; U.head0 = head0; U.dil = 1; U.ltok0 = 0; U.lstride = 0;
    } else {
        const int au = ui - ATT_NSWA, blkq = au & 31, head = au >> 5, sh = 2 * (head >> 3), L = T >> sh;
        const int prow = 256 * blkq, r = prow >> (13 - sh), u0 = prow & (L - 1);
        U.rb = qkv + (size_t)(b * T + prow) * 64;
        U.qcol = head; U.kcol = COL_KD / 64 + head; U.vcol = COL_VD / 64 + head;
        U.has_prev = u0 != 0; U.nh = 1; U.mixer = 0; U.head0 = head; U.dil = 1 << sh;
        U.ltok0 = b * T + (u0 << sh) + r; U.lstride = 1 << sh;
    }
}
__device__ __forceinline__ void attn_phase(const Frame& F, const float* sinks) {
    int gi = F.vcu;
    if (gi >= NB * ATT_UPB) return;
    att::UnitDesc U, Un; bf16x8 qn[4]; unsigned pt[6] = {0u, 0u, 0u, 0u, 0u, 0u};
    attn_make_unit(F, gi, U);
    { const int w = F.wave, lane = F.lane;
      att::dma_image<false>(F.lds + att::LDS_K, U.rb + (size_t)U.kcol * TS, w, lane, U.has_prev != 0);
      att::dma_image<true>(F.lds + att::LDS_V, U.rb + (size_t)U.vcol * TS, w, lane, U.has_prev != 0);
      const bf16* qrow = U.rb + (size_t)U.qcol * TS + (32 * w + (lane & 31)) * 64 + 8 * (lane >> 5);
#pragma unroll
      for (int kk = 0; kk < 4; ++kk) qn[kk] = *(const bf16x8*)(qrow + 16 * kk); }
    int vpar = 0;
    for (;;) {
        const bool has_next = gi + F.G < NB * ATT_UPB;
        attn_make_unit(F, has_next ? gi + F.G : gi, Un);
        att::attn_unit(F.lds, F.tid, U, sinks, (float*)(F.ws + WS_LSE), has_next, Un, qn, vpar, pt);
        if (!has_next) break;
        gi += F.G; U = Un; vpar ^= 1;
    }
    asm volatile("s_waitcnt vmcnt(0)" ::: "memory");
    __syncthreads();
    if (PROBE_T >= 40 && F.vcu == 5 && F.tid == 0) { for (int i = 0; i < 6; ++i) F.ctl[20040 + i] = pt[i]; }
}
__device__ __forceinline__ void merge_phase(const Frame& F) {
    bf16* qkv = (bf16*)(F.ws + WS_QKV); const float* lse = (const float*)(F.ws + WS_LSE);
    for (int it = F.vcu * 512 + F.tid; it < NTOK * 64; it += F.G * 512) {
        const int dc = it & 7, hs = (it >> 3) & 7, t = it >> 6, tb = t & ~(T - 1), tl = t & (T - 1);
        const float l0 = lse[(size_t)t * 24 + hs], l1 = lse[(size_t)t * 24 + 8 + hs], l2 = lse[(size_t)t * 24 + 16 + hs];
        const float mx = fmaxf(l0, fmaxf(l1, l2));
        float w0 = __expf(l0 - mx), w1 = __expf(l1 - mx), w2 = __expf(l2 - mx); const float inv = 1.f / (w0 + w1 + w2); w0 *= inv; w1 *= inv; w2 *= inv;
        const int r1 = tb | ((tl & 3) << 11) | (tl >> 2), r2 = tb | ((tl & 15) << 9) | (tl >> 4);
        f32x4 a0, b0, a1, b1, a2, b2;
        unpack8(*(const u32x4*)(qkv + (size_t)hs * TS + (size_t)t * 64 + dc * 8), a0, b0);
        unpack8(*(const u32x4*)(qkv + (size_t)(8 + hs) * TS + (size_t)r1 * 64 + dc * 8), a1, b1);
        unpack8(*(const u32x4*)(qkv + (size_t)(16 + hs) * TS + (size_t)r2 * 64 + dc * 8), a2, b2);
        *(u32x4*)(qkv + (size_t)(COL_YDIL / 64 + hs) * TS + (size_t)t * 64 + dc * 8) = pack8(a0 * w0 + a1 * w1 + a2 * w2, b0 * w0 + b1 * w1 + b2 * w2);
    }
}
__device__ __forceinline__ float dot4(const f32x4 a, const f32x4 b) { return (a.x * b.x + a.y * b.y) + (a.z * b.z + a.w * b.w); }
constexpr int RT_IMG_HALF = 32 * 3 * 1024;
constexpr int RT_STAGE_OFF = RT_IMG_HALF, RT_SP = 41;
static_assert(RT_STAGE_OFF + 8 * 32 * RT_SP * 4 <= P5_CNT_OFF, "router LDS");
__device__ __forceinline__ void router_phase(const Frame& F, const bf16* x1, const float* bg, const float* br) {
    const int lane = F.lane, tid = F.tid, n = lane & 31, h = lane >> 5;
    volatile LAS unsigned* cnt = (volatile LAS unsigned*)(F.lds + P5_CNT_OFF); volatile LAS unsigned* basew = (volatile LAS unsigned*)(F.lds + P5_BASE_OFF);
    volatile LAS unsigned* rec = (volatile LAS unsigned*)(F.lds + P5_REC_OFF);
    if (tid < 32) cnt[tid] = 0u;
    const int RPW = NTOK / F.G, row0 = F.vcu * RPW;
    const u32x4* img = (const u32x4*)(F.ws + WS_WRT);
    LAS float* stage = (LAS float*)(F.lds + RT_STAGE_OFF) + F.wave * (32 * RT_SP);
    float* rstd2 = (float*)(F.ws + WS_RSTD2); float* rw = (float*)(F.ws + WS_RW);
    for (int c0 = 0; c0 < RPW; c0 += 256) {
        const int lrow = c0 + 32 * F.wave + n;
        const u32x4* xp = (const u32x4*)(x1 + (size_t)(row0 + lrow) * 1024 + 32 * h);
        f32x16 ae, ag, as_;
#pragma unroll
        for (int r = 0; r < 16; ++r) { ae[r] = 0.f; ag[r] = 0.f; as_[r] = 0.f; }
        u32x4 a0[4], a1[4], a2[4];
#define RT_MFMA(a, b, c) __builtin_amdgcn_mfma_f32_32x32x16_bf16((a), (b), (c), 0, 0, 0)
#define RT_LOADA(buf, SS) do { _Pragma("unroll") for (int i = 0; i < 4; ++i) buf[i] = xp[8 * (SS) + i]; } while (0)
#define RT_SS(cur, nxt, SS) do { \
        if ((SS) == 0 || (SS) == 8) { __syncthreads(); \
            for (int i = tid; i < RT_IMG_HALF / 16; i += 512) ((LAS u32x4*)F.lds)[i] = img[((SS) >> 3) * (RT_IMG_HALF / 16) + i]; \
            __syncthreads(); } \
        if ((SS) + 2 < 16) RT_LOADA(nxt, (SS) + 2); \
        _Pragma("unroll") for (int i = 0; i < 4; ++i) { const LAS bf16x8* bp = (const LAS bf16x8*)F.lds + (4 * ((SS) & 7) + i) * 192 + lane; \
            const bf16x8 av = __builtin_bit_cast(bf16x8, cur[i]); \
            ae = RT_MFMA(av, bp[0], ae); ae = RT_MFMA(av, bp[64], ae); ag = RT_MFMA(av, bp[128], ag); as_ = RT_MFMA(av, av, as_); } } while (0)
        RT_LOADA(a0, 0); RT_LOADA(a1, 1);
        RT_SS(a0, a2, 0); RT_SS(a1, a0, 1); RT_SS(a2, a1, 2); RT_SS(a0, a2, 3); RT_SS(a1, a0, 4); RT_SS(a2, a1, 5); RT_SS(a0, a2, 6); RT_SS(a1, a0, 7);
        RT_SS(a2, a1, 8); RT_SS(a0, a2, 9); RT_SS(a1, a0, 10); RT_SS(a2, a1, 11); RT_SS(a0, a2, 12); RT_SS(a1, a0, 13); RT_SS(a2, a1, 14); RT_SS(a0, a2, 15);
#undef RT_SS
#undef RT_LOADA
#undef RT_MFMA
        float ssd = 0.f;
#pragma unroll
        for (int r = 0; r < 16; ++r) { const int row = (r & 3) + 8 * (r >> 2) + 4 * h;
            stage[row * RT_SP + n] = ae[r]; if (n < 8) stage[row * RT_SP + 32 + n] = ag[r]; if (row == n) ssd = as_[r]; }
        if (h == ((n >> 2) & 1)) stage[n * RT_SP + 40] = ssd;
        LDS_WAIT(); asm volatile("" ::: "memory");
        if (lane < 32) {
            const LAS float* sr = stage + n * RT_SP; const int row = row0 + lrow;
            const float rstd = 1.f / sqrtf(sr[40] * (1.f / 1024.f) + RMS_EPS);
            float gl[4];
#pragma unroll
            for (int e = 0; e < 4; ++e) gl[e] = (sr[32 + e] + sr[36 + e]) * rstd + bg[e];
            int gt = 0; float gm = gl[0];
#pragma unroll
            for (int e = 1; e < 4; ++e) if (gl[e] > gm) { gm = gl[e]; gt = e; }
            float gz = 0.f;
#pragma unroll
            for (int e = 0; e < 4; ++e) gz += __expf(gl[e] - gm);
            const float gwt = 1.f / gz;
            float el[8];
#pragma unroll
            for (int e = 0; e < 8; ++e) el[e] = sr[8 * gt + e] * rstd + br[8 * gt + e];
            int i0 = 0; float m0 = el[0];
#pragma unroll
            for (int e = 1; e < 8; ++e) if (el[e] > m0) { m0 = el[e]; i0 = e; }
            int i1 = -1; float m1 = -INFINITY;
#pragma unroll
            for (int e = 0; e < 8; ++e) if (e != i0 && el[e] > m1) { m1 = el[e]; i1 = e; }
            if (i1 < 0) i1 = (i0 == 0) ? 1 : 0;
            const float ed = __expf(m1 - m0), w0 = 1.f / (1.f + ed), w1 = ed * w0;
            const unsigned E0 = (unsigned)(8 * gt + i0), E1 = (unsigned)(8 * gt + i1);
            const unsigned r0 = __hip_atomic_fetch_add((LAS unsigned*)&cnt[E0], 1u, __ATOMIC_RELAXED, __HIP_MEMORY_SCOPE_WORKGROUP);
            const unsigned r1 = __hip_atomic_fetch_add((LAS unsigned*)&cnt[E1], 1u, __ATOMIC_RELAXED, __HIP_MEMORY_SCOPE_WORKGROUP);
            rec[lrow] = E0 | (E1 << 5) | (r0 << 10) | (r1 << 20);
            rw[2 * row] = gwt * w0; rw[2 * row + 1] = gwt * w1; rstd2[row] = rstd;
        }
    }
    __syncthreads();
    if (tid < 32) basew[tid] = __hip_atomic_fetch_add(F.ctl + CW_CNT + 64 * tid, cnt[tid], RLX_AGENT);
    __syncthreads();
    unsigned* re = (unsigned*)(F.ws + WS_RE); unsigned* rrel = (unsigned*)(F.ws + WS_RREL);
    for (int lt = tid; lt < RPW; lt += 512) { const unsigned rc = rec[lt], E0 = rc & 31u, E1 = (rc >> 5) & 31u; const int row = row0 + lt;
        re[row] = E0 | (E1 << 8); rrel[2 * row] = basew[E0] + ((rc >> 10) & 1023u); rrel[2 * row + 1] = basew[E1] + ((rc >> 20) & 1023u); }
}
__device__ __forceinline__ void slots_phase(const Frame& F) {
    volatile LAS unsigned* cnt = (volatile LAS unsigned*)F.lds; volatile LAS unsigned* off = cnt + 32;
    if (F.tid < 32) cnt[F.tid] = ld_agent(F.ctl + CW_CNT + 64 * F.tid);
    __syncthreads();
    if (F.tid == 0) { unsigned o = 0; for (int e = 0; e < 32; ++e) { off[e] = o; o += (cnt[e] + 255u) & ~255u; } off[32] = o; }
    __syncthreads();
    const int RPW = NTOK / F.G, row0 = F.vcu * RPW;
    const unsigned* re = (const unsigned*)(F.ws + WS_RE); const unsigned* rrel = (const unsigned*)(F.ws + WS_RREL); const float* rw = (const float*)(F.ws + WS_RW);
    unsigned* tos = (unsigned*)(F.ws + WS_TOS); float* wos = (float*)(F.ws + WS_WOS); float* rss = (float*)(F.ws + WS_RSS); const float* rstd2 = (const float*)(F.ws + WS_RSTD2); unsigned* sot = (unsigned*)(F.ws + WS_SOT); unsigned* pex = (unsigned*)(F.ws + WS_PEX);
    for (int lt = F.tid; lt < RPW; lt += 512) { const int row = row0 + lt; const unsigned ev = re[row], e0 = ev & 255u, e1 = ev >> 8;
        const unsigned s0 = off[e0] + rrel[2 * row], s1 = off[e1] + rrel[2 * row + 1];
        tos[s0] = (unsigned)row; tos[s1] = (unsigned)row; wos[s0] = rw[2 * row]; wos[s1] = rw[2 * row + 1]; { const float r2 = rstd2[row]; rss[s0] = r2; rss[s1] = r2; } sot[2 * row] = s0; sot[2 * row + 1] = s1; }
    for (int e = F.vcu; e < 32; e += F.G) { const unsigned c = cnt[e], pad = ((c + 255u) & ~255u) - c;
        for (unsigned i = F.tid; i < pad; i += 512) { tos[off[e] + c + i] = 0u; wos[off[e] + c + i] = 0.f; rss[off[e] + c + i] = 0.f; } }
    if (F.vcu == F.G - 1) { const unsigned np = off[32] >> 8;
        for (unsigned p = F.tid; p < np; p += 512) { unsigned e = 0; for (unsigned k = 0; k < 32; ++k) if (off[k] <= 256u * p && 256u * p < off[k + 1]) e = k; pex[p] = e; }
        if (F.tid == 0) pex[1023] = np; }
    __syncthreads();
}
__device__ __forceinline__ void final_phase(const Frame& F, float* out, const float* gfin) {
    const bf16* x1b = (const bf16*)(F.ws + WS_X1B);
    const int lane = F.lane, gw = F.vcu * 8 + F.wave, NGW = F.G * 8;
    const unsigned* sot = (const unsigned*)(F.ws + WS_SOT); const bf16* ys = (const bf16*)(F.ws + WS_YS);
    f32x4 gv[4];
#pragma unroll
    for (int j = 0; j < 4; ++j) gv[j] = *(const f32x4*)(gfin + 4 * lane + 256 * j);
    u32x2 xn[4], y0n[4], y1n[4];
#define FIN_LOAD(r) do { const unsigned _s0 = sot[2 * (r)], _s1 = sot[2 * (r) + 1]; const u32x2* _x = (const u32x2*)(x1b + (size_t)(r) * 1024) + lane; \
        const u32x2* _y0 = (const u32x2*)(ys + (size_t)_s0 * 1024) + lane; const u32x2* _y1 = (const u32x2*)(ys + (size_t)_s1 * 1024) + lane; \
        _Pragma("unroll") for (int j = 0; j < 4; ++j) { xn[j] = _x[64 * j]; y0n[j] = _y0[64 * j]; y1n[j] = _y1[64 * j]; } } while (0)
    if (gw < NTOK) FIN_LOAD(gw);
    for (int row = gw; row < NTOK; row += NGW) {
        f32x4* xr = (f32x4*)(out + (size_t)row * 1024) + lane;
        f32x4 v[4]; float ss = 0.f;
#pragma unroll
        for (int j = 0; j < 4; ++j) { const u32x2 p = y0n[j], q = y1n[j], xw = xn[j];
            v[j] = (f32x4){bf_lo(xw.x), bf_hi(xw.x), bf_lo(xw.y), bf_hi(xw.y)} + (f32x4){bf_lo(p.x), bf_hi(p.x), bf_lo(p.y), bf_hi(p.y)} + (f32x4){bf_lo(q.x), bf_hi(q.x), bf_lo(q.y), bf_hi(q.y)}; ss += dot4(v[j], v[j]); }
        if (row + NGW < NTOK) FIN_LOAD(row + NGW);
        const float rstd = 1.f / sqrtf(wave_sum(ss) * (1.f / 1024.f) + RMS_EPS);
#pragma unroll
        for (int j = 0; j < 4; ++j) xr[64 * j] = v[j] * rstd * gv[j];
    }
#undef FIN_LOAD
}

__device__ __forceinline__ void stagger_delay(unsigned ticks) {
    if (ticks == 0u) return;
    const unsigned long long t0 = __builtin_amdgcn_s_memrealtime();
    while ((unsigned long long)__builtin_amdgcn_s_memrealtime() - t0 < (unsigned long long)ticks) __builtin_amdgcn_s_sleep(16);
}
#ifndef GEMM1_WGM
#define GEMM1_WGM 4
#endif
#ifndef STAG5
#define STAG5 400
#endif
#ifndef STAG1
#define STAG1 0
#endif
constexpr int N_PHASES = 10;
constexpr int KA_OUT = 128, KA_WS = 136, KA_LO = 144, KA_HI = 148;
#if defined(__HIP_DEVICE_COMPILE__)
__device__ __forceinline__ unsigned long long karg64(int off) { auto k = __builtin_amdgcn_kernarg_segment_ptr(); unsigned long long v;
    asm volatile("s_load_dwordx2 %0, %1, %2\n\ts_waitcnt lgkmcnt(0)" : "=s"(v) : "s"(k), "i"(off)); return v; }
__device__ __forceinline__ int karg32(int off) { auto k = __builtin_amdgcn_kernarg_segment_ptr(); int v;
    asm volatile("s_load_dword %0, %1, %2\n\ts_waitcnt lgkmcnt(0)" : "=s"(v) : "s"(k), "i"(off)); return v; }
#else
__device__ __forceinline__ unsigned long long karg64(int) { return 0ull; }
__device__ __forceinline__ int karg32(int) { return 0; }
#endif
#define KIN(i) ((const float*)(const GAS float*)karg64(8 * (i)))
#define KPTR(T, off) ((T*)(GAS T*)karg64(off))
__device__ __forceinline__ Frame make_frame(int wv) {
    extern __shared__ __attribute__((aligned(16))) unsigned char lds_raw[];
    Frame F; int bx = blockIdx.x, G = gridDim.x;
    asm volatile("" : "+s"(bx), "+s"(G), "+s"(wv));
    int tid = wv * 64 + (int)__builtin_amdgcn_mbcnt_hi(~0u, __builtin_amdgcn_mbcnt_lo(~0u, 0u));
    asm volatile("" : "+v"(tid));
    F.lds = (LAS unsigned char*)lds_raw; F.MISC = (volatile LAS unsigned*)(F.lds + MISC_OFF);
    F.tid = tid; F.lane = tid & 63; F.wave = __builtin_amdgcn_readfirstlane(tid >> 6);
    F.G = G; F.bx = bx; F.vcu = (G % 8 == 0) ? (bx % 8) * (G / 8) + bx / 8 : bx;
    F.ws = KPTR(unsigned char, KA_WS); F.ctl = (unsigned*)(F.ws + WS_CTL);
    return F;
}
__global__ void __launch_bounds__(512, 2) mk_fwd(Args args_unused) {
    const int wv = __builtin_amdgcn_readfirstlane((int)threadIdx.x >> 6);
    { Frame F = make_frame(wv); if (F.tid < 64) F.MISC[F.tid] = 0u; __syncthreads();
      if (MK_ONE_LAUNCH) (void)xcd_barrier_post(F.ctl + CW_BAR, F.MISC + 8); }
    const int lo = karg32(KA_LO), hi = karg32(KA_HI);
    if (PROBE_T >= 20) { Frame Fp = make_frame(wv); if (Fp.vcu == 5 && Fp.tid == 0) Fp.ctl[20020] = (unsigned)__builtin_amdgcn_s_memrealtime(); }
#define IN(k) (lo <= (k) && (k) < hi)
#define SEAM(k) do { if (IN(k) && IN((k) + 1)) { Frame Fb = make_frame(wv); XcdBarrier bar; bar.bar = Fb.ctl + CW_BAR; bar.x = xb_xcc_id(); bar.st = Fb.MISC + 8; xcd_barrier(bar); \
        if (PROBE_T >= 20 && Fb.vcu == 5 && Fb.tid == 0) Fb.ctl[20021 + (k)] = (unsigned)__builtin_amdgcn_s_memrealtime(); } } while (0)
#define GBAR() do { Frame Fb = make_frame(wv); XcdBarrier bar; bar.bar = Fb.ctl + CW_BAR; bar.x = xb_xcc_id(); bar.st = Fb.MISC + 8; xcd_barrier(bar); } while (0)
#define REP(k) for (int rep_ = 0; rep_ < (PROBE_DUP == (k) ? 2 : 1); ++rep_)
#define REPBAR(k) do { if (PROBE_DUP == (k) && rep_ == 0) GBAR(); } while (0)
    if (IN(0)) REP(7) { Frame F = make_frame(wv); Args a{}; for (int i = 0; i < 16; ++i) a.in[i] = KIN(i); p0_prologue(F, a); REPBAR(7); } SEAM(0);
    if (IN(1)) REP(1) {
        Frame F = make_frame(wv); bf16* gates = (bf16*)KPTR(float, KA_OUT);
        pg8::Gemm g{(const bf16*)(F.ws + WS_H), nullptr, (const bf16*)(F.ws + WS_WIN), nullptr, 2048, 2048, 16, 16, 128}; pg8::StaticOrder<false, PROBE_DUP == 9> S; S.init(NTOK, IN_W, F.G, F.bx, GEMM1_WGM);
        Epi1 E{(bf16*)(F.ws + WS_QKV), gates, gates + (size_t)NTOK * 1024, (PROBE_T && (F.vcu == 5 || PROBE_T >= 8)) ? (unsigned*)(F.ctl + 20000) : nullptr};
        stagger_delay(xb_xcc_id() * (unsigned)STAG1);
        pg8::gemm_phase<Epi1, pg8::StaticOrder<false, PROBE_DUP == 9>, false>(F.lds, F.tid, g, S, E, nullptr);
        REPBAR(1);
    }
    SEAM(1);
    if (IN(2)) REP(2) { Frame F = make_frame(wv); attn_phase(F, KIN(3)); REPBAR(2); }
    SEAM(2);
    if (IN(3)) REP(8) { Frame F = make_frame(wv); merge_phase(F); REPBAR(8); }
    SEAM(3);
    if (IN(4)) REP(3) {
        Frame F = make_frame(wv); const bf16* gates = (const bf16*)KPTR(float, KA_OUT); const bf16* qkv = (const bf16*)(F.ws + WS_QKV); const bf16* wbr = (const bf16*)(F.ws + WS_WBR);
        pg8::Gemm g{qkv + (COL_QS / 64) * TS, qkv + (COL_YDIL / 64) * TS, wbr, wbr + 1024, 128, 1536 * 2, 16, 8, TS * 2}; pg8::StaticOrder<true> S; S.init(NTOK, 1024, F.G, F.bx);
        EpiMix E{gates, gates + (size_t)NTOK * 1024, (bf16*)(F.ws + WS_QKV) + (COL_MIX / 64) * TS, (PROBE_T && F.vcu == 5) ? (unsigned*)(F.ctl + 20000) : nullptr};
        pg8::gemm_phase<EpiMix, pg8::StaticOrder<true>, false>(F.lds, F.tid, g, S, E, nullptr);
        REPBAR(3);
    }
    SEAM(4);
    if (IN(5)) REP(4) {
        Frame F = make_frame(wv);
        pg8::Gemm g{(const bf16*)(F.ws + WS_QKV) + (COL_MIX / 64) * TS, nullptr, (const bf16*)(F.ws + WS_WOUT), nullptr, 128, 2048, 16, 16, TS * 2}; pg8::StaticOrder<false> S; S.init(NTOK, 1024, F.G, F.bx, pg8::WGM, true);
        EpiRes E{(const bf16*)(F.ws + WS_H), (const float*)(F.ws + WS_RMS1), (bf16*)(F.ws + WS_X1B), (PROBE_T && F.vcu == 5) ? (unsigned*)(F.ctl + 20000) : nullptr};
        pg8::gemm_phase<EpiRes, pg8::StaticOrder<false>, false>(F.lds, F.tid, g, S, E, nullptr);
        REPBAR(4);
    }
    SEAM(5);
    if (IN(6)) { Frame F = make_frame(wv); router_phase(F, (const bf16*)(F.ws + WS_X1B), KIN(9), KIN(11)); }
    SEAM(6);
    if (IN(7)) { Frame F = make_frame(wv); slots_phase(F); }
    SEAM(7);
    if (IN(8)) REP(5) {
        Frame F = make_frame(wv);
        pg8::Gemm g{(const bf16*)(F.ws + WS_X1B), nullptr, (const bf16*)(F.ws + WS_WGU), nullptr, 2048, 2048, 16, 16, 128}; pg8::PanelOrder S; S.init((const unsigned*)(F.ws + WS_PEX), (volatile LAS int*)(F.lds + PANEL_TAB_OFF), F.G, F.vcu, F.tid);
        EpiGU E{(bf16*)(F.ws + WS_ACT), (const float*)(F.ws + WS_RSS)};
        pg8::gemm_phase<EpiGU, pg8::PanelOrder, true>(F.lds, F.tid, g, S, E, (const unsigned*)(F.ws + WS_TOS));
        REPBAR(5);
    }
    SEAM(8);
    if (IN(9)) REP(6) {
        Frame F = make_frame(wv);
        pg8::Gemm g{(const bf16*)(F.ws + WS_ACT), nullptr, (const bf16*)(F.ws + WS_WD), nullptr, 1024, 1024, 8, 8, 128}; pg8::PanelOrder S; S.init((const unsigned*)(F.ws + WS_PEX), (volatile LAS int*)(F.lds + PANEL_TAB_OFF), F.G, F.vcu, F.tid);
        S.rev = true;
        EpiDown E{(bf16*)(F.ws + WS_YS), (const float*)(F.ws + WS_WOS), (PROBE_T && F.vcu == 5) ? (unsigned*)(F.ctl + 20000) : nullptr};
        pg8::gemm_phase<EpiDown, pg8::PanelOrder, false>(F.lds, F.tid, g, S, E, nullptr);
        REPBAR(6);
    }
    SEAM(9);
    if (IN(10)) { Frame F = make_frame(wv); final_phase(F, KPTR(float, KA_OUT), KIN(15)); }
#if PROBE_T
    { Frame F = make_frame(wv);
      if (F.vcu == 5) { const unsigned kl = ld_agent(F.ctl + 20001), ep = ld_agent(F.ctl + 20002), cyc = ld_agent(F.ctl + 20003), tk = ld_agent(F.ctl + 20004);
        unsigned d = 0;
        if (PROBE_T == 5) d = (unsigned)((float)cyc / (float)tk * 100.f * 25.f);
        if (PROBE_T == 6) d = ep * 2u;
        if (PROBE_T == 7) d = kl;
        if (PROBE_T >= 20 && PROBE_T < 40) { const unsigned t1 = (PROBE_T - 20 == 10) ? (unsigned)__builtin_amdgcn_s_memrealtime() : ld_agent(F.ctl + 20021 + (PROBE_T - 20)); d = 4u * (t1 - ld_agent(F.ctl + 20020 + (PROBE_T - 20))); }
        if (PROBE_T >= 40 && PROBE_T < 46) d = 4u * ld_agent(F.ctl + 20040 + (PROBE_T - 40));
        if (PROBE_T == 8) d = ld_agent(F.ctl + 20010);
        if (PROBE_T == 9) d = 0x7fffffffu - ld_agent(F.ctl + 20011);
        stagger_delay(d > 200000u ? 200000u : d); } }
#endif
#undef IN
#undef SEAM
}

extern "C" void kernel_launch(void* const* d_in, const int* in_sizes, int n_in, void* d_out, int out_size, void* d_ws, size_t ws_size, hipStream_t stream) {
    static int grid = 0;
    if (grid == 0) {
        if (n_in != 16 || in_sizes[0] != NTOK * D || out_size != NTOK * D || ws_size < WS_END) { fprintf(stderr, "kernel_launch: unexpected shapes / workspace (%d inputs, ws %zu)\n", n_in, ws_size); grid = -1; return; }
        int dev = 0, cus = 0;
        if (hipGetDevice(&dev) != hipSuccess || hipDeviceGetAttribute(&cus, hipDeviceAttributeMultiprocessorCount, dev) != hipSuccess) { grid = -1; return; }
        if (hipFuncSetAttribute((const void*)mk_fwd, hipFuncAttributeMaxDynamicSharedMemorySize, LDS_BYTES) != hipSuccess) { fprintf(stderr, "kernel_launch: hipFuncSetAttribute(%d) failed\n", LDS_BYTES); grid = -1; return; }
        int per_cu = 0;
        if (hipOccupancyMaxActiveBlocksPerMultiprocessor(&per_cu, (const void*)mk_fwd, 512, LDS_BYTES) != hipSuccess || per_cu < 1) { fprintf(stderr, "kernel_launch: occupancy query says %d\n", per_cu); }
        (void)hipGetLastError();
        int g = 64; while (g * 2 <= cus && g * 2 <= 256) g *= 2;
        grid = g;
    }
    if (grid < 0) return;
    (void)hipMemsetAsync((char*)d_ws + WS_CTL, 0, CTL_ZERO_BYTES, stream);
    Args a{};
    for (int i = 0; i < 16; ++i) a.in[i] = (const float*)d_in[i];
    a.out = (float*)d_out; a.ws = (unsigned char*)d_ws;
#if MK_ONE_LAUNCH
    a.ph_lo = 0; a.ph_hi = N_PHASES + 1;
    hipLaunchKernelGGL(mk_fwd, dim3(grid), dim3(512), LDS_BYTES, stream, a);
#else
    for (int p = 0; p <= N_PHASES; ++p) { a.ph_lo = p; a.ph_hi = p + 1; hipLaunchKernelGGL(mk_fwd, dim3(grid), dim3(512), LDS_BYTES, stream, a); }
#endif
}
```

```cpp
#include <hip/hip_runtime.h>
#include <cstdio>
#include <cstdint>

#ifndef PROBE_T
#define PROBE_T 0
#endif
#ifndef PROBE_P0
#define PROBE_P0 0
#endif
#ifndef PROBE_EPI
#define PROBE_EPI 1
#endif
#ifndef PROBE_DUP
#define PROBE_DUP 0
#endif
#ifndef MK_ONE_LAUNCH
#define MK_ONE_LAUNCH 1
#endif

#define LAS __attribute__((address_space(3)))
#define GAS __attribute__((address_space(1)))
typedef unsigned short bf16;
typedef short bf16x8 __attribute__((ext_vector_type(8)));
typedef short s16x4 __attribute__((ext_vector_type(4)));
typedef float f32x4 __attribute__((ext_vector_type(4)));
typedef float f32x16 __attribute__((ext_vector_type(16)));
typedef unsigned u32x4 __attribute__((ext_vector_type(4)));
typedef unsigned u32x2 __attribute__((ext_vector_type(2)));
typedef float f32x2_t __attribute__((ext_vector_type(2)));
typedef __bf16 bf16x2_t __attribute__((ext_vector_type(2)));
typedef GAS unsigned gu32;

constexpr int NB = 8, T = 8192, D = 1024, NTOK = NB * T;
constexpr int QKV_W = 5888;
constexpr int IN_W = 7936;
constexpr int COL_KD = 1536, COL_VD = 3072, COL_QS = 4608, COL_KS = 5632, COL_VS = 5760;
constexpr int NEXP = 32, DEXP = 512;
constexpr int SLOT_ROWS = 2 * NTOK + NEXP * 256;
constexpr int MAX_PANELS = SLOT_ROWS / 256;
constexpr float RMS_EPS = 1e-6f;
constexpr float LOG2E = 1.4426950408889634f, LN2 = 0.6931471805599453f;
constexpr float QSCALE = 0.125f * LOG2E;

constexpr size_t MiB = 1u << 20;
constexpr size_t WS_CTL = 0, CTL_ZERO_BYTES = 128 * 1024;
constexpr size_t WS_WIN = 1 * MiB;
constexpr size_t WS_WBR = 17 * MiB;
constexpr size_t WS_WOUT = 20 * MiB;
constexpr size_t WS_WGU = 22 * MiB;
constexpr size_t WS_WD = 86 * MiB;
constexpr size_t WS_WRT = 118 * MiB;
constexpr size_t WS_RE = 119 * MiB;
constexpr size_t WS_RREL = WS_RE + 256 * 1024;
constexpr size_t WS_RW = WS_RREL + 512 * 1024;
constexpr size_t WS_RMS1 = WS_RW + 512 * 1024;
constexpr size_t WS_RSTD2 = WS_RMS1 + 256 * 1024;
constexpr size_t WS_RSS = 125 * MiB;
constexpr size_t WS_TOS = 121 * MiB;
constexpr size_t WS_WOS = 122 * MiB;
constexpr size_t WS_SOT = 123 * MiB;
constexpr size_t WS_PEX = 124 * MiB;
constexpr size_t WS_H = 128 * MiB;
constexpr size_t WS_QKV = 256 * MiB;
constexpr size_t WS_LSE = 992 * MiB;
constexpr size_t WS_ACT = 256 * MiB;
constexpr size_t WS_YS = 392 * MiB;
constexpr size_t WS_X1B = 672 * MiB;
constexpr size_t WS_END = 1000 * MiB;
constexpr int COL_YDIL = 1536, COL_MIX = 0;
constexpr size_t TS = (size_t)NTOK * 64;
static_assert(WS_QKV + (size_t)NTOK * QKV_W * 2 <= WS_LSE && WS_LSE + (size_t)NTOK * 24 * 4 <= WS_END, "qkv/lse map");
static_assert(WS_ACT + (size_t)SLOT_ROWS * 512 * 2 <= WS_YS && WS_YS + (size_t)SLOT_ROWS * 1024 * 2 <= WS_LSE, "moe overlay");
constexpr int CW_BAR = 4096;
constexpr int CW_CNT = 8192;

constexpr int LDS_BYTES = 155648;
constexpr int MISC_OFF = LDS_BYTES - 256;
constexpr int PANEL_TAB_OFF = 131072 + 1024;
constexpr int P5_CNT_OFF = 147456, P5_BASE_OFF = P5_CNT_OFF + 128, P5_REC_OFF = P5_BASE_OFF + 128;

#define RLX_AGENT __ATOMIC_RELAXED, __HIP_MEMORY_SCOPE_AGENT
#define LDS_WAIT() asm volatile("s_waitcnt lgkmcnt(0)" ::: "memory")
__device__ __forceinline__ unsigned cvtpk(float lo, float hi) { f32x2_t v = {lo, hi}; bf16x2_t b = __builtin_convertvector(v, bf16x2_t); return __builtin_bit_cast(unsigned, b); }
__device__ __forceinline__ float bf_lo(unsigned u) { return __builtin_bit_cast(float, u << 16); }
__device__ __forceinline__ float bf_hi(unsigned u) { return __builtin_bit_cast(float, u & 0xffff0000u); }
__device__ __forceinline__ unsigned ld_agent(const unsigned* p) { return __hip_atomic_load(p, RLX_AGENT); }
template <int CTRL> __device__ __forceinline__ float dpp(float x) { return __builtin_bit_cast(float, __builtin_amdgcn_mov_dpp(__builtin_bit_cast(int, x), CTRL, 0xf, 0xf, true)); }
__device__ __forceinline__ float wave_sum(float v) {
    v += dpp<0xB1>(v); v += dpp<0x4E>(v); v += dpp<0x141>(v); v += dpp<0x140>(v);
    const int iv = __builtin_bit_cast(int, v);
    const float r0 = __builtin_bit_cast(float, __builtin_amdgcn_readlane(iv, 0)), r1 = __builtin_bit_cast(float, __builtin_amdgcn_readlane(iv, 16));
    const float r2 = __builtin_bit_cast(float, __builtin_amdgcn_readlane(iv, 32)), r3 = __builtin_bit_cast(float, __builtin_amdgcn_readlane(iv, 48));
    return (r0 + r1) + (r2 + r3);
}

namespace pg8 {
constexpr int BM = 256, BK = 64, HALF = 128, HTB = HALF * BK * 2, STAGE_BYTES = 8 * HTB, NXCD = 8, WGM = 8;
__host__ __device__ __forceinline__ int lds_byte(int r, int c) { const int st = (r >> 4) * 2 + (c >> 5), rr = r & 15, cc = c & 31, ob = rr * 64 + cc * 2; return st * 1024 + (ob ^ (((ob >> 9) & 1) << 5)); }
__host__ __device__ __forceinline__ void stage_rc(int b, int& R, int& C) { const int st = b / 1024, sb = b % 1024, swz = sb ^ (((sb >> 9) & 1) << 5); R = (st >> 1) * 16 + swz / 64; C = (st & 1) * 32 + (swz % 64) / 2; }
__host__ __device__ __forceinline__ int perm32(int rho) { const int n = rho >> 4, i = rho & 15; return 8 * (i >> 2) + 4 * n + (i & 3); }

struct Unit { int pm, pn, part, skip; };
struct Gemm { const bf16* A0; const bf16* A1; const bf16* B0; const bf16* B1; int lda, ldb, nt0, nt1; size_t kstepA; };

template <bool CHAIN, bool KDUP = false> struct StaticOrder {
    int nM, nN, nwg, G, c, wgm, nmine;
    __device__ void init(int M, int N, int G_, int c_, int wgm_ = WGM, bool rev = false) { nM = M / BM; nN = N / BM; nwg = nM * nN; G = G_; c = c_; wgm = wgm_; nmine = rev ? (nwg - c_ + G_ - 1) / G_ : 0; }
    __device__ bool next(int i, Unit& u) const {
        int it = (CHAIN || KDUP) ? (i >> 1) : i; u.part = CHAIN ? (i & 1) : 0; u.skip = KDUP ? !(i & 1) : 0;
        if (nmine > 0) { if (it >= nmine) return false; it = nmine - 1 - it; }
        const long L = (long)it * G + c; if (L >= nwg) return false;
        int wgid = (int)L; { const int q = nwg / NXCD, r = nwg % NXCD, xcd = wgid % NXCD, off = wgid / NXCD; wgid = (xcd < r ? xcd * (q + 1) : r * (q + 1) + (xcd - r) * q) + off; }
        const int nig = wgm * nN, gid = wgid / nig, fm = gid * wgm, gsz = (nM - fm) < wgm ? (nM - fm) : wgm;
        u.pm = fm + ((wgid % nig) % gsz); u.pn = (wgid % nig) / gsz; return true;
    }
};
struct PanelOrder {
    volatile LAS int* tab; int np4, G, c;
    __device__ void init(const unsigned* pex, volatile LAS int* tab_, int G_, int vcu, int tid) {
        tab = tab_; G = G_; c = vcu; np4 = 4 * __builtin_amdgcn_readfirstlane((int)ld_agent(pex + 1023));
        if (tid < 64) { const int L = tid * G_ + vcu; tab_[tid] = (L < np4) ? (int)ld_agent(pex + (L >> 2)) : 0; }
        __syncthreads();
    }
    bool rev = false;
    __device__ bool next(int i0, Unit& u) const {
        int i = i0;
        if (rev) { const int n = (np4 - c + G - 1) / G; if (i0 >= n) return false; i = n - 1 - i0; }
        const int L = i * G + c; if (L >= np4 || i >= 64) return false;
        u.pm = L >> 2; u.pn = 4 * __builtin_amdgcn_readfirstlane(tab[i]) + (L & 3); u.part = 0; u.skip = 0; return true;
    }
};

template <class Epi, class Sched, bool GATHER>
__device__ __forceinline__ void gemm_phase(LAS unsigned char* lds, const int tid, const Gemm g, const Sched& S, const Epi& E, const unsigned* rowidx) {
    const int wid = __builtin_amdgcn_readfirstlane(tid >> 6), lane = tid & 63, wr = wid >> 2, wc = wid & 3, fr = lane & 15, fq = lane >> 4;
    int Rr[2], Cc[2]; unsigned voffB[2];
#pragma unroll
    for (int i = 0; i < 2; ++i) { stage_rc(tid * 16 + i * 8192, Rr[i], Cc[i]); const int Rb = (Rr[i] & ~31) + perm32(Rr[i] & 31); voffB[i] = (unsigned)(Rb * g.ldb + Cc[i] * 2); }
    const size_t kstep = (size_t)(BK * 2), kA = g.kstepA;
    const size_t hstep = (size_t)HALF * g.ldb;
    const size_t tstepA = (size_t)BM * g.lda, tstepB = (size_t)BM * g.ldb;
    const unsigned ldsw = (unsigned)wid * 1024u;
    const int aoff = lds_byte(wr * 64 + fr, fq * 8), boff = lds_byte(wc * 32 + fr, fq * 8);
    unsigned vc[2][2], vn[2][2];
#define PG8_SA(b, h) (((b) * 2 + (h)) * HTB)
#define PG8_SB(b, h) ((4 + (b) * 2 + (h)) * HTB)
#define PG8_STAGE(bufoff, gbase, voff) do { _Pragma("unroll") for (int _i = 0; _i < 2; ++_i) \
        __builtin_amdgcn_global_load_lds((const unsigned*)((const char*)(gbase) + (voff)[_i]), (LAS unsigned*)(lds + (bufoff) + ldsw + _i * 8192), 16, 0, 0); } while (0)
#define PG8_LDA(dst, b, h) do { _Pragma("unroll") for (int m = 0; m < 4; ++m) _Pragma("unroll") for (int k = 0; k < 2; ++k) dst[m][k] = *(const LAS bf16x8*)(lds + PG8_SA(b, h) + aoff + m * 2048 + k * 1024); } while (0)
#define PG8_LDB(dst, b, h) do { _Pragma("unroll") for (int n = 0; n < 2; ++n) _Pragma("unroll") for (int k = 0; k < 2; ++k) dst[n][k] = *(const LAS bf16x8*)(lds + PG8_SB(b, h) + boff + n * 2048 + k * 1024); } while (0)
#define PG8_MMA(ai, bj, At, Bt) do { __builtin_amdgcn_s_setprio(1); _Pragma("unroll") for (int m = 0; m < 4; ++m) _Pragma("unroll") for (int n = 0; n < 2; ++n) _Pragma("unroll") for (int k = 0; k < 2; ++k) \
        acc[ai][bj][m][n] = __builtin_amdgcn_mfma_f32_16x16x32_bf16(Bt[n][k], At[m][k], acc[ai][bj][m][n], 0, 0, 0); __builtin_amdgcn_s_setprio(0); } while (0)
#define PG8_WAIT_V(n) asm volatile("s_waitcnt vmcnt(" #n ")" ::: "memory")
#define PG8_WAIT_L(n) asm volatile("s_waitcnt lgkmcnt(" #n ")" ::: "memory")
#define PG8_BAR __builtin_amdgcn_s_barrier()
#define PG8_SCHED __builtin_amdgcn_sched_barrier(0)
#define PG8_VOFFS(v, u) do { _Pragma("unroll") for (int _h = 0; _h < 2; ++_h) _Pragma("unroll") for (int _i = 0; _i < 2; ++_i) { \
        if (GATHER) { const unsigned _t = rowidx[(u).pm * BM + _h * HALF + Rr[_i]]; v[_h][_i] = _t * (unsigned)g.lda + (unsigned)(Cc[_i] * 2); } \
        else v[_h][_i] = (unsigned)((_h * HALF + Rr[_i]) * g.lda + Cc[_i] * 2); } } while (0)
#define PG8_ZERO() do { _Pragma("unroll") for (int a = 0; a < 2; ++a) _Pragma("unroll") for (int b = 0; b < 2; ++b) _Pragma("unroll") for (int m = 0; m < 4; ++m) _Pragma("unroll") for (int n = 0; n < 2; ++n) acc[a][b][m][n] = (f32x4){0.f, 0.f, 0.f, 0.f}; } while (0)
    Unit cur, nxt; int ui = 0;
    if (!S.next(0, cur)) return;
#if PROBE_T
#define PT_NOW() (Epi::PROBE ? (unsigned)__builtin_amdgcn_s_memrealtime() : 0u)
    unsigned pt_first = 0, pt_rest = 0, pt_epi = 0, pt0 = 0, pt1 = 0, pt2 = 0;
    const unsigned pc_c0 = Epi::PROBE ? (unsigned)__builtin_amdgcn_s_memtime() : 0u, pc_t0 = PT_NOW();
#endif
    f32x4 acc[2][2][4][2];
    PG8_ZERO();
    bf16x8 At[4][2], B0[2][2], B1[2][2];
    PG8_VOFFS(vc, cur);
    const char* cA = GATHER ? (const char*)g.A0 : (const char*)(cur.part ? g.A1 : g.A0) + (size_t)cur.pm * tstepA; const char* cB = (const char*)(cur.part ? g.B1 : g.B0) + (size_t)cur.pn * tstepB;
    int nt = cur.part ? g.nt1 : g.nt0;
    PG8_STAGE(PG8_SB(0, 0), cB, voffB); PG8_STAGE(PG8_SB(0, 1), cB + hstep, voffB); PG8_STAGE(PG8_SA(0, 0), cA, vc[0]); PG8_STAGE(PG8_SA(0, 1), cA, vc[1]);
    if (wr == 1) PG8_BAR;
    PG8_WAIT_V(2); PG8_BAR;
    PG8_STAGE(PG8_SB(1, 0), cB + kstep, voffB); PG8_STAGE(PG8_SA(1, 0), cA + kA, vc[0]); PG8_STAGE(PG8_SB(1, 1), cB + hstep + kstep, voffB);
    PG8_WAIT_V(6); PG8_BAR;
    for (;;) {
        const bool has_next = S.next(ui + 1, nxt);
        const char* nA = GATHER ? (const char*)g.A0 : (has_next ? (const char*)(nxt.part ? g.A1 : g.A0) + (size_t)nxt.pm * tstepA : cA);
        const char* nB = has_next ? (const char*)(nxt.part ? g.B1 : g.B0) + (size_t)nxt.pn * tstepB : cB;
        if constexpr (GATHER) {
            if (has_next) { PG8_VOFFS(vn, nxt); } else {
#pragma unroll
                for (int h = 0; h < 2; ++h)
#pragma unroll
                    for (int i = 0; i < 2; ++i) vn[h][i] = vc[h][i]; }
        }
#if PROBE_T
        pt0 = PT_NOW();
#endif
        for (int t = 0; t < nt; t += 2) {
            const bool last = (t == nt - 2);
            const char* a1 = cA + (size_t)(t + 1) * kA;
            const char* a2 = last ? nA : cA + (size_t)(t + 2) * kA; const char* b2 = last ? nB : cB + (size_t)(t + 2) * kstep;
            const char* a3 = a2 + kA; const char* b3 = b2 + kstep;
            unsigned v2[2][2];
#pragma unroll
            for (int h = 0; h < 2; ++h)
#pragma unroll
                for (int i = 0; i < 2; ++i) { if constexpr (GATHER) v2[h][i] = last ? vn[h][i] : vc[h][i]; else v2[h][i] = vc[h][i]; }
            PG8_LDB(B0, 0, 0); PG8_LDB(B1, 0, 1); PG8_SCHED; PG8_LDA(At, 0, 0); PG8_STAGE(PG8_SA(1, 1), a1, vc[1]);
            PG8_WAIT_V(8); PG8_WAIT_L(0); PG8_BAR; PG8_MMA(0, 0, At, B0); PG8_MMA(0, 1, At, B1); PG8_BAR; PG8_SCHED;
            PG8_LDA(At, 0, 1); PG8_STAGE(PG8_SB(0, 0), b2, voffB); PG8_STAGE(PG8_SB(0, 1), b2 + hstep, voffB); PG8_STAGE(PG8_SA(0, 0), a2, v2[0]);
            PG8_WAIT_V(8); PG8_WAIT_L(0); PG8_BAR; PG8_MMA(1, 0, At, B0); PG8_MMA(1, 1, At, B1); PG8_BAR; PG8_SCHED;
            PG8_LDB(B0, 1, 0); PG8_LDB(B1, 1, 1); PG8_SCHED; PG8_LDA(At, 1, 0); PG8_STAGE(PG8_SA(0, 1), a2, v2[1]);
            PG8_WAIT_V(8); PG8_WAIT_L(0); PG8_BAR; PG8_MMA(0, 0, At, B0); PG8_MMA(0, 1, At, B1); PG8_BAR; PG8_SCHED;
            PG8_LDA(At, 1, 1); PG8_STAGE(PG8_SB(1, 0), b3, voffB); PG8_STAGE(PG8_SB(1, 1), b3 + hstep, voffB); PG8_STAGE(PG8_SA(1, 0), a3, v2[0]);
            PG8_WAIT_V(8); PG8_WAIT_L(0); PG8_BAR; PG8_MMA(1, 0, At, B0); PG8_MMA(1, 1, At, B1); PG8_BAR; PG8_SCHED;
        }
#if PROBE_T
        pt2 = PT_NOW(); pt_rest += pt2 - pt0;
#endif
        if (wr == 0) PG8_BAR;
        bool mid = false;
        if constexpr (Epi::CHAINED) mid = (cur.part == 0);
        if (mid) { if constexpr (Epi::CHAINED) E.mid(acc, cur, wr, wc, fr, fq); } else if (!cur.skip) { E(acc, cur, wr, wc, fr, fq); if (PROBE_DUP == 10 && Epi::PROBE10) { asm volatile("" ::: "memory"); E(acc, cur, wr, wc, fr, fq); } }
#if PROBE_T
        pt_epi += PT_NOW() - pt2;
#endif
        if (!has_next) break;
        if (!mid) PG8_ZERO();
        cur = nxt; cA = nA; cB = nB; nt = cur.part ? g.nt1 : g.nt0; ++ui;
        if constexpr (GATHER) {
#pragma unroll
            for (int h = 0; h < 2; ++h)
#pragma unroll
                for (int i = 0; i < 2; ++i) vc[h][i] = vn[h][i];
        }
        if (wr == 1) PG8_BAR;
    }
    PG8_WAIT_V(0);
    PG8_BAR;
#if PROBE_T
    if constexpr (Epi::PROBE) { if (E.probe_out && tid == 0) { E.probe_out[0] = pt_first; E.probe_out[1] = pt_rest; E.probe_out[2] = pt_epi; E.probe_out[3] = (unsigned)__builtin_amdgcn_s_memtime() - pc_c0; E.probe_out[4] = PT_NOW() - pc_t0;
        if (PROBE_T >= 8) { atomicMax(E.probe_out + 10, PT_NOW() - pc_t0); atomicMax(E.probe_out + 11, 0x7fffffffu - (PT_NOW() - pc_t0)); } } }
#endif
#undef PG8_SA
#undef PG8_SB
#undef PG8_STAGE
#undef PG8_LDA
#undef PG8_LDB
#undef PG8_MMA
#undef PG8_WAIT_V
#undef PG8_WAIT_L
#undef PG8_BAR
#undef PG8_SCHED
#undef PG8_VOFFS
#undef PG8_ZERO
}
}

__device__ __forceinline__ float sigmoidf_fast(float a) { return __builtin_amdgcn_rcpf(1.f + __builtin_amdgcn_exp2f(-a * LOG2E)); }
__device__ __forceinline__ u32x4 pack8(const f32x4 a, const f32x4 b) { u32x4 w; w.x = cvtpk(a[0], a[1]); w.y = cvtpk(a[2], a[3]); w.z = cvtpk(b[0], b[1]); w.w = cvtpk(b[2], b[3]); return w; }
__device__ __forceinline__ void unpack8(const u32x4 w, f32x4& a, f32x4& b) { a = (f32x4){bf_lo(w.x), bf_hi(w.x), bf_lo(w.y), bf_hi(w.y)}; b = (f32x4){bf_lo(w.z), bf_hi(w.z), bf_lo(w.w), bf_hi(w.w)}; }
typedef const f32x4 (&AccRef)[2][2][4][2];
typedef f32x4 (&AccMut)[2][2][4][2];

struct Epi1 {
    static constexpr bool CHAINED = false; static constexpr bool PROBE = (PROBE_T != 0 && PROBE_EPI == 1); static constexpr bool PROBE10 = true;
    bf16* qkv; bf16* sgd; bf16* sgs; unsigned* probe_out;
    __device__ __forceinline__ void operator()(AccRef acc, const pg8::Unit& u, int wr, int wc, int fr, int fq) const {
        const int pn = u.pn;
        if (pn < 23) {
            int sh = 0; float sc = 1.f;
            if (pn < 18) { sh = 2 * ((pn % 6) >> 1); if (pn < 6) sc = QSCALE; } else if (pn < 22) sc = QSCALE;
            const int col0 = pn * 256 + wc * 32 + fq * 8;
#pragma unroll
            for (int ai = 0; ai < 2; ++ai)
#pragma unroll
                for (int m = 0; m < 4; ++m) {
                    const int row = u.pm * 256 + ai * 128 + wr * 64 + m * 16 + fr, t = row & (T - 1);
                    const int rowp = (row & ~(T - 1)) | ((t & ((1 << sh) - 1)) << (13 - sh)) | (t >> sh);
                    bf16* rp = qkv + (size_t)(col0 >> 6) * TS + (size_t)rowp * 64 + (col0 & 63);
#pragma unroll
                    for (int bj = 0; bj < 2; ++bj) *(u32x4*)(rp + bj * 2 * TS) = pack8(acc[ai][bj][m][0] * sc, acc[ai][bj][m][1] * sc);
                }
        } else {
            const int col0 = (pn - 23) * 128 + wc * 32 + fq * 8;
#pragma unroll
            for (int ai = 0; ai < 2; ++ai)
#pragma unroll
                for (int m = 0; m < 4; ++m) {
                    const size_t off = (size_t)(u.pm * 256 + ai * 128 + wr * 64 + m * 16 + fr) * 1024 + col0;
#pragma unroll
                    for (int bj = 0; bj < 2; ++bj) { f32x4 a = acc[ai][bj][m][0], b = acc[ai][bj][m][1];
#pragma unroll
                        for (int i = 0; i < 4; ++i) { a[i] = sigmoidf_fast(a[i]); b[i] = sigmoidf_fast(b[i]); }
                        *(u32x4*)((bj ? sgs : sgd) + off) = pack8(a, b); }
                }
        }
    }
};
struct EpiMix {
    static constexpr bool CHAINED = true; static constexpr bool PROBE = (PROBE_T != 0 && PROBE_EPI == 4); static constexpr bool PROBE10 = false;
    const bf16* sgd; const bf16* sgs; bf16* mix; unsigned* probe_out;
    __device__ __forceinline__ void mid(AccMut acc, const pg8::Unit& u, int wr, int wc, int fr, int fq) const {
#pragma unroll
        for (int ai = 0; ai < 2; ++ai)
#pragma unroll
            for (int m = 0; m < 4; ++m) {
                const size_t off = (size_t)(u.pm * 256 + ai * 128 + wr * 64 + m * 16 + fr) * 1024 + u.pn * 256 + wc * 32 + fq * 8;
#pragma unroll
                for (int bj = 0; bj < 2; ++bj) { f32x4 da, db, sa, sb; unpack8(*(const u32x4*)(sgd + off + bj * 128), da, db); unpack8(*(const u32x4*)(sgs + off + bj * 128), sa, sb);
#pragma unroll
                    for (int i = 0; i < 4; ++i) { acc[ai][bj][m][0][i] *= sa[i] * __builtin_amdgcn_rcpf(fmaxf(da[i], 1e-20f)); acc[ai][bj][m][1][i] *= sb[i] * __builtin_amdgcn_rcpf(fmaxf(db[i], 1e-20f)); } }
            }
    }
    __device__ __forceinline__ void operator()(AccRef acc, const pg8::Unit& u, int wr, int wc, int fr, int fq) const {
        u32x4 gd[2][4][2];
#pragma unroll
        for (int ai = 0; ai < 2; ++ai)
#pragma unroll
            for (int m = 0; m < 4; ++m) {
                const size_t off = (size_t)(u.pm * 256 + ai * 128 + wr * 64 + m * 16 + fr) * 1024 + u.pn * 256 + wc * 32 + fq * 8;
#pragma unroll
                for (int bj = 0; bj < 2; ++bj) gd[ai][m][bj] = *(const u32x4*)(sgd + off + bj * 128);
            }
        __builtin_amdgcn_sched_barrier(0);
#pragma unroll
        for (int ai = 0; ai < 2; ++ai)
#pragma unroll
            for (int m = 0; m < 4; ++m) {
                const size_t row = (size_t)(u.pm * 256 + ai * 128 + wr * 64 + m * 16 + fr); const int col = u.pn * 256 + wc * 32 + fq * 8;
#pragma unroll
                for (int bj = 0; bj < 2; ++bj) { f32x4 da, db; unpack8(gd[ai][m][bj], da, db);
#pragma unroll
                    for (int i = 0; i < 4; ++i) { da[i] = fmaxf(da[i], 1e-20f); db[i] = fmaxf(db[i], 1e-20f); }
                    *(u32x4*)(mix + (size_t)((col >> 6) + 2 * bj) * TS + row * 64 + (col & 63)) = pack8(da * acc[ai][bj][m][0], db * acc[ai][bj][m][1]); }
            }
    }
};
struct EpiRes {
    static constexpr bool CHAINED = false; static constexpr bool PROBE = (PROBE_T != 0 && PROBE_EPI == 5); static constexpr bool PROBE10 = false;
    const bf16* hx; const float* rms; bf16* x1b; unsigned* probe_out;
    __device__ __forceinline__ void operator()(AccRef acc, const pg8::Unit& u, int wr, int wc, int fr, int fq) const {
        u32x4 xv[2][4][2]; float rm[2][4];
#pragma unroll
        for (int ai = 0; ai < 2; ++ai)
#pragma unroll
            for (int m = 0; m < 4; ++m) {
                const int row = u.pm * 256 + ai * 128 + wr * 64 + m * 16 + fr;
                const size_t off = (size_t)row * 1024 + u.pn * 256 + wc * 32 + fq * 8;
                rm[ai][m] = rms[row];
#pragma unroll
                for (int bj = 0; bj < 2; ++bj) xv[ai][m][bj] = *(const u32x4*)(hx + off + bj * 128);
            }
        __builtin_amdgcn_sched_barrier(0);
#pragma unroll
        for (int ai = 0; ai < 2; ++ai)
#pragma unroll
            for (int m = 0; m < 4; ++m) {
                const size_t off = (size_t)(u.pm * 256 + ai * 128 + wr * 64 + m * 16 + fr) * 1024 + u.pn * 256 + wc * 32 + fq * 8;
#pragma unroll
                for (int bj = 0; bj < 2; ++bj) { f32x4 a, b; unpack8(xv[ai][m][bj], a, b);
                    *(u32x4*)(x1b + off + bj * 128) = pack8(a * rm[ai][m] + acc[ai][bj][m][0], b * rm[ai][m] + acc[ai][bj][m][1]); }
            }
    }
};
struct EpiGU {
    static constexpr bool CHAINED = false; static constexpr bool PROBE = false; static constexpr bool PROBE10 = false;
    bf16* act; const float* rss;
    __device__ __forceinline__ void operator()(AccRef acc, const pg8::Unit& u, int wr, int wc, int fr, int fq) const {
        const int col0 = (u.pn & 3) * 128 + wc * 32 + fq * 8;
        float rs[2][4];
#pragma unroll
        for (int ai = 0; ai < 2; ++ai)
#pragma unroll
            for (int m = 0; m < 4; ++m) rs[ai][m] = rss[u.pm * 256 + ai * 128 + wr * 64 + m * 16 + fr];
        __builtin_amdgcn_sched_barrier(0);
#pragma unroll
        for (int ai = 0; ai < 2; ++ai)
#pragma unroll
            for (int m = 0; m < 4; ++m) {
                const size_t off = (size_t)(u.pm * 256 + ai * 128 + wr * 64 + m * 16 + fr) * DEXP + col0;
                f32x4 o[2];
#pragma unroll
                for (int n = 0; n < 2; ++n)
#pragma unroll
                    for (int i = 0; i < 4; ++i) { const float gt = acc[ai][0][m][n][i] * rs[ai][m]; o[n][i] = gt * sigmoidf_fast(gt) * (acc[ai][1][m][n][i] * rs[ai][m]); }
                *(u32x4*)(act + off) = pack8(o[0], o[1]);
            }
    }
};
struct EpiDown {
    static constexpr bool CHAINED = false; static constexpr bool PROBE = (PROBE_T != 0 && PROBE_EPI == 9); static constexpr bool PROBE10 = false;
    bf16* ys; const float* wos; unsigned* probe_out;
    __device__ __forceinline__ void operator()(AccRef acc, const pg8::Unit& u, int wr, int wc, int fr, int fq) const {
        float wv[2][4];
#pragma unroll
        for (int ai = 0; ai < 2; ++ai)
#pragma unroll
            for (int m = 0; m < 4; ++m) wv[ai][m] = wos[u.pm * 256 + ai * 128 + wr * 64 + m * 16 + fr];
        __builtin_amdgcn_sched_barrier(0);
#pragma unroll
        for (int ai = 0; ai < 2; ++ai)
#pragma unroll
            for (int m = 0; m < 4; ++m) {
                const int row = u.pm * 256 + ai * 128 + wr * 64 + m * 16 + fr;
                const size_t off = (size_t)row * 1024 + (u.pn & 3) * 256 + wc * 32 + fq * 8;
#pragma unroll
                for (int bj = 0; bj < 2; ++bj) *(u32x4*)(ys + off + bj * 128) = pack8(acc[ai][bj][m][0] * wv[ai][m], acc[ai][bj][m][1] * wv[ai][m]);
            }
    }
};

namespace att {
constexpr int VPITCH = 128, KROWS = 384, LDS_K = 0, LDS_V = KROWS * 128;
static_assert(LDS_V + 2 * KROWS * VPITCH <= 147456, "attention LDS: K image + two V images");
#define MFMA32(a, b, c) __builtin_amdgcn_mfma_f32_32x32x16_bf16((a), (b), (c), 0, 0, 0)
typedef short v4i16_t __attribute__((ext_vector_type(4)));
__device__ __forceinline__ s16x4 vtr(const LAS unsigned char* p) { return __builtin_bit_cast(s16x4, __builtin_amdgcn_ds_read_tr16_b64_v4i16((LAS v4i16_t*)p)); }

struct UnitDesc {
    const bf16* rb;
    int qcol, kcol, vcol;
    int has_prev, nh, mixer, head0, dil;
    int ltok0, lstride;
};
template <bool ISV> __device__ __forceinline__ void dma_image(LAS unsigned char* img, const bf16* g0  , const int w, const int lane, const bool has_prev) {
#pragma unroll
    for (int j = 0; j < 6; ++j) {
        if (j >= 2 || has_prev) {
            const int pi = w + 8 * j, r = 8 * pi + (lane >> 3), cp = lane & 7, c = ISV ? (cp ^ (((r >> 1) & 1) << 2)) : (cp ^ ((r >> 1) & 7));
            __builtin_amdgcn_global_load_lds((const unsigned*)(g0 + (ptrdiff_t)(r - 128) * 64 + c * 8), (LAS unsigned*)(img + pi * 1024), 16, 0, 0);
        }
    }
}
#define ATT_WAIT_V(n) asm volatile("s_waitcnt vmcnt(" #n ")" ::: "memory")
#define ATT_BAR() do { asm volatile("s_waitcnt lgkmcnt(0)" ::: "memory"); __builtin_amdgcn_s_barrier(); asm volatile("" ::: "memory"); } while (0)
__device__ __forceinline__ void attn_unit(LAS unsigned char* lds, const int tid, const UnitDesc& U, const float* sinks, float* lse, const bool has_next, const UnitDesc& Un, bf16x8 (&qn)[4], const int vpar, unsigned (&pt)[6]) {
#define APT(i) do { if (PROBE_T >= 40) { const unsigned _n = (unsigned)__builtin_amdgcn_s_memrealtime(); pt[i] += _n - ptl; ptl = _n; } } while (0)
    unsigned ptl = (PROBE_T >= 40) ? (unsigned)__builtin_amdgcn_s_memrealtime() : 0u;
    const int w = __builtin_amdgcn_readfirstlane(tid >> 6), lane = tid & 63, ql = lane & 31, h = lane >> 5;
    const int cstart = U.has_prev ? 0 : (w < 4 ? 4 - w : 0);
    const int i16 = lane & 15, q4 = i16 >> 2, p4 = i16 & 3, blk = (lane >> 4) & 1, swz = (q4 >> 1) & 1, kswz = (ql >> 1) & 7;
    float skl = 0.f;
    if (U.mixer) { const int hs = U.head0 + (lane & 7); skl = sinks[hs < 16 ? hs : 15]; }
    ATT_WAIT_V(0);
#pragma unroll
    for (int kk = 0; kk < 4; ++kk) asm volatile("" : "+v"(qn[kk]));
    asm volatile("" : "+v"(skl));
    ATT_BAR();
    APT(0);
    LAS unsigned char* const vimg = lds + LDS_V + vpar * (KROWS * VPITCH);
    const unsigned vbl = (unsigned)reinterpret_cast<__SIZE_TYPE__>(vimg) + (unsigned)((32 * w + 4 * h + q4) * VPITCH + (2 * blk + (p4 >> 1)) * 16 + 8 * (p4 & 1));
    const unsigned vb0 = vbl + (unsigned)(64 * swz), vb1 = vbl + (unsigned)(64 * (swz ^ 1));
    unsigned kbase[4];
#pragma unroll
    for (int kk = 0; kk < 4; ++kk) kbase[kk] = (unsigned)reinterpret_cast<__SIZE_TYPE__>(lds + LDS_K) + (unsigned)((32 * w + ql) * 128 + (((2 * kk + h) ^ kswz) * 16));
    for (int hh = 0; hh < U.nh; ++hh) {
        const int head = U.head0 + hh;
        const float slope = U.mixer ? __builtin_amdgcn_exp2f(-0.5f * (float)(head + 1)) : __builtin_amdgcn_exp2f((float)(head + 1) * (-8.f / 24.f));
        const float c2 = slope * (float)U.dil * LOG2E;
        const float sink2 = U.mixer ? __builtin_bit_cast(float, __builtin_amdgcn_readlane(__builtin_bit_cast(int, skl), hh)) * LOG2E : -INFINITY;
        bf16x8 qf[4];
#pragma unroll
        for (int kk = 0; kk < 4; ++kk) qf[kk] = qn[kk];
        if (hh == 0 && has_next) dma_image<true>(lds + LDS_V + (vpar ^ 1) * (KROWS * VPITCH), Un.rb + (size_t)Un.vcol * TS, w, lane, Un.has_prev != 0);
        f32x16 S[5];
        const float tl = -c2 * (float)(128 + ql - 4 * h);
        bf16x8 ka[4];
#define QK_READ(set, c) do { _Pragma("unroll") for (int kk = 0; kk < 4; ++kk) \
            asm volatile("ds_read_b128 %0, %1 offset:%c2" : "=&v"(set[kk]) : "v"(kbase[kk]), "i"((32 * (c)) * 128) : "memory"); } while (0)
#define QK_STEP(cur, nxt, c) do { if ((c) >= cstart) { \
            QK_READ(cur, c); \
            const float tc = tl + c2 * (32.f * (float)(c)); \
            _Pragma("unroll") for (int r = 0; r < 16; ++r) S[c][r] = tc + c2 * (float)((r & 3) + 8 * (r >> 2)); \
            asm volatile("s_waitcnt lgkmcnt(0)" : "+v"(cur[0]), "+v"(cur[1]), "+v"(cur[2]), "+v"(cur[3]) :: "memory"); \
            _Pragma("unroll") for (int kk = 0; kk < 4; ++kk) S[c] = MFMA32(cur[kk], qf[kk], S[c]); \
        } else { _Pragma("unroll") for (int r = 0; r < 16; ++r) S[c][r] = -INFINITY; } } while (0)
        QK_STEP(ka, ka, 0); QK_STEP(ka, ka, 1); QK_STEP(ka, ka, 2); QK_STEP(ka, ka, 3); QK_STEP(ka, ka, 4);
#undef QK_READ
#undef QK_STEP
        APT(1);
        if (hh + 1 < U.nh) {
            const bf16* qrow = U.rb + (size_t)(U.qcol + hh + 1) * TS + (32 * w + ql) * 64 + 8 * h;
#pragma unroll
            for (int kk = 0; kk < 4; ++kk) qn[kk] = *(const bf16x8*)(qrow + 16 * kk);
        }
        if (hh == U.nh - 1) {
            ATT_BAR();
            if (has_next) {
                dma_image<false>(lds + LDS_K, Un.rb + (size_t)Un.kcol * TS, w, lane, Un.has_prev != 0);
                const bf16* qrow = Un.rb + (size_t)Un.qcol * TS + (32 * w + ql) * 64 + 8 * h;
#pragma unroll
                for (int kk = 0; kk < 4; ++kk) qn[kk] = *(const bf16x8*)(qrow + 16 * kk);
            }
        }
        const int d0 = U.mixer;
#pragma unroll
        for (int r = 0; r < 16; ++r) { const int kl = (r & 3) + 8 * (r >> 2) + 4 * h; if (kl < ql + d0) S[0][r] = -INFINITY; if (kl > ql) S[4][r] = -INFINITY; }
        float m = sink2;
#pragma unroll
        for (int c = 0; c < 5; ++c)
#pragma unroll
            for (int r = 0; r < 16; ++r) m = fmaxf(m, S[c][r]);
        m = fmaxf(m, __shfl_xor(m, 32));
        float l = 0.f;
        APT(2);
        APT(3);
        f32x16 O[2];
#pragma unroll
        for (int r = 0; r < 16; ++r) { O[0][r] = 0.f; O[1][r] = 0.f; }
        s16x4 ra[4], rb[4];
#define PV_READ(set, k) do { \
            asm volatile("ds_read_b64_tr_b16 %0, %1 offset:%c2" : "=&v"(set[0]) : "v"(vb0), "i"((16 * (k)) * VPITCH) : "memory"); \
            asm volatile("ds_read_b64_tr_b16 %0, %1 offset:%c2" : "=&v"(set[1]) : "v"(vb0), "i"((16 * (k) + 8) * VPITCH) : "memory"); \
            asm volatile("ds_read_b64_tr_b16 %0, %1 offset:%c2" : "=&v"(set[2]) : "v"(vb1), "i"((16 * (k)) * VPITCH) : "memory"); \
            asm volatile("ds_read_b64_tr_b16 %0, %1 offset:%c2" : "=&v"(set[3]) : "v"(vb1), "i"((16 * (k) + 8) * VPITCH) : "memory"); } while (0)
#define PV_EXP(k) do { _Pragma("unroll") for (int r = 0; r < 8; ++r) { const float p = __builtin_amdgcn_exp2f(S[(k) >> 1][8 * ((k) & 1) + r] - m); S[(k) >> 1][8 * ((k) & 1) + r] = p; l += p; } } while (0)
#define PV_STEP(cur, nxt, k) do { if (((k) >> 1) >= cstart) { \
            if ((k) == 2 * cstart) { PV_READ(cur, k); PV_EXP(k); } \
            asm volatile("s_waitcnt lgkmcnt(0)" : "+v"(cur[0]), "+v"(cur[1]), "+v"(cur[2]), "+v"(cur[3]) :: "memory"); \
            if ((k) + 1 < 10) PV_READ(nxt, (k) + 1); \
            u32x4 pw; pw.x = cvtpk(S[(k) >> 1][8 * ((k) & 1)], S[(k) >> 1][8 * ((k) & 1) + 1]); pw.y = cvtpk(S[(k) >> 1][8 * ((k) & 1) + 2], S[(k) >> 1][8 * ((k) & 1) + 3]); \
            pw.z = cvtpk(S[(k) >> 1][8 * ((k) & 1) + 4], S[(k) >> 1][8 * ((k) & 1) + 5]); pw.w = cvtpk(S[(k) >> 1][8 * ((k) & 1) + 6], S[(k) >> 1][8 * ((k) & 1) + 7]); \
            const bf16x8 pf = __builtin_bit_cast(bf16x8, pw); \
            O[0] = MFMA32(__builtin_shufflevector(cur[0], cur[1], 0, 1, 2, 3, 4, 5, 6, 7), pf, O[0]); \
            O[1] = MFMA32(__builtin_shufflevector(cur[2], cur[3], 0, 1, 2, 3, 4, 5, 6, 7), pf, O[1]); \
            if ((k) + 1 < 10) PV_EXP((k) + 1);     } } while (0)
        PV_STEP(ra, rb, 0); PV_STEP(rb, ra, 1); PV_STEP(ra, rb, 2); PV_STEP(rb, ra, 3); PV_STEP(ra, rb, 4);
        PV_STEP(rb, ra, 5); PV_STEP(ra, rb, 6); PV_STEP(rb, ra, 7); PV_STEP(ra, rb, 8); PV_STEP(rb, ra, 9);
#undef PV_READ
#undef PV_STEP
#undef PV_EXP
        l += __shfl_xor(l, 32);
        l += __builtin_amdgcn_exp2f(sink2 - m);
        APT(4);
        const float inv = 1.f / l;
        const int qi = 32 * w + ql;
        bf16* op = const_cast<bf16*>(U.rb) + (size_t)(U.qcol + hh) * TS + qi * 64 + 8 * h;
#pragma unroll
        for (int dt = 0; dt < 2; ++dt)
#pragma unroll
            for (int j = 0; j < 2; ++j) {
                const int ga = 2 * j, gb = 2 * j + 1;
                const unsigned ax = cvtpk(O[dt][4 * ga] * inv, O[dt][4 * ga + 1] * inv), ay = cvtpk(O[dt][4 * ga + 2] * inv, O[dt][4 * ga + 3] * inv);
                const unsigned bx_ = cvtpk(O[dt][4 * gb] * inv, O[dt][4 * gb + 1] * inv), by = cvtpk(O[dt][4 * gb + 2] * inv, O[dt][4 * gb + 3] * inv);
                const auto sx = __builtin_amdgcn_permlane32_swap(ax, bx_, false, false), sy = __builtin_amdgcn_permlane32_swap(ay, by, false, false);
                u32x4 o4; o4.x = sx[0]; o4.y = sy[0]; o4.z = sx[1]; o4.w = sy[1];
                *(u32x4*)(op + 32 * dt + 16 * j) = o4; }
        if (!U.mixer && h == 0) lse[(size_t)(U.ltok0 + qi * U.lstride) * 24 + head] = (m + __builtin_amdgcn_logf(l)) * LN2;
        APT(5);
    }
#undef APT
}
#undef ATT_WAIT_V
#undef ATT_BAR
#undef MFMA32
}

#define XB_TMO      128
#define XB_XCNT(j)  (256  + 64 * (j))
#define XB_XSUB(j)  (1280 + 64 * (j))
#define XB_XGEN(j)  (2304 + 64 * (j))
#define XB_TOP      3328
#define XB_TOPGEN   3392
#define XCD_BAR_WORDS 3456
#define XB_SPIN_CAP (1u << 18)
__device__ __forceinline__ unsigned xb_ld(unsigned* p)              { return __hip_atomic_load(p, __ATOMIC_RELAXED, __HIP_MEMORY_SCOPE_AGENT); }
__device__ __forceinline__ unsigned xb_add(unsigned* p, unsigned v) { return __hip_atomic_fetch_add(p, v, __ATOMIC_RELAXED, __HIP_MEMORY_SCOPE_AGENT); }
__device__ __forceinline__ unsigned xb_xcc_id() { return (unsigned)__builtin_amdgcn_s_getreg((3 << 11) | 20) & 0xFu; }
#define XB_SPIN(cond, bar) do { unsigned _sp = 0; while (cond) { __builtin_amdgcn_s_sleep(1); \
    if ((++_sp & 255u) == 0u) { if (xb_ld(&(bar)[XB_TMO])) break; if (_sp > XB_SPIN_CAP) { atomicAdd(&(bar)[XB_TMO], 1u); break; } } } } while (0)
struct XcdBarrier { unsigned* bar; unsigned x; volatile LAS unsigned* st; };
__device__ __forceinline__ XcdBarrier xcd_barrier_post(unsigned* bar, volatile LAS unsigned* st) {
    XcdBarrier b; b.bar = bar; b.x = xb_xcc_id(); b.st = st;
    if (threadIdx.x == 0) (void)xb_add(&bar[XB_XCNT(b.x)], 1u);
    return b;
}
__device__ __forceinline__ void xcd_barrier_complete(unsigned* bar, unsigned x, unsigned& nloc, unsigned& nx) {
    const unsigned G = gridDim.x * gridDim.y * gridDim.z;
    unsigned sum, cnt, mine, sp = 0u;
    for (;;) {
        sum = 0u; cnt = 0u; mine = 0u;
#pragma unroll
        for (unsigned j = 0; j < 16; ++j) { const unsigned c = xb_ld(&bar[XB_XCNT(j)]); sum += c; cnt += (c > 0u) ? 1u : 0u; mine = (j == x) ? c : mine; }
        if (sum == G) break;
        __builtin_amdgcn_s_sleep(1);
        if ((++sp & 255u) == 0u) { if (xb_ld(&bar[XB_TMO])) break; if (sp > XB_SPIN_CAP) { atomicAdd(&bar[XB_TMO], 1u); break; } }
    }
    nloc = mine > 0u ? mine : 1u; nx = cnt > 0u ? cnt : 1u;
}
__device__ __forceinline__ void xcd_barrier(const XcdBarrier& b) {
    asm volatile("s_waitcnt vmcnt(0)" ::: "memory");
    __syncthreads();
    if (threadIdx.x == 0) {
        unsigned* bar = b.bar;
        __builtin_amdgcn_s_waitcnt(0);
        unsigned nloc = b.st[0], nx = b.st[1];
        if (nloc == 0u) { xcd_barrier_complete(bar, b.x, nloc, nx); b.st[0] = nloc; b.st[1] = nx; }
        const unsigned old = xb_add(&bar[XB_XSUB(b.x)], 1u);
        const unsigned gen = old / nloc;
        if (old + 1u == (gen + 1u) * nloc) {
            __builtin_amdgcn_fence(__ATOMIC_RELEASE, "agent");
            asm volatile("s_waitcnt vmcnt(0)" ::: "memory");
            const unsigned og = xb_add(&bar[XB_TOP], 1u);
            const unsigned tg = og / nx;
            if (og + 1u == (tg + 1u) * nx) xb_add(&bar[XB_TOPGEN], 1u);
            else XB_SPIN(xb_ld(&bar[XB_TOPGEN]) == tg, bar);
            __builtin_amdgcn_fence(__ATOMIC_ACQUIRE, "agent");
            xb_add(&bar[XB_XGEN(b.x)], 1u);
            asm volatile("s_waitcnt vmcnt(0)" ::: "memory");
        } else {
            XB_SPIN(xb_ld(&bar[XB_XGEN(b.x)]) == gen, bar);
            __builtin_amdgcn_fence(__ATOMIC_ACQUIRE, "agent");
            asm volatile("s_waitcnt vmcnt(0)" ::: "memory");
        }
    }
    __syncthreads();
}

struct Args { const float* in[16]; float* out; unsigned char* ws; int ph_lo, ph_hi; };
struct Frame {
    LAS unsigned char* lds; volatile LAS unsigned* MISC; unsigned* ctl; unsigned char* ws;
    int tid, lane, wave, vcu, G, bx;
};

template <bool GAIN>
__device__ __forceinline__ void tr_item(const float* W, int ldw, int k0, int src_n0, bf16* WT, int ldt, int dst_r0, LAS float* scr, int lane, const float* gk = nullptr) {
#pragma unroll 8
    for (int i = 0; i < 32; ++i) { const int kk = 2 * i + (lane >> 5); float w = W[(size_t)(k0 + kk) * ldw + src_n0 + (lane & 31)]; if (GAIN) w *= gk[k0 + kk]; scr[kk * 33 + (lane & 31)] = w; }
    LDS_WAIT(); asm volatile("" ::: "memory");
    const int c = lane & 7;
#pragma unroll
    for (int j = 0; j < 4; ++j) { const int n = (lane >> 3) + 8 * j; const LAS float* sp = scr + (8 * c) * 33 + n;
        u32x4 o; o.x = cvtpk(sp[0 * 33], sp[1 * 33]); o.y = cvtpk(sp[2 * 33], sp[3 * 33]); o.z = cvtpk(sp[4 * 33], sp[5 * 33]); o.w = cvtpk(sp[6 * 33], sp[7 * 33]);
        *(u32x4*)(WT + (size_t)(dst_r0 + n) * ldt + k0 + 8 * c) = o; }
    LDS_WAIT(); asm volatile("" ::: "memory");
}
__device__ __forceinline__ void p0_prologue(const Frame& F, const Args& a) {
    LAS float* scr = (LAS float*)(F.lds + F.wave * 16384);
    const int gw = F.vcu * 8 + F.wave, NGW = F.G * 8, lane = F.lane;
    bf16* win = (bf16*)(F.ws + WS_WIN); bf16* wbr = (bf16*)(F.ws + WS_WBR); bf16* wout = (bf16*)(F.ws + WS_WOUT);
    bf16* wgu = (bf16*)(F.ws + WS_WGU); bf16* wd = (bf16*)(F.ws + WS_WD);
    constexpr int I_IN = 16 * 248, I_BD = 8 * 32, I_BS = 16 * 32, I_OUT = 16 * 32, I_G = 32 * 256, I_U = 32 * 256, I_D = 32 * 256;
    constexpr int NITEMS = I_IN + I_BD + I_BS + I_OUT + I_G + I_U + I_D;
    for (int it = gw; it < NITEMS; it += NGW) {
        int r = it;
        if (r < I_IN) { const int kb = r / 248, nb = r % 248, dr = 32 * nb; int src = dr;
            if (dr >= QKV_W) { const int o = dr - QKV_W, j = o >> 8, i = o & 255; src = (i < 128) ? QKV_W + 128 * j + i : QKV_W + 1024 + 128 * j + (i - 128); }
            tr_item<true>(a.in[2], IN_W, 64 * kb, src, win, 1024, dr, scr, lane, a.in[1]); continue; } r -= I_IN;
        if (r < I_BD) { tr_item<false>(a.in[4], 1024, 64 * (r >> 5), 32 * (r & 31), wbr + 1024, 1536, 32 * (r & 31), scr, lane); continue; } r -= I_BD;
        if (r < I_BS) { tr_item<false>(a.in[5], 1024, 64 * (r >> 5), 32 * (r & 31), wbr, 1536, 32 * (r & 31), scr, lane); continue; } r -= I_BS;
        if (r < I_OUT) { tr_item<false>(a.in[6], 1024, 64 * (r >> 5), 32 * (r & 31), wout, 1024, 32 * (r & 31), scr, lane); continue; } r -= I_OUT;
        if (r < I_G + I_U) { const int up = r >= I_G; if (up) r -= I_G; const int e = r >> 8, kb = (r >> 4) & 15, nb = r & 15;
            tr_item<true>((up ? a.in[13] : a.in[12]) + (size_t)e * 1024 * 512, 512, 64 * kb, 32 * nb, wgu, 1024, e * 1024 + 256 * (nb >> 2) + 128 * up + 32 * (nb & 3), scr, lane, a.in[7]); continue; } r -= I_G + I_U;
        { const int e = r >> 8, kb = (r >> 5) & 7, nb = r & 31;
            tr_item<false>(a.in[14] + (size_t)e * 512 * 1024, 1024, 64 * kb, 32 * nb, wd, 512, e * 1024 + 32 * nb, scr, lane); }
    }
    { u32x4* img = (u32x4*)(F.ws + WS_WRT); const float* gf = a.in[7]; const float* wg = a.in[8]; const float* wr = a.in[10];
        for (int i = F.vcu * 512 + F.tid; i < 2 * 32 * 3 * 64; i += F.G * 512) {
            const int ln = i & 63, q = i >> 6, b = q % 3, t = (q / 3) & 31, half = q / 96, n = ln & 31;
            const int k0 = 512 * half + 64 * (t >> 2) + 32 * (ln >> 5) + 8 * (t & 3);
            const bool want_lo = (b == 1) || (b == 2 && n >= 4);
            float w[8];
#pragma unroll
            for (int j = 0; j < 8; ++j) { const int k = k0 + j; float v = 0.f;
                if (b < 2) v = gf[k] * wr[k * 32 + n]; else if (n < 8) v = gf[k] * wg[k * 4 + (n & 3)];
                const float hi = bf_lo(cvtpk(v, 0.f));
                w[j] = want_lo ? v - hi : hi; }
            u32x4 o; o.x = cvtpk(w[0], w[1]); o.y = cvtpk(w[2], w[3]); o.z = cvtpk(w[4], w[5]); o.w = cvtpk(w[6], w[7]);
            img[i] = o; } }
    for (int dup_ = 0; dup_ < (PROBE_P0 == 2 ? 2 : 1); ++dup_)
    { const float* x = a.in[0]; bf16* H = (bf16*)(F.ws + WS_H); float* rms1 = (float*)(F.ws + WS_RMS1);
        f32x4 vnx[4];
        if (gw < NTOK) { const f32x4* xr0 = (const f32x4*)(x + (size_t)gw * 1024) + lane;
#pragma unroll
            for (int j = 0; j < 4; ++j) vnx[j] = xr0[64 * j]; }
        for (int row = gw; row < NTOK; row += NGW) {
            f32x4 v[4]; float ss = 0.f;
#pragma unroll
            for (int j = 0; j < 4; ++j) v[j] = vnx[j];
            if (row + NGW < NTOK) { const f32x4* xrn = (const f32x4*)(x + (size_t)(row + NGW) * 1024) + lane;
#pragma unroll
                for (int j = 0; j < 4; ++j) vnx[j] = xrn[64 * j]; }
#pragma unroll
            for (int j = 0; j < 4; ++j) ss += (v[j].x * v[j].x + v[j].y * v[j].y) + (v[j].z * v[j].z + v[j].w * v[j].w);
            const float rms = sqrtf(wave_sum(ss) * (1.f / 1024.f) + RMS_EPS), rstd = 1.f / rms;
            if (lane == 0) rms1[row] = rms;
            u32x2* o = (u32x2*)(H + (size_t)row * 1024) + lane;
#pragma unroll
            for (int j = 0; j < 4; ++j) { const f32x4 t = v[j] * rstd; u32x2 p; p.x = cvtpk(t.x, t.y); p.y = cvtpk(t.z, t.w); o[64 * j] = p; }
        }
    }
}

#ifndef ATT_REVERSE
#define ATT_REVERSE 1
#endif
#ifndef ATT_PRIO
#define ATT_PRIO 1
#endif
#ifndef SWA_NH
#define SWA_NH 8
#endif
constexpr int ATT_NSWA = 2 * 32 * (8 / SWA_NH), ATT_UPB = ATT_NSWA + 24 * 32;
__device__ __forceinline__ void attn_make_unit(const Frame& F, const int gi, att::UnitDesc& U) {
    const bf16* qkv = (const bf16*)(F.ws + WS_QKV);
    const int gr = ATT_REVERSE ? (NB * ATT_UPB - 1 - gi) : gi;
    const int b = gr / ATT_UPB, ui = gr - b * ATT_UPB;
    if (ui < ATT_NSWA) {
        const int grp = ui % (8 / SWA_NH), blkq = (ui / (8 / SWA_NH)) & 31, kvh = ui / (32 * (8 / SWA_NH)), head0 = kvh * 8 + grp * SWA_NH;
        U.rb = qkv + (size_t)(b * T + 256 * blkq) * 64;
        U.qcol = COL_QS / 64 + head0; U.kcol = COL_KS / 64 + kvh; U.vcol = COL_VS / 64 + kvh;
        U.has_prev = blkq != 0; U.nh = SWA_NH; U.mixer = 1; U.head0 = head0; U.dil = 1; U.ltok0 = 0; U.lstride = 0;
    } else {
        const int au = ui - ATT_NSWA, blkq = au & 31, head = au >> 5, sh = 2 * (head >> 3), L = T >> sh;
        const int prow = 256 * blkq, r = prow >> (13 - sh), u0 = prow & (L - 1);
        U.rb = qkv + (size_t)(b * T + prow) * 64;
        U.qcol = head; U.kcol = COL_KD / 64 + head; U.vcol = COL_VD / 64 + head;
        U.has_prev = u0 != 0; U.nh = 1; U.mixer = 0; U.head0 = head; U.dil = 1 << sh;
        U.ltok0 = b * T + (u0 << sh) + r; U.lstride = 1 << sh;
    }
}
__device__ __forceinline__ void attn_phase(const Frame& F, const float* sinks) {
    int gi = F.vcu;
    if (gi >= NB * ATT_UPB) return;
    att::UnitDesc U, Un; bf16x8 qn[4]; unsigned pt[6] = {0u, 0u, 0u, 0u, 0u, 0u};
    attn_make_unit(F, gi, U);
    { const int w = F.wave, lane = F.lane;
      att::dma_image<false>(F.lds + att::LDS_K, U.rb + (size_t)U.kcol * TS, w, lane, U.has_prev != 0);
      att::dma_image<true>(F.lds + att::LDS_V, U.rb + (size_t)U.vcol * TS, w, lane, U.has_prev != 0);
      const bf16* qrow = U.rb + (size_t)U.qcol * TS + (32 * w + (lane & 31)) * 64 + 8 * (lane >> 5);
#pragma unroll
      for (int kk = 0; kk < 4; ++kk) qn[kk] = *(const bf16x8*)(qrow + 16 * kk); }
    if (ATT_PRIO && F.wave >= 4) __builtin_amdgcn_s_setprio(1);
    int vpar = 0;
    for (;;) {
        const bool has_next = gi + F.G < NB * ATT_UPB;
        attn_make_unit(F, has_next ? gi + F.G : gi, Un);
        att::attn_unit(F.lds, F.tid, U, sinks, (float*)(F.ws + WS_LSE), has_next, Un, qn, vpar, pt);
        if (!has_next) break;
        gi += F.G; U = Un; vpar ^= 1;
    }
    if (ATT_PRIO) __builtin_amdgcn_s_setprio(0);
    asm volatile("s_waitcnt vmcnt(0)" ::: "memory");
    __syncthreads();
    if (PROBE_T >= 40 && F.vcu == 5 && F.tid == 0) { for (int i = 0; i < 6; ++i) F.ctl[20040 + i] = pt[i]; }
}
__device__ __forceinline__ void merge_phase(const Frame& F) {
    bf16* qkv = (bf16*)(F.ws + WS_QKV); const float* lse = (const float*)(F.ws + WS_LSE);
    for (int it = F.vcu * 512 + F.tid; it < NTOK * 64; it += F.G * 512) {
        const int dc = it & 7, hs = (it >> 3) & 7, t = it >> 6, tb = t & ~(T - 1), tl = t & (T - 1);
        const float l0 = lse[(size_t)t * 24 + hs], l1 = lse[(size_t)t * 24 + 8 + hs], l2 = lse[(size_t)t * 24 + 16 + hs];
        const float mx = fmaxf(l0, fmaxf(l1, l2));
        float w0 = __expf(l0 - mx), w1 = __expf(l1 - mx), w2 = __expf(l2 - mx); const float inv = 1.f / (w0 + w1 + w2); w0 *= inv; w1 *= inv; w2 *= inv;
        const int r1 = tb | ((tl & 3) << 11) | (tl >> 2), r2 = tb | ((tl & 15) << 9) | (tl >> 4);
        f32x4 a0, b0, a1, b1, a2, b2;
        unpack8(*(const u32x4*)(qkv + (size_t)hs * TS + (size_t)t * 64 + dc * 8), a0, b0);
        unpack8(*(const u32x4*)(qkv + (size_t)(8 + hs) * TS + (size_t)r1 * 64 + dc * 8), a1, b1);
        unpack8(*(const u32x4*)(qkv + (size_t)(16 + hs) * TS + (size_t)r2 * 64 + dc * 8), a2, b2);
        *(u32x4*)(qkv + (size_t)(COL_YDIL / 64 + hs) * TS + (size_t)t * 64 + dc * 8) = pack8(a0 * w0 + a1 * w1 + a2 * w2, b0 * w0 + b1 * w1 + b2 * w2);
    }
}
__device__ __forceinline__ float dot4(const f32x4 a, const f32x4 b) { return (a.x * b.x + a.y * b.y) + (a.z * b.z + a.w * b.w); }
constexpr int RT_IMG_HALF = 32 * 3 * 1024;
constexpr int RT_STAGE_OFF = RT_IMG_HALF, RT_SP = 41;
static_assert(RT_STAGE_OFF + 8 * 32 * RT_SP * 4 <= P5_CNT_OFF, "router LDS");
__device__ __forceinline__ void router_phase(const Frame& F, const bf16* x1, const float* bg, const float* br) {
    const int lane = F.lane, tid = F.tid, n = lane & 31, h = lane >> 5;
    volatile LAS unsigned* cnt = (volatile LAS unsigned*)(F.lds + P5_CNT_OFF); volatile LAS unsigned* basew = (volatile LAS unsigned*)(F.lds + P5_BASE_OFF);
    volatile LAS unsigned* rec = (volatile LAS unsigned*)(F.lds + P5_REC_OFF);
    if (tid < 32) cnt[tid] = 0u;
    const int RPW = NTOK / F.G, row0 = F.vcu * RPW;
    const u32x4* img = (const u32x4*)(F.ws + WS_WRT);
    LAS float* stage = (LAS float*)(F.lds + RT_STAGE_OFF) + F.wave * (32 * RT_SP);
    float* rstd2 = (float*)(F.ws + WS_RSTD2); float* rw = (float*)(F.ws + WS_RW);
    for (int c0 = 0; c0 < RPW; c0 += 256) {
        const int lrow = c0 + 32 * F.wave + n;
        const u32x4* xp = (const u32x4*)(x1 + (size_t)(row0 + lrow) * 1024 + 32 * h);
        f32x16 ae, ag, as_;
#pragma unroll
        for (int r = 0; r < 16; ++r) { ae[r] = 0.f; ag[r] = 0.f; as_[r] = 0.f; }
        u32x4 a0[4], a1[4], a2[4];
#define RT_MFMA(a, b, c) __builtin_amdgcn_mfma_f32_32x32x16_bf16((a), (b), (c), 0, 0, 0)
#define RT_LOADA(buf, SS) do { _Pragma("unroll") for (int i = 0; i < 4; ++i) buf[i] = xp[8 * (SS) + i]; } while (0)
#define RT_SS(cur, nxt, SS) do { \
        if ((SS) == 0 || (SS) == 8) { __syncthreads(); \
            for (int i = tid; i < RT_IMG_HALF / 16; i += 512) ((LAS u32x4*)F.lds)[i] = img[((SS) >> 3) * (RT_IMG_HALF / 16) + i]; \
            __syncthreads(); } \
        if ((SS) + 2 < 16) RT_LOADA(nxt, (SS) + 2); \
        _Pragma("unroll") for (int i = 0; i < 4; ++i) { const LAS bf16x8* bp = (const LAS bf16x8*)F.lds + (4 * ((SS) & 7) + i) * 192 + lane; \
            const bf16x8 av = __builtin_bit_cast(bf16x8, cur[i]); \
            ae = RT_MFMA(av, bp[0], ae); ae = RT_MFMA(av, bp[64], ae); ag = RT_MFMA(av, bp[128], ag); as_ = RT_MFMA(av, av, as_); } } while (0)
        RT_LOADA(a0, 0); RT_LOADA(a1, 1);
        RT_SS(a0, a2, 0); RT_SS(a1, a0, 1); RT_SS(a2, a1, 2); RT_SS(a0, a2, 3); RT_SS(a1, a0, 4); RT_SS(a2, a1, 5); RT_SS(a0, a2, 6); RT_SS(a1, a0, 7);
        RT_SS(a2, a1, 8); RT_SS(a0, a2, 9); RT_SS(a1, a0, 10); RT_SS(a2, a1, 11); RT_SS(a0, a2, 12); RT_SS(a1, a0, 13); RT_SS(a2, a1, 14); RT_SS(a0, a2, 15);
#undef RT_SS
#undef RT_LOADA
#undef RT_MFMA
        float ssd = 0.f;
#pragma unroll
        for (int r = 0; r < 16; ++r) { const int row = (r & 3) + 8 * (r >> 2) + 4 * h;
            stage[row * RT_SP + n] = ae[r]; if (n < 8) stage[row * RT_SP + 32 + n] = ag[r]; if (row == n) ssd = as_[r]; }
        if (h == ((n >> 2) & 1)) stage[n * RT_SP + 40] = ssd;
        LDS_WAIT(); asm volatile("" ::: "memory");
        if (lane < 32) {
            const LAS float* sr = stage + n * RT_SP; const int row = row0 + lrow;
            const float rstd = 1.f / sqrtf(sr[40] * (1.f / 1024.f) + RMS_EPS);
            float gl[4];
#pragma unroll
            for (int e = 0; e < 4; ++e) gl[e] = (sr[32 + e] + sr[36 + e]) * rstd + bg[e];
            int gt = 0; float gm = gl[0];
#pragma unroll
            for (int e = 1; e < 4; ++e) if (gl[e] > gm) { gm = gl[e]; gt = e; }
            float gz = 0.f;
#pragma unroll
            for (int e = 0; e < 4; ++e) gz += __expf(gl[e] - gm);
            const float gwt = 1.f / gz;
            float el[8];
#pragma unroll
            for (int e = 0; e < 8; ++e) el[e] = sr[8 * gt + e] * rstd + br[8 * gt + e];
            int i0 = 0; float m0 = el[0];
#pragma unroll
            for (int e = 1; e < 8; ++e) if (el[e] > m0) { m0 = el[e]; i0 = e; }
            int i1 = -1; float m1 = -INFINITY;
#pragma unroll
            for (int e = 0; e < 8; ++e) if (e != i0 && el[e] > m1) { m1 = el[e]; i1 = e; }
            if (i1 < 0) i1 = (i0 == 0) ? 1 : 0;
            const float ed = __expf(m1 - m0), w0 = 1.f / (1.f + ed), w1 = ed * w0;
            const unsigned E0 = (unsigned)(8 * gt + i0), E1 = (unsigned)(8 * gt + i1);
            const unsigned r0 = __hip_atomic_fetch_add((LAS unsigned*)&cnt[E0], 1u, __ATOMIC_RELAXED, __HIP_MEMORY_SCOPE_WORKGROUP);
            const unsigned r1 = __hip_atomic_fetch_add((LAS unsigned*)&cnt[E1], 1u, __ATOMIC_RELAXED, __HIP_MEMORY_SCOPE_WORKGROUP);
            rec[lrow] = E0 | (E1 << 5) | (r0 << 10) | (r1 << 20);
            rw[2 * row] = gwt * w0; rw[2 * row + 1] = gwt * w1; rstd2[row] = rstd;
        }
    }
    __syncthreads();
    if (tid < 32) basew[tid] = __hip_atomic_fetch_add(F.ctl + CW_CNT + 64 * tid, cnt[tid], RLX_AGENT);
    __syncthreads();
    unsigned* re = (unsigned*)(F.ws + WS_RE); unsigned* rrel = (unsigned*)(F.ws + WS_RREL);
    for (int lt = tid; lt < RPW; lt += 512) { const unsigned rc = rec[lt], E0 = rc & 31u, E1 = (rc >> 5) & 31u; const int row = row0 + lt;
        re[row] = E0 | (E1 << 8); rrel[2 * row] = basew[E0] + ((rc >> 10) & 1023u); rrel[2 * row + 1] = basew[E1] + ((rc >> 20) & 1023u); }
}
__device__ __forceinline__ void slots_phase(const Frame& F) {
    volatile LAS unsigned* cnt = (volatile LAS unsigned*)F.lds; volatile LAS unsigned* off = cnt + 32;
    if (F.tid < 32) cnt[F.tid] = ld_agent(F.ctl + CW_CNT + 64 * F.tid);
    __syncthreads();
    if (F.tid == 0) { unsigned o = 0; for (int e = 0; e < 32; ++e) { off[e] = o; o += (cnt[e] + 255u) & ~255u; } off[32] = o; }
    __syncthreads();
    const int RPW = NTOK / F.G, row0 = F.vcu * RPW;
    const unsigned* re = (const unsigned*)(F.ws + WS_RE); const unsigned* rrel = (const unsigned*)(F.ws + WS_RREL); const float* rw = (const float*)(F.ws + WS_RW);
    unsigned* tos = (unsigned*)(F.ws + WS_TOS); float* wos = (float*)(F.ws + WS_WOS); float* rss = (float*)(F.ws + WS_RSS); const float* rstd2 = (const float*)(F.ws + WS_RSTD2); unsigned* sot = (unsigned*)(F.ws + WS_SOT); unsigned* pex = (unsigned*)(F.ws + WS_PEX);
    for (int lt = F.tid; lt < RPW; lt += 512) { const int row = row0 + lt; const unsigned ev = re[row], e0 = ev & 255u, e1 = ev >> 8;
        const unsigned s0 = off[e0] + rrel[2 * row], s1 = off[e1] + rrel[2 * row + 1];
        tos[s0] = (unsigned)row; tos[s1] = (unsigned)row; wos[s0] = rw[2 * row]; wos[s1] = rw[2 * row + 1]; { const float r2 = rstd2[row]; rss[s0] = r2; rss[s1] = r2; } sot[2 * row] = s0; sot[2 * row + 1] = s1; }
    for (int e = F.vcu; e < 32; e += F.G) { const unsigned c = cnt[e], pad = ((c + 255u) & ~255u) - c;
        for (unsigned i = F.tid; i < pad; i += 512) { tos[off[e] + c + i] = 0u; wos[off[e] + c + i] = 0.f; rss[off[e] + c + i] = 0.f; } }
    if (F.vcu == F.G - 1) { const unsigned np = off[32] >> 8;
        for (unsigned p = F.tid; p < np; p += 512) { unsigned e = 0; for (unsigned k = 0; k < 32; ++k) if (off[k] <= 256u * p && 256u * p < off[k + 1]) e = k; pex[p] = e; }
        if (F.tid == 0) pex[1023] = np; }
    __syncthreads();
}
__device__ __forceinline__ void final_phase(const Frame& F, float* out, const float* gfin) {
    const bf16* x1b = (const bf16*)(F.ws + WS_X1B);
    const int lane = F.lane, gw = F.vcu * 8 + F.wave, NGW = F.G * 8;
    const unsigned* sot = (const unsigned*)(F.ws + WS_SOT); const bf16* ys = (const bf16*)(F.ws + WS_YS);
    f32x4 gv[4];
#pragma unroll
    for (int j = 0; j < 4; ++j) gv[j] = *(const f32x4*)(gfin + 4 * lane + 256 * j);
    u32x2 xn[4], y0n[4], y1n[4];
#define FIN_LOAD(r) do { const unsigned _s0 = sot[2 * (r)], _s1 = sot[2 * (r) + 1]; const u32x2* _x = (const u32x2*)(x1b + (size_t)(r) * 1024) + lane; \
        const u32x2* _y0 = (const u32x2*)(ys + (size_t)_s0 * 1024) + lane; const u32x2* _y1 = (const u32x2*)(ys + (size_t)_s1 * 1024) + lane; \
        _Pragma("unroll") for (int j = 0; j < 4; ++j) { xn[j] = _x[64 * j]; y0n[j] = _y0[64 * j]; y1n[j] = _y1[64 * j]; } } while (0)
    if (gw < NTOK) FIN_LOAD(gw);
    for (int row = gw; row < NTOK; row += NGW) {
        f32x4* xr = (f32x4*)(out + (size_t)row * 1024) + lane;
        f32x4 v[4]; float ss = 0.f;
#pragma unroll
        for (int j = 0; j < 4; ++j) { const u32x2 p = y0n[j], q = y1n[j], xw = xn[j];
            v[j] = (f32x4){bf_lo(xw.x), bf_hi(xw.x), bf_lo(xw.y), bf_hi(xw.y)} + (f32x4){bf_lo(p.x), bf_hi(p.x), bf_lo(p.y), bf_hi(p.y)} + (f32x4){bf_lo(q.x), bf_hi(q.x), bf_lo(q.y), bf_hi(q.y)}; ss += dot4(v[j], v[j]); }
        if (row + NGW < NTOK) FIN_LOAD(row + NGW);
        const float rstd = 1.f / sqrtf(wave_sum(ss) * (1.f / 1024.f) + RMS_EPS);
#pragma unroll
        for (int j = 0; j < 4; ++j) xr[64 * j] = v[j] * rstd * gv[j];
    }
#undef FIN_LOAD
}

__device__ __forceinline__ void stagger_delay(unsigned ticks) {
    if (ticks == 0u) return;
    const unsigned long long t0 = __builtin_amdgcn_s_memrealtime();
    while ((unsigned long long)__builtin_amdgcn_s_memrealtime() - t0 < (unsigned long long)ticks) __builtin_amdgcn_s_sleep(16);
}
#ifndef GEMM1_WGM
#define GEMM1_WGM 4
#endif
#ifndef STAG5
#define STAG5 400
#endif
#ifndef STAG1
#define STAG1 0
#endif
constexpr int N_PHASES = 10;
constexpr int KA_OUT = 128, KA_WS = 136, KA_LO = 144, KA_HI = 148;
#if defined(__HIP_DEVICE_COMPILE__)
__device__ __forceinline__ unsigned long long karg64(int off) { auto k = __builtin_amdgcn_kernarg_segment_ptr(); unsigned long long v;
    asm volatile("s_load_dwordx2 %0, %1, %2\n\ts_waitcnt lgkmcnt(0)" : "=s"(v) : "s"(k), "i"(off)); return v; }
__device__ __forceinline__ int karg32(int off) { auto k = __builtin_amdgcn_kernarg_segment_ptr(); int v;
    asm volatile("s_load_dword %0, %1, %2\n\ts_waitcnt lgkmcnt(0)" : "=s"(v) : "s"(k), "i"(off)); return v; }
#else
__device__ __forceinline__ unsigned long long karg64(int) { return 0ull; }
__device__ __forceinline__ int karg32(int) { return 0; }
#endif
#define KIN(i) ((const float*)(const GAS float*)karg64(8 * (i)))
#define KPTR(T, off) ((T*)(GAS T*)karg64(off))
__device__ __forceinline__ Frame make_frame(int wv) {
    extern __shared__ __attribute__((aligned(16))) unsigned char lds_raw[];
    Frame F; int bx = blockIdx.x, G = gridDim.x;
    asm volatile("" : "+s"(bx), "+s"(G), "+s"(wv));
    int tid = wv * 64 + (int)__builtin_amdgcn_mbcnt_hi(~0u, __builtin_amdgcn_mbcnt_lo(~0u, 0u));
    asm volatile("" : "+v"(tid));
    F.lds = (LAS unsigned char*)lds_raw; F.MISC = (volatile LAS unsigned*)(F.lds + MISC_OFF);
    F.tid = tid; F.lane = tid & 63; F.wave = __builtin_amdgcn_readfirstlane(tid >> 6);
    F.G = G; F.bx = bx; F.vcu = (G % 8 == 0) ? (bx % 8) * (G / 8) + bx / 8 : bx;
    F.ws = KPTR(unsigned char, KA_WS); F.ctl = (unsigned*)(F.ws + WS_CTL);
    return F;
}
__global__ void __launch_bounds__(512, 2) mk_fwd(Args args_unused) {
    const int wv = __builtin_amdgcn_readfirstlane((int)threadIdx.x >> 6);
    { Frame F = make_frame(wv); if (F.tid < 64) F.MISC[F.tid] = 0u; __syncthreads();
      if (MK_ONE_LAUNCH) (void)xcd_barrier_post(F.ctl + CW_BAR, F.MISC + 8); }
    const int lo = karg32(KA_LO), hi = karg32(KA_HI);
    if (PROBE_T >= 20) { Frame Fp = make_frame(wv); if (Fp.vcu == 5 && Fp.tid == 0) Fp.ctl[20020] = (unsigned)__builtin_amdgcn_s_memrealtime(); }
#define IN(k) (lo <= (k) && (k) < hi)
#define SEAM(k) do { if (IN(k) && IN((k) + 1)) { Frame Fb = make_frame(wv); XcdBarrier bar; bar.bar = Fb.ctl + CW_BAR; bar.x = xb_xcc_id(); bar.st = Fb.MISC + 8; xcd_barrier(bar); \
        if (PROBE_T >= 20 && Fb.vcu == 5 && Fb.tid == 0) Fb.ctl[20021 + (k)] = (unsigned)__builtin_amdgcn_s_memrealtime(); } } while (0)
#define GBAR() do { Frame Fb = make_frame(wv); XcdBarrier bar; bar.bar = Fb.ctl + CW_BAR; bar.x = xb_xcc_id(); bar.st = Fb.MISC + 8; xcd_barrier(bar); } while (0)
#define REP(k) for (int rep_ = 0; rep_ < (PROBE_DUP == (k) ? 2 : 1); ++rep_)
#define REPBAR(k) do { if (PROBE_DUP == (k) && rep_ == 0) GBAR(); } while (0)
    if (IN(0)) REP(7) { Frame F = make_frame(wv); Args a{}; for (int i = 0; i < 16; ++i) a.in[i] = KIN(i); p0_prologue(F, a); REPBAR(7); } SEAM(0);
    if (IN(1)) REP(1) {
        Frame F = make_frame(wv); bf16* gates = (bf16*)KPTR(float, KA_OUT);
        pg8::Gemm g{(const bf16*)(F.ws + WS_H), nullptr, (const bf16*)(F.ws + WS_WIN), nullptr, 2048, 2048, 16, 16, 128}; pg8::StaticOrder<false, PROBE_DUP == 9> S; S.init(NTOK, IN_W, F.G, F.bx, GEMM1_WGM);
        Epi1 E{(bf16*)(F.ws + WS_QKV), gates, gates + (size_t)NTOK * 1024, (PROBE_T && (F.vcu == 5 || PROBE_T >= 8)) ? (unsigned*)(F.ctl + 20000) : nullptr};
        stagger_delay(xb_xcc_id() * (unsigned)STAG1);
        pg8::gemm_phase<Epi1, pg8::StaticOrder<false, PROBE_DUP == 9>, false>(F.lds, F.tid, g, S, E, nullptr);
        REPBAR(1);
    }
    SEAM(1);
    if (IN(2)) REP(2) { Frame F = make_frame(wv); attn_phase(F, KIN(3)); REPBAR(2); }
    SEAM(2);
    if (IN(3)) REP(8) { Frame F = make_frame(wv); merge_phase(F); REPBAR(8); }
    SEAM(3);
    if (IN(4)) REP(3) {
        Frame F = make_frame(wv); const bf16* gates = (const bf16*)KPTR(float, KA_OUT); const bf16* qkv = (const bf16*)(F.ws + WS_QKV); const bf16* wbr = (const bf16*)(F.ws + WS_WBR);
        pg8::Gemm g{qkv + (COL_QS / 64) * TS, qkv + (COL_YDIL / 64) * TS, wbr, wbr + 1024, 128, 1536 * 2, 16, 8, TS * 2}; pg8::StaticOrder<true> S; S.init(NTOK, 1024, F.G, F.bx);
        EpiMix E{gates, gates + (size_t)NTOK * 1024, (bf16*)(F.ws + WS_QKV) + (COL_MIX / 64) * TS, (PROBE_T && F.vcu == 5) ? (unsigned*)(F.ctl + 20000) : nullptr};
        pg8::gemm_phase<EpiMix, pg8::StaticOrder<true>, false>(F.lds, F.tid, g, S, E, nullptr);
        REPBAR(3);
    }
    SEAM(4);
    if (IN(5)) REP(4) {
        Frame F = make_frame(wv);
        pg8::Gemm g{(const bf16*)(F.ws + WS_QKV) + (COL_MIX / 64) * TS, nullptr, (const bf16*)(F.ws + WS_WOUT), nullptr, 128, 2048, 16, 16, TS * 2}; pg8::StaticOrder<false> S; S.init(NTOK, 1024, F.G, F.bx, pg8::WGM, true);
        EpiRes E{(const bf16*)(F.ws + WS_H), (const float*)(F.ws + WS_RMS1), (bf16*)(F.ws + WS_X1B), (PROBE_T && F.vcu == 5) ? (unsigned*)(F.ctl + 20000) : nullptr};
        pg8::gemm_phase<EpiRes, pg8::StaticOrder<false>, false>(F.lds, F.tid, g, S, E, nullptr);
        REPBAR(4);
    }
    SEAM(5);
    if (IN(6)) { Frame F = make_frame(wv); router_phase(F, (const bf16*)(F.ws + WS_X1B), KIN(9), KIN(11)); }
    SEAM(6);
    if (IN(7)) { Frame F = make_frame(wv); slots_phase(F); }
    SEAM(7);
    if (IN(8)) REP(5) {
        Frame F = make_frame(wv);
        pg8::Gemm g{(const bf16*)(F.ws + WS_X1B), nullptr, (const bf16*)(F.ws + WS_WGU), nullptr, 2048, 2048, 16, 16, 128}; pg8::PanelOrder S; S.init((const unsigned*)(F.ws + WS_PEX), (volatile LAS int*)(F.lds + PANEL_TAB_OFF), F.G, F.vcu, F.tid);
        EpiGU E{(bf16*)(F.ws + WS_ACT), (const float*)(F.ws + WS_RSS)};
        pg8::gemm_phase<EpiGU, pg8::PanelOrder, true>(F.lds, F.tid, g, S, E, (const unsigned*)(F.ws + WS_TOS));
        REPBAR(5);
    }
    SEAM(8);
    if (IN(9)) REP(6) {
        Frame F = make_frame(wv);
        pg8::Gemm g{(const bf16*)(F.ws + WS_ACT), nullptr, (const bf16*)(F.ws + WS_WD), nullptr, 1024, 1024, 8, 8, 128}; pg8::PanelOrder S; S.init((const unsigned*)(F.ws + WS_PEX), (volatile LAS int*)(F.lds + PANEL_TAB_OFF), F.G, F.vcu, F.tid);
        S.rev = true;
        EpiDown E{(bf16*)(F.ws + WS_YS), (const float*)(F.ws + WS_WOS), (PROBE_T && F.vcu == 5) ? (unsigned*)(F.ctl + 20000) : nullptr};
        pg8::gemm_phase<EpiDown, pg8::PanelOrder, false>(F.lds, F.tid, g, S, E, nullptr);
        REPBAR(6);
    }
    SEAM(9);
    if (IN(10)) { Frame F = make_frame(wv); final_phase(F, KPTR(float, KA_OUT), KIN(15)); }
#if PROBE_T
    { Frame F = make_frame(wv);
      if (F.vcu == 5) { const unsigned kl = ld_agent(F.ctl + 20001), ep = ld_agent(F.ctl + 20002), cyc = ld_agent(F.ctl + 20003), tk = ld_agent(F.ctl + 20004);
        unsigned d = 0;
        if (PROBE_T == 5) d = (unsigned)((float)cyc / (float)tk * 100.f * 25.f);
        if (PROBE_T == 6) d = ep * 2u;
        if (PROBE_T == 7) d = kl;
        if (PROBE_T >= 20 && PROBE_T < 40) { const unsigned t1 = (PROBE_T - 20 == 10) ? (unsigned)__builtin_amdgcn_s_memrealtime() : ld_agent(F.ctl + 20021 + (PROBE_T - 20)); d = 4u * (t1 - ld_agent(F.ctl + 20020 + (PROBE_T - 20))); }
        if (PROBE_T >= 40 && PROBE_T < 46) d = 4u * ld_agent(F.ctl + 20040 + (PROBE_T - 40));
        if (PROBE_T == 8) d = ld_agent(F.ctl + 20010);
        if (PROBE_T == 9) d = 0x7fffffffu - ld_agent(F.ctl + 20011);
        stagger_delay(d > 200000u ? 200000u : d); } }
#endif
#undef IN
#undef SEAM
}

extern "C" void kernel_launch(void* const* d_in, const int* in_sizes, int n_in, void* d_out, int out_size, void* d_ws, size_t ws_size, hipStream_t stream) {
    static int grid = 0;
    if (grid == 0) {
        if (n_in != 16 || in_sizes[0] != NTOK * D || out_size != NTOK * D || ws_size < WS_END) { fprintf(stderr, "kernel_launch: unexpected shapes / workspace (%d inputs, ws %zu)\n", n_in, ws_size); grid = -1; return; }
        int dev = 0, cus = 0;
        if (hipGetDevice(&dev) != hipSuccess || hipDeviceGetAttribute(&cus, hipDeviceAttributeMultiprocessorCount, dev) != hipSuccess) { grid = -1; return; }
        if (hipFuncSetAttribute((const void*)mk_fwd, hipFuncAttributeMaxDynamicSharedMemorySize, LDS_BYTES) != hipSuccess) { fprintf(stderr, "kernel_launch: hipFuncSetAttribute(%d) failed\n", LDS_BYTES); grid = -1; return; }
        int per_cu = 0;
        if (hipOccupancyMaxActiveBlocksPerMultiprocessor(&per_cu, (const void*)mk_fwd, 512, LDS_BYTES) != hipSuccess || per_cu < 1) { fprintf(stderr, "kernel_launch: occupancy query says %d\n", per_cu); }
        (void)hipGetLastError();
        int g = 64; while (g * 2 <= cus && g * 2 <= 256) g *= 2;
        grid = g;
    }
    if (grid < 0) return;
    (void)hipMemsetAsync((char*)d_ws + WS_CTL, 0, CTL_ZERO_BYTES, stream);
    Args a{};
    for (int i = 0; i < 16; ++i) a.in[i] = (const float*)d_in[i];
    a.out = (float*)d_out; a.ws = (unsigned char*)d_ws;
#if MK_ONE_LAUNCH
    a.ph_lo = 0; a.ph_hi = N_PHASES + 1;
    hipLaunchKernelGGL(mk_fwd, dim3(grid), dim3(512), LDS_BYTES, stream, a);
#else
    for (int p = 0; p <= N_PHASES; ++p) { a.ph_lo = p; a.ph_hi = p + 1; hipLaunchKernelGGL(mk_fwd, dim3(grid), dim3(512), LDS_BYTES, stream, a); }
#endif
}
```

```cpp
#include <hip/hip_runtime.h>
#include <cstdio>
#include <cstdint>

#ifndef PROBE_T
#define PROBE_T 0
#endif
#ifndef PROBE_P0
#define PROBE_P0 0
#endif
#ifndef PROBE_EPI
#define PROBE_EPI 1
#endif
#ifndef PROBE_DUP
#define PROBE_DUP 0
#endif
#ifndef MK_ONE_LAUNCH
#define MK_ONE_LAUNCH 1
#endif

#define LAS __attribute__((address_space(3)))
#define GAS __attribute__((address_space(1)))
typedef unsigned short bf16;
typedef short bf16x8 __attribute__((ext_vector_type(8)));
typedef short s16x4 __attribute__((ext_vector_type(4)));
typedef float f32x4 __attribute__((ext_vector_type(4)));
typedef float f32x16 __attribute__((ext_vector_type(16)));
typedef unsigned u32x4 __attribute__((ext_vector_type(4)));
typedef unsigned u32x2 __attribute__((ext_vector_type(2)));
typedef float f32x2_t __attribute__((ext_vector_type(2)));
typedef __bf16 bf16x2_t __attribute__((ext_vector_type(2)));
typedef GAS unsigned gu32;

constexpr int NB = 8, T = 8192, D = 1024, NTOK = NB * T;
constexpr int QKV_W = 5888;
constexpr int IN_W = 7936;
constexpr int COL_KD = 1536, COL_VD = 3072, COL_QS = 4608, COL_KS = 5632, COL_VS = 5760;
constexpr int NEXP = 32, DEXP = 512;
constexpr int SLOT_ROWS = 2 * NTOK + NEXP * 256;
constexpr int MAX_PANELS = SLOT_ROWS / 256;
constexpr float RMS_EPS = 1e-6f;
constexpr float LOG2E = 1.4426950408889634f, LN2 = 0.6931471805599453f;
constexpr float QSCALE = 0.125f * LOG2E;

constexpr size_t MiB = 1u << 20;
constexpr size_t WS_CTL = 0, CTL_ZERO_BYTES = 128 * 1024;
constexpr size_t WS_WIN = 1 * MiB;
constexpr size_t WS_WBR = 17 * MiB;
constexpr size_t WS_WOUT = 20 * MiB;
constexpr size_t WS_WGU = 22 * MiB;
constexpr size_t WS_WD = 86 * MiB;
constexpr size_t WS_WRT = 118 * MiB;
constexpr size_t WS_RE = 119 * MiB;
constexpr size_t WS_RREL = WS_RE + 256 * 1024;
constexpr size_t WS_RW = WS_RREL + 512 * 1024;
constexpr size_t WS_RMS1 = WS_RW + 512 * 1024;
constexpr size_t WS_RSTD2 = WS_RMS1 + 256 * 1024;
constexpr size_t WS_RSS = 125 * MiB;
constexpr size_t WS_TOS = 121 * MiB;
constexpr size_t WS_WOS = 122 * MiB;
constexpr size_t WS_SOT = 123 * MiB;
constexpr size_t WS_PEX = 124 * MiB;
constexpr size_t WS_H = 128 * MiB;
constexpr size_t WS_QKV = 256 * MiB;
constexpr size_t WS_LSE = 992 * MiB;
constexpr size_t WS_ACT = 256 * MiB;
constexpr size_t WS_YS = 392 * MiB;
constexpr size_t WS_X1B = 672 * MiB;
constexpr size_t WS_END = 1000 * MiB;
constexpr int COL_YDIL = 1536, COL_MIX = 0;
constexpr size_t TS = (size_t)NTOK * 64;
static_assert(WS_QKV + (size_t)NTOK * QKV_W * 2 <= WS_LSE && WS_LSE + (size_t)NTOK * 24 * 4 <= WS_END, "qkv/lse map");
static_assert(WS_ACT + (size_t)SLOT_ROWS * 512 * 2 <= WS_YS && WS_YS + (size_t)SLOT_ROWS * 1024 * 2 <= WS_LSE, "moe overlay");
constexpr int CW_BAR = 4096;
constexpr int CW_CNT = 8192;
constexpr int CW_HO = 12288;

constexpr int LDS_BYTES = 155648;
constexpr int MISC_OFF = LDS_BYTES - 256;
constexpr int PANEL_TAB_OFF = 131072 + 1024;
constexpr int PANEL_AUX_OFF = PANEL_TAB_OFF + 256;
static_assert(PANEL_AUX_OFF + 20 * 1024 <= MISC_OFF, "PanelOrder side table");
constexpr int P5_CNT_OFF = 147456, P5_BASE_OFF = P5_CNT_OFF + 128, P5_REC_OFF = P5_BASE_OFF + 128;

#define RLX_AGENT __ATOMIC_RELAXED, __HIP_MEMORY_SCOPE_AGENT
#define LDS_WAIT() asm volatile("s_waitcnt lgkmcnt(0)" ::: "memory")
__device__ __forceinline__ unsigned cvtpk(float lo, float hi) { f32x2_t v = {lo, hi}; bf16x2_t b = __builtin_convertvector(v, bf16x2_t); return __builtin_bit_cast(unsigned, b); }
__device__ __forceinline__ float bf_lo(unsigned u) { return __builtin_bit_cast(float, u << 16); }
__device__ __forceinline__ float bf_hi(unsigned u) { return __builtin_bit_cast(float, u & 0xffff0000u); }
__device__ __forceinline__ unsigned ld_agent(const unsigned* p) { return __hip_atomic_load(p, RLX_AGENT); }
template <int CTRL> __device__ __forceinline__ float dpp(float x) { return __builtin_bit_cast(float, __builtin_amdgcn_mov_dpp(__builtin_bit_cast(int, x), CTRL, 0xf, 0xf, true)); }
__device__ __forceinline__ float wave_sum(float v) {
    v += dpp<0xB1>(v); v += dpp<0x4E>(v); v += dpp<0x141>(v); v += dpp<0x140>(v);
    const int iv = __builtin_bit_cast(int, v);
    const float r0 = __builtin_bit_cast(float, __builtin_amdgcn_readlane(iv, 0)), r1 = __builtin_bit_cast(float, __builtin_amdgcn_readlane(iv, 16));
    const float r2 = __builtin_bit_cast(float, __builtin_amdgcn_readlane(iv, 32)), r3 = __builtin_bit_cast(float, __builtin_amdgcn_readlane(iv, 48));
    return (r0 + r1) + (r2 + r3);
}

namespace pg8 {
constexpr int BM = 256, BK = 64, HALF = 128, HTB = HALF * BK * 2, STAGE_BYTES = 8 * HTB, NXCD = 8, WGM = 8;
__host__ __device__ __forceinline__ int lds_byte(int r, int c) { const int st = (r >> 4) * 2 + (c >> 5), rr = r & 15, cc = c & 31, ob = rr * 64 + cc * 2; return st * 1024 + (ob ^ (((ob >> 9) & 1) << 5)); }
__host__ __device__ __forceinline__ void stage_rc(int b, int& R, int& C) { const int st = b / 1024, sb = b % 1024, swz = sb ^ (((sb >> 9) & 1) << 5); R = (st >> 1) * 16 + swz / 64; C = (st & 1) * 32 + (swz % 64) / 2; }
__host__ __device__ __forceinline__ int perm32(int rho) { const int n = rho >> 4, i = rho & 15; return 8 * (i >> 2) + 4 * n + (i & 3); }

struct Unit { int pm, pn, part, skip, aux; };
struct Gemm { const bf16* A0; const bf16* A1; const bf16* B0; const bf16* B1; int lda, ldb, nt0, nt1; size_t kstepA; };

template <bool CHAIN, bool KDUP = false> struct StaticOrder {
    int nM, nN, nwg, G, c, wgm, nmine;
    __device__ void init(int M, int N, int G_, int c_, int wgm_ = WGM, bool rev = false) { nM = M / BM; nN = N / BM; nwg = nM * nN; G = G_; c = c_; wgm = wgm_; nmine = rev ? (nwg - c_ + G_ - 1) / G_ : 0; }
    __device__ bool next(int i, Unit& u) const {
        int it = (CHAIN || KDUP) ? (i >> 1) : i; u.part = CHAIN ? (i & 1) : 0; u.skip = KDUP ? !(i & 1) : 0; u.aux = 0;
        if (nmine > 0) { if (it >= nmine) return false; it = nmine - 1 - it; }
        const long L = (long)it * G + c; if (L >= nwg) return false;
        int wgid = (int)L; { const int q = nwg / NXCD, r = nwg % NXCD, xcd = wgid % NXCD, off = wgid / NXCD; wgid = (xcd < r ? xcd * (q + 1) : r * (q + 1) + (xcd - r) * q) + off; }
        const int nig = wgm * nN, gid = wgid / nig, fm = gid * wgm, gsz = (nM - fm) < wgm ? (nM - fm) : wgm;
        u.pm = fm + ((wgid % nig) % gsz); u.pn = (wgid % nig) / gsz; return true;
    }
};
constexpr int PANEL_AUX_UNITS = 20;
struct PanelOrder {
    volatile LAS int* tab; int G, c, ib, n;
    bool rev = false;
    __device__ void init(const unsigned* pex, volatile LAS int* tab_, int G_, int c_, int tid, int ib_, int ie_, int np4, const float* aux_src, LAS float* aux_lds) {
        tab = tab_; G = G_; c = c_; ib = ib_;
        int hi = (np4 - c_ + G_ - 1) / G_; hi = hi < ie_ ? hi : ie_; hi = hi < ib_ + PANEL_AUX_UNITS ? hi : ib_ + PANEL_AUX_UNITS; n = hi > ib_ ? hi - ib_ : 0;
        __syncthreads();
        if (tid < 64) { const int L = (ib_ + tid) * G_ + c_; tab_[tid] = (tid < n) ? (int)ld_agent(pex + (L >> 2)) : 0; }
        for (int idx = tid; idx < n * 256; idx += 512) { const int L = (ib_ + (idx >> 8)) * G_ + c_; aux_lds[idx] = aux_src[(size_t)(L >> 2) * 256 + (idx & 255)]; }
        __syncthreads();
    }
    __device__ bool next(int j0, Unit& u) const {
        if (j0 >= n) return false;
        const int j = rev ? n - 1 - j0 : j0, L = (ib + j) * G + c;
        u.pm = L >> 2; u.pn = 4 * __builtin_amdgcn_readfirstlane(tab[j]) + (L & 3); u.part = 0; u.skip = 0; u.aux = j; return true;
    }
};

template <class Epi, class Sched, bool GATHER>
__device__ __forceinline__ void gemm_phase(LAS unsigned char* lds, const int tid, const Gemm g, const Sched& S, const Epi& E, const unsigned* rowidx) {
    const int wid = __builtin_amdgcn_readfirstlane(tid >> 6), lane = tid & 63, wr = wid >> 2, wc = wid & 3, fr = lane & 15, fq = lane >> 4;
    int Rr[2], Cc[2]; unsigned voffB[2];
#pragma unroll
    for (int i = 0; i < 2; ++i) { stage_rc(tid * 16 + i * 8192, Rr[i], Cc[i]); const int Rb = (Rr[i] & ~31) + perm32(Rr[i] & 31); voffB[i] = (unsigned)(Rb * g.ldb + Cc[i] * 2); }
    const size_t kstep = (size_t)(BK * 2), kA = g.kstepA;
    const size_t hstep = (size_t)HALF * g.ldb;
    const size_t tstepA = (size_t)BM * g.lda, tstepB = (size_t)BM * g.ldb;
    const unsigned ldsw = (unsigned)wid * 1024u;
    const int aoff = lds_byte(wr * 64 + fr, fq * 8), boff = lds_byte(wc * 32 + fr, fq * 8);
    unsigned vc[2][2], vn[2][2];
#define PG8_SA(b, h) (((b) * 2 + (h)) * HTB)
#define PG8_SB(b, h) ((4 + (b) * 2 + (h)) * HTB)
#define PG8_STAGE(bufoff, gbase, voff) do { _Pragma("unroll") for (int _i = 0; _i < 2; ++_i) \
        __builtin_amdgcn_global_load_lds((const unsigned*)((const char*)(gbase) + (voff)[_i]), (LAS unsigned*)(lds + (bufoff) + ldsw + _i * 8192), 16, 0, 0); } while (0)
#define PG8_LDA(dst, b, h) do { _Pragma("unroll") for (int m = 0; m < 4; ++m) _Pragma("unroll") for (int k = 0; k < 2; ++k) dst[m][k] = *(const LAS bf16x8*)(lds + PG8_SA(b, h) + aoff + m * 2048 + k * 1024); } while (0)
#define PG8_LDB(dst, b, h) do { _Pragma("unroll") for (int n = 0; n < 2; ++n) _Pragma("unroll") for (int k = 0; k < 2; ++k) dst[n][k] = *(const LAS bf16x8*)(lds + PG8_SB(b, h) + boff + n * 2048 + k * 1024); } while (0)
#define PG8_MMA(ai, bj, At, Bt) do { __builtin_amdgcn_s_setprio(1); _Pragma("unroll") for (int m = 0; m < 4; ++m) _Pragma("unroll") for (int n = 0; n < 2; ++n) _Pragma("unroll") for (int k = 0; k < 2; ++k) \
        acc[ai][bj][m][n] = __builtin_amdgcn_mfma_f32_16x16x32_bf16(Bt[n][k], At[m][k], acc[ai][bj][m][n], 0, 0, 0); __builtin_amdgcn_s_setprio(0); } while (0)
#define PG8_WAIT_V(n) asm volatile("s_waitcnt vmcnt(" #n ")" ::: "memory")
#define PG8_WAIT_L(n) asm volatile("s_waitcnt lgkmcnt(" #n ")" ::: "memory")
#define PG8_BAR __builtin_amdgcn_s_barrier()
#define PG8_SCHED __builtin_amdgcn_sched_barrier(0)
#define PG8_VOFFS(v, u) do { _Pragma("unroll") for (int _h = 0; _h < 2; ++_h) _Pragma("unroll") for (int _i = 0; _i < 2; ++_i) { \
        if (GATHER) { const unsigned _t = rowidx[(u).pm * BM + _h * HALF + Rr[_i]]; v[_h][_i] = _t * (unsigned)g.lda + (unsigned)(Cc[_i] * 2); } \
        else v[_h][_i] = (unsigned)((_h * HALF + Rr[_i]) * g.lda + Cc[_i] * 2); } } while (0)
#define PG8_ZERO() do { _Pragma("unroll") for (int a = 0; a < 2; ++a) _Pragma("unroll") for (int b = 0; b < 2; ++b) _Pragma("unroll") for (int m = 0; m < 4; ++m) _Pragma("unroll") for (int n = 0; n < 2; ++n) acc[a][b][m][n] = (f32x4){0.f, 0.f, 0.f, 0.f}; } while (0)
    Unit cur, nxt; int ui = 0;
    if (!S.next(0, cur)) return;
#if PROBE_T
#define PT_NOW() (Epi::PROBE ? (unsigned)__builtin_amdgcn_s_memrealtime() : 0u)
    unsigned pt_first = 0, pt_rest = 0, pt_epi = 0, pt0 = 0, pt1 = 0, pt2 = 0;
    const unsigned pc_c0 = Epi::PROBE ? (unsigned)__builtin_amdgcn_s_memtime() : 0u, pc_t0 = PT_NOW();
#endif
    f32x4 acc[2][2][4][2];
    PG8_ZERO();
    bf16x8 At[4][2], B0[2][2], B1[2][2];
    PG8_VOFFS(vc, cur);
    const char* cA = GATHER ? (const char*)g.A0 : (const char*)(cur.part ? g.A1 : g.A0) + (size_t)cur.pm * tstepA; const char* cB = (const char*)(cur.part ? g.B1 : g.B0) + (size_t)cur.pn * tstepB;
    int nt = cur.part ? g.nt1 : g.nt0;
    PG8_STAGE(PG8_SB(0, 0), cB, voffB); PG8_STAGE(PG8_SB(0, 1), cB + hstep, voffB); PG8_STAGE(PG8_SA(0, 0), cA, vc[0]); PG8_STAGE(PG8_SA(0, 1), cA, vc[1]);
    if (wr == 1) PG8_BAR;
    PG8_WAIT_V(2); PG8_BAR;
    PG8_STAGE(PG8_SB(1, 0), cB + kstep, voffB); PG8_STAGE(PG8_SA(1, 0), cA + kA, vc[0]); PG8_STAGE(PG8_SB(1, 1), cB + hstep + kstep, voffB);
    PG8_WAIT_V(6); PG8_BAR;
    for (;;) {
        const bool has_next = S.next(ui + 1, nxt);
        const char* nA = GATHER ? (const char*)g.A0 : (has_next ? (const char*)(nxt.part ? g.A1 : g.A0) + (size_t)nxt.pm * tstepA : cA);
        const char* nB = has_next ? (const char*)(nxt.part ? g.B1 : g.B0) + (size_t)nxt.pn * tstepB : cB;
        if constexpr (GATHER) {
            if (has_next) { PG8_VOFFS(vn, nxt); } else {
#pragma unroll
                for (int h = 0; h < 2; ++h)
#pragma unroll
                    for (int i = 0; i < 2; ++i) vn[h][i] = vc[h][i]; }
        }
#if PROBE_T
        pt0 = PT_NOW();
#endif
        for (int t = 0; t < nt; t += 2) {
            const bool last = (t == nt - 2);
            const char* a1 = cA + (size_t)(t + 1) * kA;
            const char* a2 = last ? nA : cA + (size_t)(t + 2) * kA; const char* b2 = last ? nB : cB + (size_t)(t + 2) * kstep;
            const char* a3 = a2 + kA; const char* b3 = b2 + kstep;
            unsigned v2[2][2];
#pragma unroll
            for (int h = 0; h < 2; ++h)
#pragma unroll
                for (int i = 0; i < 2; ++i) { if constexpr (GATHER) v2[h][i] = last ? vn[h][i] : vc[h][i]; else v2[h][i] = vc[h][i]; }
            PG8_LDB(B0, 0, 0); PG8_LDB(B1, 0, 1); PG8_SCHED; PG8_LDA(At, 0, 0); PG8_STAGE(PG8_SA(1, 1), a1, vc[1]);
            PG8_WAIT_V(8); PG8_WAIT_L(0); PG8_BAR; PG8_MMA(0, 0, At, B0); PG8_MMA(0, 1, At, B1); PG8_BAR; PG8_SCHED;
            PG8_LDA(At, 0, 1); PG8_STAGE(PG8_SB(0, 0), b2, voffB); PG8_STAGE(PG8_SB(0, 1), b2 + hstep, voffB); PG8_STAGE(PG8_SA(0, 0), a2, v2[0]);
            PG8_WAIT_V(8); PG8_WAIT_L(0); PG8_BAR; PG8_MMA(1, 0, At, B0); PG8_MMA(1, 1, At, B1); PG8_BAR; PG8_SCHED;
            PG8_LDB(B0, 1, 0); PG8_LDB(B1, 1, 1); PG8_SCHED; PG8_LDA(At, 1, 0); PG8_STAGE(PG8_SA(0, 1), a2, v2[1]);
            PG8_WAIT_V(8); PG8_WAIT_L(0); PG8_BAR; PG8_MMA(0, 0, At, B0); PG8_MMA(0, 1, At, B1); PG8_BAR; PG8_SCHED;
            PG8_LDA(At, 1, 1); PG8_STAGE(PG8_SB(1, 0), b3, voffB); PG8_STAGE(PG8_SB(1, 1), b3 + hstep, voffB); PG8_STAGE(PG8_SA(1, 0), a3, v2[0]);
            PG8_WAIT_V(8); PG8_WAIT_L(0); PG8_BAR; PG8_MMA(1, 0, At, B0); PG8_MMA(1, 1, At, B1); PG8_BAR; PG8_SCHED;
        }
#if PROBE_T
        pt2 = PT_NOW(); pt_rest += pt2 - pt0;
#endif
        if (wr == 0) PG8_BAR;
        bool mid = false;
        if constexpr (Epi::CHAINED) mid = (cur.part == 0);
        if (mid) { if constexpr (Epi::CHAINED) E.mid(acc, cur, wr, wc, fr, fq); } else if (!cur.skip) { E(acc, cur, wr, wc, fr, fq); if (PROBE_DUP == 10 && Epi::PROBE10) { asm volatile("" ::: "memory"); E(acc, cur, wr, wc, fr, fq); } }
#if PROBE_T
        pt_epi += PT_NOW() - pt2;
#endif
        if (!has_next) break;
        if (!mid) PG8_ZERO();
        cur = nxt; cA = nA; cB = nB; nt = cur.part ? g.nt1 : g.nt0; ++ui;
        if constexpr (GATHER) {
#pragma unroll
            for (int h = 0; h < 2; ++h)
#pragma unroll
                for (int i = 0; i < 2; ++i) vc[h][i] = vn[h][i];
        }
        if (wr == 1) PG8_BAR;
    }
    PG8_WAIT_V(0);
    PG8_BAR;
#if PROBE_T
    if constexpr (Epi::PROBE) { if (E.probe_out && tid == 0) { E.probe_out[0] = pt_first; E.probe_out[1] = pt_rest; E.probe_out[2] = pt_epi; E.probe_out[3] = (unsigned)__builtin_amdgcn_s_memtime() - pc_c0; E.probe_out[4] = PT_NOW() - pc_t0;
        if (PROBE_T >= 8) { atomicMax(E.probe_out + 10, PT_NOW() - pc_t0); atomicMax(E.probe_out + 11, 0x7fffffffu - (PT_NOW() - pc_t0)); } } }
#endif
#undef PG8_SA
#undef PG8_SB
#undef PG8_STAGE
#undef PG8_LDA
#undef PG8_LDB
#undef PG8_MMA
#undef PG8_WAIT_V
#undef PG8_WAIT_L
#undef PG8_BAR
#undef PG8_SCHED
#undef PG8_VOFFS
#undef PG8_ZERO
}
}

__device__ __forceinline__ float sigmoidf_fast(float a) { return __builtin_amdgcn_rcpf(1.f + __builtin_amdgcn_exp2f(-a * LOG2E)); }
__device__ __forceinline__ u32x4 pack8(const f32x4 a, const f32x4 b) { u32x4 w; w.x = cvtpk(a[0], a[1]); w.y = cvtpk(a[2], a[3]); w.z = cvtpk(b[0], b[1]); w.w = cvtpk(b[2], b[3]); return w; }
__device__ __forceinline__ void unpack8(const u32x4 w, f32x4& a, f32x4& b) { a = (f32x4){bf_lo(w.x), bf_hi(w.x), bf_lo(w.y), bf_hi(w.y)}; b = (f32x4){bf_lo(w.z), bf_hi(w.z), bf_lo(w.w), bf_hi(w.w)}; }
typedef const f32x4 (&AccRef)[2][2][4][2];
typedef f32x4 (&AccMut)[2][2][4][2];

struct Epi1 {
    static constexpr bool CHAINED = false; static constexpr bool PROBE = (PROBE_T != 0 && PROBE_EPI == 1); static constexpr bool PROBE10 = true;
    bf16* qkv; bf16* sgd; bf16* sgs; unsigned* probe_out;
    __device__ __forceinline__ void operator()(AccRef acc, const pg8::Unit& u, int wr, int wc, int fr, int fq) const {
        const int pn = u.pn;
        if (pn < 23) {
            int sh = 0; float sc = 1.f;
            if (pn < 18) { sh = 2 * ((pn % 6) >> 1); if (pn < 6) sc = QSCALE; } else if (pn < 22) sc = QSCALE;
            const int col0 = pn * 256 + wc * 32 + fq * 8;
#pragma unroll
            for (int ai = 0; ai < 2; ++ai)
#pragma unroll
                for (int m = 0; m < 4; ++m) {
                    const int row = u.pm * 256 + ai * 128 + wr * 64 + m * 16 + fr, t = row & (T - 1);
                    const int rowp = (row & ~(T - 1)) | ((t & ((1 << sh) - 1)) << (13 - sh)) | (t >> sh);
                    bf16* rp = qkv + (size_t)(col0 >> 6) * TS + (size_t)rowp * 64 + (col0 & 63);
#pragma unroll
                    for (int bj = 0; bj < 2; ++bj) *(u32x4*)(rp + bj * 2 * TS) = pack8(acc[ai][bj][m][0] * sc, acc[ai][bj][m][1] * sc);
                }
        } else {
            const int col0 = (pn - 23) * 128 + wc * 32 + fq * 8;
#pragma unroll
            for (int ai = 0; ai < 2; ++ai)
#pragma unroll
                for (int m = 0; m < 4; ++m) {
                    const size_t off = (size_t)(u.pm * 256 + ai * 128 + wr * 64 + m * 16 + fr) * 1024 + col0;
#pragma unroll
                    for (int bj = 0; bj < 2; ++bj) { f32x4 a = acc[ai][bj][m][0], b = acc[ai][bj][m][1];
#pragma unroll
                        for (int i = 0; i < 4; ++i) { a[i] = fminf(__builtin_amdgcn_exp2f(a[i] * -LOG2E), 1e30f); b[i] = fminf(__builtin_amdgcn_exp2f(b[i] * -LOG2E), 1e30f); }
                        __builtin_nontemporal_store(pack8(a, b), (u32x4*)((bj ? sgs : sgd) + off)); }
                }
        }
    }
};
struct EpiMix {
    static constexpr bool CHAINED = true; static constexpr bool PROBE = (PROBE_T != 0 && PROBE_EPI == 4); static constexpr bool PROBE10 = false;
    const bf16* sgd; const bf16* sgs; bf16* mix; unsigned* probe_out;
    __device__ __forceinline__ void mid(AccMut acc, const pg8::Unit& u, int wr, int wc, int fr, int fq) const {
#pragma unroll
        for (int ai = 0; ai < 2; ++ai)
#pragma unroll
            for (int m = 0; m < 4; ++m) {
                const size_t off = (size_t)(u.pm * 256 + ai * 128 + wr * 64 + m * 16 + fr) * 1024 + u.pn * 256 + wc * 32 + fq * 8;
#pragma unroll
                for (int bj = 0; bj < 2; ++bj) { f32x4 da, db, sa, sb; unpack8(*(const u32x4*)(sgd + off + bj * 128), da, db); unpack8(*(const u32x4*)(sgs + off + bj * 128), sa, sb);
#pragma unroll
                    for (int i = 0; i < 4; ++i) { acc[ai][bj][m][0][i] *= (1.f + da[i]) * __builtin_amdgcn_rcpf(1.f + sa[i]); acc[ai][bj][m][1][i] *= (1.f + db[i]) * __builtin_amdgcn_rcpf(1.f + sb[i]); } }
            }
    }
    __device__ __forceinline__ void operator()(AccRef acc, const pg8::Unit& u, int wr, int wc, int fr, int fq) const {
        u32x4 gd[2][4][2];
#pragma unroll
        for (int ai = 0; ai < 2; ++ai)
#pragma unroll
            for (int m = 0; m < 4; ++m) {
                const size_t off = (size_t)(u.pm * 256 + ai * 128 + wr * 64 + m * 16 + fr) * 1024 + u.pn * 256 + wc * 32 + fq * 8;
#pragma unroll
                for (int bj = 0; bj < 2; ++bj) gd[ai][m][bj] = *(const u32x4*)(sgd + off + bj * 128);
            }
        __builtin_amdgcn_sched_barrier(0);
#pragma unroll
        for (int ai = 0; ai < 2; ++ai)
#pragma unroll
            for (int m = 0; m < 4; ++m) {
                const size_t row = (size_t)(u.pm * 256 + ai * 128 + wr * 64 + m * 16 + fr); const int col = u.pn * 256 + wc * 32 + fq * 8;
#pragma unroll
                for (int bj = 0; bj < 2; ++bj) { f32x4 da, db; unpack8(gd[ai][m][bj], da, db);
#pragma unroll
                    for (int i = 0; i < 4; ++i) { da[i] = __builtin_amdgcn_rcpf(1.f + da[i]); db[i] = __builtin_amdgcn_rcpf(1.f + db[i]); }
                    *(u32x4*)(mix + (size_t)((col >> 6) + 2 * bj) * TS + row * 64 + (col & 63)) = pack8(da * acc[ai][bj][m][0], db * acc[ai][bj][m][1]); }
            }
    }
};
struct EpiRes {
    static constexpr bool CHAINED = false; static constexpr bool PROBE = (PROBE_T != 0 && PROBE_EPI == 5); static constexpr bool PROBE10 = false;
    const bf16* hx; const float* rms; bf16* x1b; unsigned* probe_out;
    __device__ __forceinline__ void operator()(AccRef acc, const pg8::Unit& u, int wr, int wc, int fr, int fq) const {
        u32x4 xv[2][4][2]; float rm[2][4];
#pragma unroll
        for (int ai = 0; ai < 2; ++ai)
#pragma unroll
            for (int m = 0; m < 4; ++m) {
                const int row = u.pm * 256 + ai * 128 + wr * 64 + m * 16 + fr;
                const size_t off = (size_t)row * 1024 + u.pn * 256 + wc * 32 + fq * 8;
                rm[ai][m] = rms[row];
#pragma unroll
                for (int bj = 0; bj < 2; ++bj) xv[ai][m][bj] = *(const u32x4*)(hx + off + bj * 128);
            }
        __builtin_amdgcn_sched_barrier(0);
#pragma unroll
        for (int ai = 0; ai < 2; ++ai)
#pragma unroll
            for (int m = 0; m < 4; ++m) {
                const size_t off = (size_t)(u.pm * 256 + ai * 128 + wr * 64 + m * 16 + fr) * 1024 + u.pn * 256 + wc * 32 + fq * 8;
#pragma unroll
                for (int bj = 0; bj < 2; ++bj) { f32x4 a, b; unpack8(xv[ai][m][bj], a, b);
                    *(u32x4*)(x1b + off + bj * 128) = pack8(a * rm[ai][m] + acc[ai][bj][m][0], b * rm[ai][m] + acc[ai][bj][m][1]); }
            }
    }
};
__device__ __forceinline__ void epi_row_scalars(float (&rs)[2][4], const LAS float* l, const pg8::Unit& u, int wr, int fr) {
    const unsigned a = (unsigned)reinterpret_cast<__SIZE_TYPE__>(l) + (unsigned)((u.aux * 256 + wr * 64 + fr) * 4);
#pragma unroll
    for (int ai = 0; ai < 2; ++ai)
#pragma unroll
        for (int m = 0; m < 4; ++m) asm volatile("ds_read_b32 %0, %1 offset:%c2" : "=&v"(rs[ai][m]) : "v"(a), "i"((ai * 128 + m * 16) * 4) : "memory");
    asm volatile("s_waitcnt lgkmcnt(0)" : "+v"(rs[0][0]), "+v"(rs[0][1]), "+v"(rs[0][2]), "+v"(rs[0][3]), "+v"(rs[1][0]), "+v"(rs[1][1]), "+v"(rs[1][2]), "+v"(rs[1][3]) :: "memory");
}
struct EpiGU {
    static constexpr bool CHAINED = false; static constexpr bool PROBE = false; static constexpr bool PROBE10 = false;
    bf16* act; const float* rss; const LAS float* rsl;
    __device__ __forceinline__ void operator()(AccRef acc, const pg8::Unit& u, int wr, int wc, int fr, int fq) const {
        const int col0 = (u.pn & 3) * 128 + wc * 32 + fq * 8;
        float rs[2][4];
        epi_row_scalars(rs, rsl, u, wr, fr);
        __builtin_amdgcn_sched_barrier(0);
#pragma unroll
        for (int ai = 0; ai < 2; ++ai)
#pragma unroll
            for (int m = 0; m < 4; ++m) {
                const size_t off = (size_t)(u.pm * 256 + ai * 128 + wr * 64 + m * 16 + fr) * DEXP + col0;
                f32x4 o[2];
#pragma unroll
                for (int n = 0; n < 2; ++n)
#pragma unroll
                    for (int i = 0; i < 4; ++i) { const float gt = acc[ai][0][m][n][i] * rs[ai][m]; o[n][i] = gt * sigmoidf_fast(gt) * (acc[ai][1][m][n][i] * rs[ai][m]); }
                *(u32x4*)(act + off) = pack8(o[0], o[1]);
            }
    }
};
struct EpiDown {
    static constexpr bool CHAINED = false; static constexpr bool PROBE = (PROBE_T != 0 && PROBE_EPI == 9); static constexpr bool PROBE10 = false;
    bf16* ys; const float* wos; const LAS float* wsl; unsigned* probe_out;
    __device__ __forceinline__ void operator()(AccRef acc, const pg8::Unit& u, int wr, int wc, int fr, int fq) const {
        float wv[2][4];
        epi_row_scalars(wv, wsl, u, wr, fr);
        __builtin_amdgcn_sched_barrier(0);
#pragma unroll
        for (int ai = 0; ai < 2; ++ai)
#pragma unroll
            for (int m = 0; m < 4; ++m) {
                const int row = u.pm * 256 + ai * 128 + wr * 64 + m * 16 + fr;
                const size_t off = (size_t)row * 1024 + (u.pn & 3) * 256 + wc * 32 + fq * 8;
#pragma unroll
                for (int bj = 0; bj < 2; ++bj) *(u32x4*)(ys + off + bj * 128) = pack8(acc[ai][bj][m][0] * wv[ai][m], acc[ai][bj][m][1] * wv[ai][m]);
            }
    }
};

namespace att {
constexpr int VPITCH = 128, KROWS = 384, LDS_K = 0, LDS_V = KROWS * 128;
static_assert(LDS_V + 2 * KROWS * VPITCH <= 147456, "attention LDS: K image + two V images");
#define MFMA32(a, b, c) __builtin_amdgcn_mfma_f32_32x32x16_bf16((a), (b), (c), 0, 0, 0)
typedef short v4i16_t __attribute__((ext_vector_type(4)));
__device__ __forceinline__ s16x4 vtr(const LAS unsigned char* p) { return __builtin_bit_cast(s16x4, __builtin_amdgcn_ds_read_tr16_b64_v4i16((LAS v4i16_t*)p)); }

struct UnitDesc {
    const bf16* rb;
    int qcol, kcol, vcol;
    int has_prev, nh, mixer, head0, dil;
    int ltok0, lstride;
};
template <bool ISV> __device__ __forceinline__ void dma_image(LAS unsigned char* img, const bf16* g0  , const int w, const int lane, const bool has_prev) {
#pragma unroll
    for (int j = 0; j < 6; ++j) {
        if (j >= 2 || has_prev) {
            const int pi = w + 8 * j, r = 8 * pi + (lane >> 3), cp = lane & 7, c = ISV ? (cp ^ (((r >> 1) & 1) << 2)) : (cp ^ ((r >> 1) & 7));
            __builtin_amdgcn_global_load_lds((const unsigned*)(g0 + (ptrdiff_t)(r - 128) * 64 + c * 8), (LAS unsigned*)(img + pi * 1024), 16, 0, 0);
        }
    }
}
#define ATT_WAIT_V(n) asm volatile("s_waitcnt vmcnt(" #n ")" ::: "memory")
#define ATT_BAR() do { asm volatile("s_waitcnt lgkmcnt(0)" ::: "memory"); __builtin_amdgcn_s_barrier(); asm volatile("" ::: "memory"); } while (0)
__device__ __forceinline__ void attn_unit(LAS unsigned char* lds, const int tid, const UnitDesc& U, const float* sinks, float* lse, const bool has_next, const UnitDesc& Un, bf16x8 (&qn)[4], const int vpar, unsigned (&pt)[6]) {
#define APT(i) do { if (PROBE_T >= 40) { const unsigned _n = (unsigned)__builtin_amdgcn_s_memrealtime(); pt[i] += _n - ptl; ptl = _n; } } while (0)
    unsigned ptl = (PROBE_T >= 40) ? (unsigned)__builtin_amdgcn_s_memrealtime() : 0u;
    const int w = __builtin_amdgcn_readfirstlane(tid >> 6), lane = tid & 63, ql = lane & 31, h = lane >> 5;
    const int cstart = U.has_prev ? 0 : (w < 4 ? 4 - w : 0);
    const int i16 = lane & 15, q4 = i16 >> 2, p4 = i16 & 3, blk = (lane >> 4) & 1, swz = (q4 >> 1) & 1, kswz = (ql >> 1) & 7;
    float skl = 0.f;
    if (U.mixer) { const int hs = U.head0 + (lane & 7); skl = sinks[hs < 16 ? hs : 15]; }
    ATT_WAIT_V(0);
#pragma unroll
    for (int kk = 0; kk < 4; ++kk) asm volatile("" : "+v"(qn[kk]));
    asm volatile("" : "+v"(skl));
    ATT_BAR();
    APT(0);
    LAS unsigned char* const vimg = lds + LDS_V + vpar * (KROWS * VPITCH);
    const unsigned vbl = (unsigned)reinterpret_cast<__SIZE_TYPE__>(vimg) + (unsigned)((32 * w + 4 * h + q4) * VPITCH + (2 * blk + (p4 >> 1)) * 16 + 8 * (p4 & 1));
    const unsigned vb0 = vbl + (unsigned)(64 * swz), vb1 = vbl + (unsigned)(64 * (swz ^ 1));
    unsigned kbase[4];
#pragma unroll
    for (int kk = 0; kk < 4; ++kk) kbase[kk] = (unsigned)reinterpret_cast<__SIZE_TYPE__>(lds + LDS_K) + (unsigned)((32 * w + ql) * 128 + (((2 * kk + h) ^ kswz) * 16));
    for (int hh = 0; hh < U.nh; ++hh) {
        const int head = U.head0 + hh;
        const float slope = U.mixer ? __builtin_amdgcn_exp2f(-0.5f * (float)(head + 1)) : __builtin_amdgcn_exp2f((float)(head + 1) * (-8.f / 24.f));
        const float c2 = slope * (float)U.dil * LOG2E;
        const float sink2 = U.mixer ? __builtin_bit_cast(float, __builtin_amdgcn_readlane(__builtin_bit_cast(int, skl), hh)) * LOG2E : -INFINITY;
        bf16x8 qf[4];
#pragma unroll
        for (int kk = 0; kk < 4; ++kk) qf[kk] = qn[kk];
        if (hh == 0 && has_next) dma_image<true>(lds + LDS_V + (vpar ^ 1) * (KROWS * VPITCH), Un.rb + (size_t)Un.vcol * TS, w, lane, Un.has_prev != 0);
        f32x16 S[5];
        const float tl = -c2 * (float)(128 + ql - 4 * h);
        bf16x8 ka[4];
#define QK_READ(set, c) do { _Pragma("unroll") for (int kk = 0; kk < 4; ++kk) \
            asm volatile("ds_read_b128 %0, %1 offset:%c2" : "=&v"(set[kk]) : "v"(kbase[kk]), "i"((32 * (c)) * 128) : "memory"); } while (0)
#define QK_STEP(cur, nxt, c) do { if ((c) >= cstart) { \
            if ((c) == cstart) QK_READ(cur, c); \
            const float tc = tl + c2 * (32.f * (float)(c)); \
            _Pragma("unroll") for (int r = 0; r < 16; ++r) S[c][r] = tc + c2 * (float)((r & 3) + 8 * (r >> 2)); \
            asm volatile("s_waitcnt lgkmcnt(0)" : "+v"(cur[0]), "+v"(cur[1]), "+v"(cur[2]), "+v"(cur[3]) :: "memory"); \
            if ((c) + 1 < 5) QK_READ(nxt, (c) + 1);        \
            _Pragma("unroll") for (int kk = 0; kk < 4; ++kk) S[c] = MFMA32(cur[kk], qf[kk], S[c]); \
        } else { _Pragma("unroll") for (int r = 0; r < 16; ++r) S[c][r] = -INFINITY; } } while (0)
        bf16x8 kb[4];
        QK_STEP(ka, kb, 0); QK_STEP(kb, ka, 1); QK_STEP(ka, kb, 2); QK_STEP(kb, ka, 3); QK_STEP(ka, kb, 4);
#undef QK_READ
#undef QK_STEP
        APT(1);
        if (hh + 1 < U.nh) {
            const bf16* qrow = U.rb + (size_t)(U.qcol + hh + 1) * TS + (32 * w + ql) * 64 + 8 * h;
#pragma unroll
            for (int kk = 0; kk < 4; ++kk) qn[kk] = *(const bf16x8*)(qrow + 16 * kk);
        }
        if (hh == U.nh - 1) {
            ATT_BAR();
            if (has_next) {
                dma_image<false>(lds + LDS_K, Un.rb + (size_t)Un.kcol * TS, w, lane, Un.has_prev != 0);
                const bf16* qrow = Un.rb + (size_t)Un.qcol * TS + (32 * w + ql) * 64 + 8 * h;
#pragma unroll
                for (int kk = 0; kk < 4; ++kk) qn[kk] = *(const bf16x8*)(qrow + 16 * kk);
            }
        }
        const int d0 = U.mixer;
#pragma unroll
        for (int r = 0; r < 16; ++r) { const int kl = (r & 3) + 8 * (r >> 2) + 4 * h; if (kl < ql + d0) S[0][r] = -INFINITY; if (kl > ql) S[4][r] = -INFINITY; }
        float m = sink2;
#pragma unroll
        for (int c = 0; c < 5; ++c)
#pragma unroll
            for (int r = 0; r < 16; ++r) m = fmaxf(m, S[c][r]);
        m = fmaxf(m, __shfl_xor(m, 32));
        f32x2_t l2 = {0.f, 0.f}; const f32x2_t m2 = {m, m};
        APT(2);
        APT(3);
        f32x16 O[2];
#pragma unroll
        for (int r = 0; r < 16; ++r) { O[0][r] = 0.f; O[1][r] = 0.f; }
        s16x4 ra[4], rb[4];
#define PV_READ(set, k) do { \
            asm volatile("ds_read_b64_tr_b16 %0, %1 offset:%c2" : "=&v"(set[0]) : "v"(vb0), "i"((16 * (k)) * VPITCH) : "memory"); \
            asm volatile("ds_read_b64_tr_b16 %0, %1 offset:%c2" : "=&v"(set[1]) : "v"(vb0), "i"((16 * (k) + 8) * VPITCH) : "memory"); \
            asm volatile("ds_read_b64_tr_b16 %0, %1 offset:%c2" : "=&v"(set[2]) : "v"(vb1), "i"((16 * (k)) * VPITCH) : "memory"); \
            asm volatile("ds_read_b64_tr_b16 %0, %1 offset:%c2" : "=&v"(set[3]) : "v"(vb1), "i"((16 * (k) + 8) * VPITCH) : "memory"); } while (0)
#define PV_EXP(k) do { _Pragma("unroll") for (int r = 0; r < 8; r += 2) {     \
            const f32x2_t d2 = (f32x2_t){S[(k) >> 1][8 * ((k) & 1) + r], S[(k) >> 1][8 * ((k) & 1) + r + 1]} - m2; \
            f32x2_t p2; p2.x = __builtin_amdgcn_exp2f(d2.x); p2.y = __builtin_amdgcn_exp2f(d2.y); \
            S[(k) >> 1][8 * ((k) & 1) + r] = p2.x; S[(k) >> 1][8 * ((k) & 1) + r + 1] = p2.y; l2 += p2; } } while (0)
#define PV_STEP(cur, nxt, k) do { if (((k) >> 1) >= cstart) { \
            if ((k) == 2 * cstart) { PV_READ(cur, k); PV_EXP(k); } \
            asm volatile("s_waitcnt lgkmcnt(0)" : "+v"(cur[0]), "+v"(cur[1]), "+v"(cur[2]), "+v"(cur[3]) :: "memory"); \
            if ((k) + 1 < 10) PV_READ(nxt, (k) + 1); \
            u32x4 pw; pw.x = cvtpk(S[(k) >> 1][8 * ((k) & 1)], S[(k) >> 1][8 * ((k) & 1) + 1]); pw.y = cvtpk(S[(k) >> 1][8 * ((k) & 1) + 2], S[(k) >> 1][8 * ((k) & 1) + 3]); \
            pw.z = cvtpk(S[(k) >> 1][8 * ((k) & 1) + 4], S[(k) >> 1][8 * ((k) & 1) + 5]); pw.w = cvtpk(S[(k) >> 1][8 * ((k) & 1) + 6], S[(k) >> 1][8 * ((k) & 1) + 7]); \
            const bf16x8 pf = __builtin_bit_cast(bf16x8, pw); \
            O[0] = MFMA32(__builtin_shufflevector(cur[0], cur[1], 0, 1, 2, 3, 4, 5, 6, 7), pf, O[0]); \
            O[1] = MFMA32(__builtin_shufflevector(cur[2], cur[3], 0, 1, 2, 3, 4, 5, 6, 7), pf, O[1]); \
            if ((k) + 1 < 10) PV_EXP((k) + 1);     } } while (0)
        PV_STEP(ra, rb, 0); PV_STEP(rb, ra, 1); PV_STEP(ra, rb, 2); PV_STEP(rb, ra, 3); PV_STEP(ra, rb, 4);
        PV_STEP(rb, ra, 5); PV_STEP(ra, rb, 6); PV_STEP(rb, ra, 7); PV_STEP(ra, rb, 8); PV_STEP(rb, ra, 9);
#undef PV_READ
#undef PV_STEP
#undef PV_EXP
        float l = l2.x + l2.y;
        l += __shfl_xor(l, 32);
        l += __builtin_amdgcn_exp2f(sink2 - m);
        APT(4);
        const float inv = 1.f / l;
        const int qi = 32 * w + ql;
        bf16* op = const_cast<bf16*>(U.rb) + (size_t)(U.qcol + hh) * TS + qi * 64 + 8 * h;
#pragma unroll
        for (int dt = 0; dt < 2; ++dt)
#pragma unroll
            for (int j = 0; j < 2; ++j) {
                const int ga = 2 * j, gb = 2 * j + 1;
                const unsigned ax = cvtpk(O[dt][4 * ga] * inv, O[dt][4 * ga + 1] * inv), ay = cvtpk(O[dt][4 * ga + 2] * inv, O[dt][4 * ga + 3] * inv);
                const unsigned bx_ = cvtpk(O[dt][4 * gb] * inv, O[dt][4 * gb + 1] * inv), by = cvtpk(O[dt][4 * gb + 2] * inv, O[dt][4 * gb + 3] * inv);
                const auto sx = __builtin_amdgcn_permlane32_swap(ax, bx_, false, false), sy = __builtin_amdgcn_permlane32_swap(ay, by, false, false);
                u32x4 o4; o4.x = sx[0]; o4.y = sy[0]; o4.z = sx[1]; o4.w = sy[1];
                *(u32x4*)(op + 32 * dt + 16 * j) = o4; }
        if (!U.mixer && h == 0) lse[(size_t)(U.ltok0 + qi * U.lstride) * 24 + head] = (m + __builtin_amdgcn_logf(l)) * LN2;
        APT(5);
    }
#undef APT
}
#undef ATT_WAIT_V
#undef ATT_BAR
#undef MFMA32
}

#define XB_TMO      128
#define XB_XCNT(j)  (256  + 64 * (j))
#define XB_XSUB(j)  (1280 + 64 * (j))
#define XB_XGEN(j)  (2304 + 64 * (j))
#define XB_TOP      3328
#define XB_TOPGEN   3392
#define XCD_BAR_WORDS 3456
#define XB_SPIN_CAP (1u << 18)
__device__ __forceinline__ unsigned xb_ld(unsigned* p)              { return __hip_atomic_load(p, __ATOMIC_RELAXED, __HIP_MEMORY_SCOPE_AGENT); }
__device__ __forceinline__ unsigned xb_add(unsigned* p, unsigned v) { return __hip_atomic_fetch_add(p, v, __ATOMIC_RELAXED, __HIP_MEMORY_SCOPE_AGENT); }
__device__ __forceinline__ unsigned xb_xcc_id() { return (unsigned)__builtin_amdgcn_s_getreg((3 << 11) | 20) & 0xFu; }
#define XB_SPIN(cond, bar) do { unsigned _sp = 0; while (cond) { __builtin_amdgcn_s_sleep(1); \
    if ((++_sp & 255u) == 0u) { if (xb_ld(&(bar)[XB_TMO])) break; if (_sp > XB_SPIN_CAP) { atomicAdd(&(bar)[XB_TMO], 1u); break; } } } } while (0)
struct XcdBarrier { unsigned* bar; unsigned x; volatile LAS unsigned* st; };
__device__ __forceinline__ XcdBarrier xcd_barrier_post(unsigned* bar, volatile LAS unsigned* st) {
    XcdBarrier b; b.bar = bar; b.x = xb_xcc_id(); b.st = st;
    if (threadIdx.x == 0) (void)xb_add(&bar[XB_XCNT(b.x)], 1u);
    return b;
}
__device__ __forceinline__ void xcd_barrier_complete(unsigned* bar, unsigned x, unsigned& nloc, unsigned& nx) {
    const unsigned G = gridDim.x * gridDim.y * gridDim.z;
    unsigned sum, cnt, mine, sp = 0u;
    for (;;) {
        sum = 0u; cnt = 0u; mine = 0u;
#pragma unroll
        for (unsigned j = 0; j < 16; ++j) { const unsigned c = xb_ld(&bar[XB_XCNT(j)]); sum += c; cnt += (c > 0u) ? 1u : 0u; mine = (j == x) ? c : mine; }
        if (sum == G) break;
        __builtin_amdgcn_s_sleep(1);
        if ((++sp & 255u) == 0u) { if (xb_ld(&bar[XB_TMO])) break; if (sp > XB_SPIN_CAP) { atomicAdd(&bar[XB_TMO], 1u); break; } }
    }
    nloc = mine > 0u ? mine : 1u; nx = cnt > 0u ? cnt : 1u;
}
__device__ __forceinline__ void xcd_barrier(const XcdBarrier& b) {
    asm volatile("s_waitcnt vmcnt(0)" ::: "memory");
    __syncthreads();
    if (threadIdx.x == 0) {
        unsigned* bar = b.bar;
        __builtin_amdgcn_s_waitcnt(0);
        unsigned nloc = b.st[0], nx = b.st[1];
        if (nloc == 0u) { xcd_barrier_complete(bar, b.x, nloc, nx); b.st[0] = nloc; b.st[1] = nx; }
        const unsigned old = xb_add(&bar[XB_XSUB(b.x)], 1u);
        const unsigned gen = old / nloc;
        if (old + 1u == (gen + 1u) * nloc) {
            __builtin_amdgcn_fence(__ATOMIC_RELEASE, "agent");
            asm volatile("s_waitcnt vmcnt(0)" ::: "memory");
            const unsigned og = xb_add(&bar[XB_TOP], 1u);
            const unsigned tg = og / nx;
            if (og + 1u == (tg + 1u) * nx) xb_add(&bar[XB_TOPGEN], 1u);
            else XB_SPIN(xb_ld(&bar[XB_TOPGEN]) == tg, bar);
            __builtin_amdgcn_fence(__ATOMIC_ACQUIRE, "agent");
            xb_add(&bar[XB_XGEN(b.x)], 1u);
            asm volatile("s_waitcnt vmcnt(0)" ::: "memory");
        } else {
            XB_SPIN(xb_ld(&bar[XB_XGEN(b.x)]) == gen, bar);
            __builtin_amdgcn_fence(__ATOMIC_ACQUIRE, "agent");
            asm volatile("s_waitcnt vmcnt(0)" ::: "memory");
        }
    }
    __syncthreads();
}

struct Args { const float* in[16]; float* out; unsigned char* ws; int ph_lo, ph_hi; };
struct Frame {
    LAS unsigned char* lds; volatile LAS unsigned* MISC; unsigned* ctl; unsigned char* ws;
    int tid, lane, wave, vcu, G, bx;
};

template <bool GAIN>
__device__ __forceinline__ void tr_item(const float* W, int ldw, int k0, int src_n0, bf16* WT, int ldt, int dst_r0, LAS float* scr, int lane, const float* gk = nullptr, const bool dostore = true) {
#pragma unroll 8
    for (int i = 0; i < 32; ++i) { const int kk = 2 * i + (lane >> 5); float w = __builtin_nontemporal_load(W + (size_t)(k0 + kk) * ldw + src_n0 + (lane & 31)); if (GAIN) w *= gk[k0 + kk]; scr[kk * 33 + (lane & 31)] = w; }
    LDS_WAIT(); asm volatile("" ::: "memory");
    const int c = lane & 7;
#pragma unroll
    for (int j = 0; j < 4; ++j) { const int n = (lane >> 3) + 8 * j; const LAS float* sp = scr + (8 * c) * 33 + n;
        u32x4 o; o.x = cvtpk(sp[0 * 33], sp[1 * 33]); o.y = cvtpk(sp[2 * 33], sp[3 * 33]); o.z = cvtpk(sp[4 * 33], sp[5 * 33]); o.w = cvtpk(sp[6 * 33], sp[7 * 33]);
        if (dostore) *(u32x4*)(WT + (size_t)(dst_r0 + n) * ldt + k0 + 8 * c) = o; else asm volatile("" :: "v"(o)); }
    LDS_WAIT(); asm volatile("" ::: "memory");
}
__device__ __forceinline__ void p0_prologue(const Frame& F, const Args& a) {
    LAS float* scr = (LAS float*)(F.lds + F.wave * 16384);
    const int gw = F.vcu * 8 + F.wave, NGW = F.G * 8, lane = F.lane;
    bf16* win = (bf16*)(F.ws + WS_WIN); bf16* wbr = (bf16*)(F.ws + WS_WBR); bf16* wout = (bf16*)(F.ws + WS_WOUT);
    bf16* wgu = (bf16*)(F.ws + WS_WGU); bf16* wd = (bf16*)(F.ws + WS_WD);
    constexpr int I_IN = 16 * 248, I_BD = 8 * 32, I_BS = 16 * 32, I_OUT = 16 * 32, I_G = 32 * 256, I_U = 32 * 256, I_D = 32 * 256;
    constexpr int NITEMS = I_IN + I_BD + I_BS + I_OUT + I_G + I_U + I_D;
    const float* x = a.in[0]; bf16* H = (bf16*)(F.ws + WS_H); float* rms1 = (float*)(F.ws + WS_RMS1);
    f32x4 vnx[4]; int nrow = gw;
    if (nrow < NTOK) { const f32x4* xr0 = (const f32x4*)(x + (size_t)nrow * 1024) + lane;
#pragma unroll
        for (int j = 0; j < 4; ++j) vnx[j] = __builtin_nontemporal_load(xr0 + 64 * j); }
#define P0_NORM_ROW() do { if (nrow < NTOK) { const int row = nrow; nrow += NGW; \
        f32x4 v[4]; float ss = 0.f; \
        _Pragma("unroll") for (int j = 0; j < 4; ++j) v[j] = vnx[j]; \
        if (nrow < NTOK) { const f32x4* xrn = (const f32x4*)(x + (size_t)nrow * 1024) + lane; _Pragma("unroll") for (int j = 0; j < 4; ++j) vnx[j] = __builtin_nontemporal_load(xrn + 64 * j); } \
        _Pragma("unroll") for (int j = 0; j < 4; ++j) ss += (v[j].x * v[j].x + v[j].y * v[j].y) + (v[j].z * v[j].z + v[j].w * v[j].w); \
        const float rms = sqrtf(wave_sum(ss) * (1.f / 1024.f) + RMS_EPS), rstd = 1.f / rms; \
        if (lane == 0) rms1[row] = rms; \
        u32x2* o = (u32x2*)(H + (size_t)row * 1024) + lane; \
        _Pragma("unroll") for (int j = 0; j < 4; ++j) { const f32x4 t = v[j] * rstd; u32x2 p; p.x = cvtpk(t.x, t.y); p.y = cvtpk(t.z, t.w); o[64 * j] = p; } } } while (0)
    for (int it = gw; it < NITEMS; it += NGW) {
        const bool ds_ = true;
        do {
            int r = it;
            if (r < I_IN) { const int kb = r / 248, nb = r % 248, dr = 32 * nb; int src = dr;
                if (dr >= QKV_W) { const int o = dr - QKV_W, j = o >> 8, i = o & 255; src = (i < 128) ? QKV_W + 128 * j + i : QKV_W + 1024 + 128 * j + (i - 128); }
                tr_item<true>(a.in[2], IN_W, 64 * kb, src, win, 1024, dr, scr, lane, a.in[1], ds_); break; } r -= I_IN;
            if (r < I_BD) { tr_item<false>(a.in[4], 1024, 64 * (r >> 5), 32 * (r & 31), wbr + 1024, 1536, 32 * (r & 31), scr, lane, nullptr, ds_); break; } r -= I_BD;
            if (r < I_BS) { tr_item<false>(a.in[5], 1024, 64 * (r >> 5), 32 * (r & 31), wbr, 1536, 32 * (r & 31), scr, lane, nullptr, ds_); break; } r -= I_BS;
            if (r < I_OUT) { tr_item<false>(a.in[6], 1024, 64 * (r >> 5), 32 * (r & 31), wout, 1024, 32 * (r & 31), scr, lane, nullptr, ds_); break; } r -= I_OUT;
            if (r < I_G + I_U) { const int up = r >= I_G; if (up) r -= I_G; const int e = r >> 8, kb = (r >> 4) & 15, nb = r & 15;
                tr_item<true>((up ? a.in[13] : a.in[12]) + (size_t)e * 1024 * 512, 512, 64 * kb, 32 * nb, wgu, 1024, e * 1024 + 256 * (nb >> 2) + 128 * up + 32 * (nb & 3), scr, lane, a.in[7], ds_); break; } r -= I_G + I_U;
            { const int e = r >> 8, kb = (r >> 5) & 7, nb = r & 31;
                tr_item<false>(a.in[14] + (size_t)e * 512 * 1024, 1024, 64 * kb, 32 * nb, wd, 512, e * 1024 + 32 * nb, scr, lane, nullptr, ds_); }
        } while (0);
        P0_NORM_ROW(); P0_NORM_ROW();
    }
    while (nrow < NTOK) P0_NORM_ROW();
#undef P0_NORM_ROW
    { u32x4* img = (u32x4*)(F.ws + WS_WRT); const float* gf = a.in[7]; const float* wg = a.in[8]; const float* wr = a.in[10];
        for (int i = F.vcu * 512 + F.tid; i < 2 * 32 * 3 * 64; i += F.G * 512) {
            const int ln = i & 63, q = i >> 6, b = q % 3, t = (q / 3) & 31, half = q / 96, n = ln & 31;
            const int k0 = 512 * half + 64 * (t >> 2) + 32 * (ln >> 5) + 8 * (t & 3);
            const bool want_lo = (b == 1) || (b == 2 && n >= 4);
            float w[8];
#pragma unroll
            for (int j = 0; j < 8; ++j) { const int k = k0 + j; float v = 0.f;
                if (b < 2) v = gf[k] * wr[k * 32 + n]; else if (n < 8) v = gf[k] * wg[k * 4 + (n & 3)];
                const float hi = bf_lo(cvtpk(v, 0.f));
                w[j] = want_lo ? v - hi : hi; }
            u32x4 o; o.x = cvtpk(w[0], w[1]); o.y = cvtpk(w[2], w[3]); o.z = cvtpk(w[4], w[5]); o.w = cvtpk(w[6], w[7]);
            img[i] = o; } }
}

#ifndef ATT_REVERSE
#define ATT_REVERSE 1
#endif
#ifndef ATT_RUNS
#define ATT_RUNS 1
#endif
#ifndef ATT_PRIO
#define ATT_PRIO 1
#endif
#ifndef SWA_NH
#define SWA_NH 8
#endif
constexpr int ATT_NSWA = 2 * 32 * (8 / SWA_NH), ATT_UPB = ATT_NSWA + 24 * 32;
__device__ __forceinline__ void attn_make_unit(const Frame& F, const int gi, att::UnitDesc& U) {
    const bf16* qkv = (const bf16*)(F.ws + WS_QKV);
    int b, ui;
    if (ATT_RUNS && F.G == 256 && SWA_NH == 8) {
        const int k = gi >> 8, v = gi & 255;
        if (k < 2) { const int s = 2 * v + k; b = s >> 6; ui = s & 63; }
        else { const int d = 24 * v + (k - 2); b = d / 768; ui = ATT_NSWA + (d - b * 768); }
    } else {
        const int gr = ATT_REVERSE ? (NB * ATT_UPB - 1 - gi) : gi;
        b = gr / ATT_UPB; ui = gr - b * ATT_UPB;
    }
    if (ui < ATT_NSWA) {
        const int grp = ui % (8 / SWA_NH), blkq = (ui / (8 / SWA_NH)) & 31, kvh = ui / (32 * (8 / SWA_NH)), head0 = kvh * 8 + grp * SWA_NH;
        U.rb = qkv + (size_t)(b * T + 256 * blkq) * 64;
        U.qcol = COL_QS / 64 + head0; U.kcol = COL_KS / 64 + kvh; U.vcol = COL_VS / 64 + kvh;
        U.has_prev = blkq != 0; U.nh = SWA_NH; U.mixer = 1; U.head0 = head0; U.dil = 1; U.ltok0 = 0; U.lstride = 0;
    } else {
        const int au = ui - ATT_NSWA, blkq = au & 31, head = au >> 5, sh = 2 * (head >> 3), L = T >> sh;
        const int prow = 256 * blkq, r = prow >> (13 - sh), u0 = prow & (L - 1);
        U.rb = qkv + (size_t)(b * T + prow) * 64;
        U.qcol = head; U.kcol = COL_KD / 64 + head; U.vcol = COL_VD / 64 + head;
        U.has_prev = u0 != 0; U.nh = 1; U.mixer = 0; U.head0 = head; U.dil = 1 << sh;
        U.ltok0 = b * T + (u0 << sh) + r; U.lstride = 1 << sh;
    }
}
__device__ __forceinline__ void attn_phase(const Frame& F, const float* sinks) {
    int gi = F.vcu;
    if (gi >= NB * ATT_UPB) return;
    att::UnitDesc U, Un; bf16x8 qn[4]; unsigned pt[6] = {0u, 0u, 0u, 0u, 0u, 0u};
    attn_make_unit(F, gi, U);
    { const int w = F.wave, lane = F.lane;
      att::dma_image<false>(F.lds + att::LDS_K, U.rb + (size_t)U.kcol * TS, w, lane, U.has_prev != 0);
      att::dma_image<true>(F.lds + att::LDS_V, U.rb + (size_t)U.vcol * TS, w, lane, U.has_prev != 0);
      const bf16* qrow = U.rb + (size_t)U.qcol * TS + (32 * w + (lane & 31)) * 64 + 8 * (lane >> 5);
#pragma unroll
      for (int kk = 0; kk < 4; ++kk) qn[kk] = *(const bf16x8*)(qrow + 16 * kk); }
    if (ATT_PRIO && F.wave >= 4) __builtin_amdgcn_s_setprio(1);
    int vpar = 0;
    for (;;) {
        const bool has_next = gi + F.G < NB * ATT_UPB;
        attn_make_unit(F, has_next ? gi + F.G : gi, Un);
        att::attn_unit(F.lds, F.tid, U, sinks, (float*)(F.ws + WS_LSE), has_next, Un, qn, vpar, pt);
        if (!has_next) break;
        gi += F.G; U = Un; vpar ^= 1;
    }
    if (ATT_PRIO) __builtin_amdgcn_s_setprio(0);
    asm volatile("s_waitcnt vmcnt(0)" ::: "memory");
    __syncthreads();
    if (PROBE_T >= 40 && F.vcu == 5 && F.tid == 0) { for (int i = 0; i < 6; ++i) F.ctl[20040 + i] = pt[i]; }
}
__device__ __forceinline__ void merge_phase(const Frame& F) {
    bf16* qkv = (bf16*)(F.ws + WS_QKV); const float* lse = (const float*)(F.ws + WS_LSE);
    for (int it = F.vcu * 512 + F.tid; it < NTOK * 64; it += F.G * 512) {
        const int dc = it & 7, hs = (it >> 3) & 7, t = it >> 6, tb = t & ~(T - 1), tl = t & (T - 1);
        const float l0 = lse[(size_t)t * 24 + hs], l1 = lse[(size_t)t * 24 + 8 + hs], l2 = lse[(size_t)t * 24 + 16 + hs];
        const float mx = fmaxf(l0, fmaxf(l1, l2));
        float w0 = __expf(l0 - mx), w1 = __expf(l1 - mx), w2 = __expf(l2 - mx); const float inv = 1.f / (w0 + w1 + w2); w0 *= inv; w1 *= inv; w2 *= inv;
        const int r1 = tb | ((tl & 3) << 11) | (tl >> 2), r2 = tb | ((tl & 15) << 9) | (tl >> 4);
        f32x4 a0, b0, a1, b1, a2, b2;
        unpack8(__builtin_nontemporal_load((const u32x4*)(qkv + (size_t)hs * TS + (size_t)t * 64 + dc * 8)), a0, b0);
        unpack8(__builtin_nontemporal_load((const u32x4*)(qkv + (size_t)(8 + hs) * TS + (size_t)r1 * 64 + dc * 8)), a1, b1);
        unpack8(__builtin_nontemporal_load((const u32x4*)(qkv + (size_t)(16 + hs) * TS + (size_t)r2 * 64 + dc * 8)), a2, b2);
        *(u32x4*)(qkv + (size_t)(COL_YDIL / 64 + hs) * TS + (size_t)t * 64 + dc * 8) = pack8(a0 * w0 + a1 * w1 + a2 * w2, b0 * w0 + b1 * w1 + b2 * w2);
    }
}
__device__ __forceinline__ float dot4(const f32x4 a, const f32x4 b) { return (a.x * b.x + a.y * b.y) + (a.z * b.z + a.w * b.w); }
constexpr int RT_IMG_HALF = 32 * 3 * 1024;
constexpr int RT_STAGE_OFF = RT_IMG_HALF, RT_SP = 41;
static_assert(RT_STAGE_OFF + 8 * 32 * RT_SP * 4 <= P5_CNT_OFF, "router LDS");
__device__ __forceinline__ void router_phase(const Frame& F, const bf16* x1, const float* bg, const float* br) {
    const int lane = F.lane, tid = F.tid, n = lane & 31, h = lane >> 5;
    volatile LAS unsigned* cnt = (volatile LAS unsigned*)(F.lds + P5_CNT_OFF); volatile LAS unsigned* basew = (volatile LAS unsigned*)(F.lds + P5_BASE_OFF);
    volatile LAS unsigned* rec = (volatile LAS unsigned*)(F.lds + P5_REC_OFF);
    if (tid < 32) cnt[tid] = 0u;
    const int RPW = NTOK / F.G, row0 = F.vcu * RPW;
    const u32x4* img = (const u32x4*)(F.ws + WS_WRT);
    LAS float* stage = (LAS float*)(F.lds + RT_STAGE_OFF) + F.wave * (32 * RT_SP);
    float* rstd2 = (float*)(F.ws + WS_RSTD2); float* rw = (float*)(F.ws + WS_RW);
    for (int c0 = 0; c0 < RPW; c0 += 256) {
        const int lrow = c0 + 32 * F.wave + n;
        const u32x4* xp = (const u32x4*)(x1 + (size_t)(row0 + lrow) * 1024 + 32 * h);
        f32x16 ae, ag, as_;
#pragma unroll
        for (int r = 0; r < 16; ++r) { ae[r] = 0.f; ag[r] = 0.f; as_[r] = 0.f; }
        u32x4 a0[4], a1[4], a2[4];
#define RT_MFMA(a, b, c) __builtin_amdgcn_mfma_f32_32x32x16_bf16((a), (b), (c), 0, 0, 0)
#define RT_LOADA(buf, SS) do { _Pragma("unroll") for (int i = 0; i < 4; ++i) buf[i] = xp[8 * (SS) + i]; } while (0)
#define RT_SS(cur, nxt, SS) do { \
        if ((SS) == 0 || (SS) == 8) { __syncthreads(); \
            for (int i = tid; i < RT_IMG_HALF / 16; i += 512) ((LAS u32x4*)F.lds)[i] = img[((SS) >> 3) * (RT_IMG_HALF / 16) + i]; \
            __syncthreads(); } \
        if ((SS) + 2 < 16) RT_LOADA(nxt, (SS) + 2); \
        _Pragma("unroll") for (int i = 0; i < 4; ++i) { const LAS bf16x8* bp = (const LAS bf16x8*)F.lds + (4 * ((SS) & 7) + i) * 192 + lane; \
            const bf16x8 av = __builtin_bit_cast(bf16x8, cur[i]); \
            ae = RT_MFMA(av, bp[0], ae); ae = RT_MFMA(av, bp[64], ae); ag = RT_MFMA(av, bp[128], ag); as_ = RT_MFMA(av, av, as_); } } while (0)
        RT_LOADA(a0, 0); RT_LOADA(a1, 1);
        RT_SS(a0, a2, 0); RT_SS(a1, a0, 1); RT_SS(a2, a1, 2); RT_SS(a0, a2, 3); RT_SS(a1, a0, 4); RT_SS(a2, a1, 5); RT_SS(a0, a2, 6); RT_SS(a1, a0, 7);
        RT_SS(a2, a1, 8); RT_SS(a0, a2, 9); RT_SS(a1, a0, 10); RT_SS(a2, a1, 11); RT_SS(a0, a2, 12); RT_SS(a1, a0, 13); RT_SS(a2, a1, 14); RT_SS(a0, a2, 15);
#undef RT_SS
#undef RT_LOADA
#undef RT_MFMA
        float ssd = 0.f;
#pragma unroll
        for (int r = 0; r < 16; ++r) { const int row = (r & 3) + 8 * (r >> 2) + 4 * h;
            stage[row * RT_SP + n] = ae[r]; if (n < 8) stage[row * RT_SP + 32 + n] = ag[r]; if (row == n) ssd = as_[r]; }
        if (h == ((n >> 2) & 1)) stage[n * RT_SP + 40] = ssd;
        LDS_WAIT(); asm volatile("" ::: "memory");
        if (lane < 32) {
            const LAS float* sr = stage + n * RT_SP; const int row = row0 + lrow;
            const float rstd = 1.f / sqrtf(sr[40] * (1.f / 1024.f) + RMS_EPS);
            float gl[4];
#pragma unroll
            for (int e = 0; e < 4; ++e) gl[e] = (sr[32 + e] + sr[36 + e]) * rstd + bg[e];
            int gt = 0; float gm = gl[0];
#pragma unroll
            for (int e = 1; e < 4; ++e) if (gl[e] > gm) { gm = gl[e]; gt = e; }
            float gz = 0.f;
#pragma unroll
            for (int e = 0; e < 4; ++e) gz += __expf(gl[e] - gm);
            const float gwt = 1.f / gz;
            float el[8];
#pragma unroll
            for (int e = 0; e < 8; ++e) el[e] = sr[8 * gt + e] * rstd + br[8 * gt + e];
            int i0 = 0; float m0 = el[0];
#pragma unroll
            for (int e = 1; e < 8; ++e) if (el[e] > m0) { m0 = el[e]; i0 = e; }
            int i1 = -1; float m1 = -INFINITY;
#pragma unroll
            for (int e = 0; e < 8; ++e) if (e != i0 && el[e] > m1) { m1 = el[e]; i1 = e; }
            if (i1 < 0) i1 = (i0 == 0) ? 1 : 0;
            const float ed = __expf(m1 - m0), w0 = 1.f / (1.f + ed), w1 = ed * w0;
            const unsigned E0 = (unsigned)(8 * gt + i0), E1 = (unsigned)(8 * gt + i1);
            const unsigned r0 = __hip_atomic_fetch_add((LAS unsigned*)&cnt[E0], 1u, __ATOMIC_RELAXED, __HIP_MEMORY_SCOPE_WORKGROUP);
            const unsigned r1 = __hip_atomic_fetch_add((LAS unsigned*)&cnt[E1], 1u, __ATOMIC_RELAXED, __HIP_MEMORY_SCOPE_WORKGROUP);
            rec[lrow] = E0 | (E1 << 5) | (r0 << 10) | (r1 << 20);
            rw[2 * row] = gwt * w0; rw[2 * row + 1] = gwt * w1; rstd2[row] = rstd;
        }
    }
    __syncthreads();
    if (tid < 32) basew[tid] = __hip_atomic_fetch_add(F.ctl + CW_CNT + 64 * tid, cnt[tid], RLX_AGENT);
    __syncthreads();
    unsigned* re = (unsigned*)(F.ws + WS_RE); unsigned* rrel = (unsigned*)(F.ws + WS_RREL);
    for (int lt = tid; lt < RPW; lt += 512) { const unsigned rc = rec[lt], E0 = rc & 31u, E1 = (rc >> 5) & 31u; const int row = row0 + lt;
        re[row] = E0 | (E1 << 8); rrel[2 * row] = basew[E0] + ((rc >> 10) & 1023u); rrel[2 * row + 1] = basew[E1] + ((rc >> 20) & 1023u); }
}
__device__ __forceinline__ void slots_phase(const Frame& F) {
    volatile LAS unsigned* cnt = (volatile LAS unsigned*)F.lds; volatile LAS unsigned* off = cnt + 32;
    if (F.tid < 32) cnt[F.tid] = ld_agent(F.ctl + CW_CNT + 64 * F.tid);
    __syncthreads();
    if (F.tid == 0) { unsigned o = 0; for (int e = 0; e < 32; ++e) { off[e] = o; o += (cnt[e] + 255u) & ~255u; } off[32] = o; }
    __syncthreads();
    const int RPW = NTOK / F.G, row0 = F.vcu * RPW;
    const unsigned* re = (const unsigned*)(F.ws + WS_RE); const unsigned* rrel = (const unsigned*)(F.ws + WS_RREL); const float* rw = (const float*)(F.ws + WS_RW);
    unsigned* tos = (unsigned*)(F.ws + WS_TOS); float* wos = (float*)(F.ws + WS_WOS); float* rss = (float*)(F.ws + WS_RSS); const float* rstd2 = (const float*)(F.ws + WS_RSTD2); unsigned* sot = (unsigned*)(F.ws + WS_SOT); unsigned* pex = (unsigned*)(F.ws + WS_PEX);
    for (int lt = F.tid; lt < RPW; lt += 512) { const int row = row0 + lt; const unsigned ev = re[row], e0 = ev & 255u, e1 = ev >> 8;
        const unsigned s0 = off[e0] + rrel[2 * row], s1 = off[e1] + rrel[2 * row + 1];
        tos[s0] = (unsigned)row; tos[s1] = (unsigned)row; wos[s0] = rw[2 * row]; wos[s1] = rw[2 * row + 1]; { const float r2 = rstd2[row]; rss[s0] = r2; rss[s1] = r2; } sot[2 * row] = s0; sot[2 * row + 1] = s1; }
    for (int e = F.vcu; e < 32; e += F.G) { const unsigned c = cnt[e], pad = ((c + 255u) & ~255u) - c;
        for (unsigned i = F.tid; i < pad; i += 512) { tos[off[e] + c + i] = 0u; wos[off[e] + c + i] = 0.f; rss[off[e] + c + i] = 0.f; } }
    if (F.vcu == F.G - 1) { const unsigned np = off[32] >> 8;
        for (unsigned p = F.tid; p < np; p += 512) { unsigned e = 0; for (unsigned k = 0; k < 32; ++k) if (off[k] <= 256u * p && 256u * p < off[k + 1]) e = k; pex[p] = e; }
        if (F.tid == 0) pex[1023] = np; }
    __syncthreads();
}
__device__ __forceinline__ void final_phase(const Frame& F, float* out, const float* gfin) {
    const bf16* x1b = (const bf16*)(F.ws + WS_X1B);
    const int lane = F.lane, gw = F.vcu * 8 + F.wave, NGW = F.G * 8;
    const unsigned* sot = (const unsigned*)(F.ws + WS_SOT); const bf16* ys = (const bf16*)(F.ws + WS_YS);
    f32x4 gv[4];
#pragma unroll
    for (int j = 0; j < 4; ++j) gv[j] = *(const f32x4*)(gfin + 4 * lane + 256 * j);
    u32x2 xn[4], y0n[4], y1n[4];
#define FIN_LOAD(r) do { const unsigned _s0 = sot[2 * (r)], _s1 = sot[2 * (r) + 1]; const u32x2* _x = (const u32x2*)(x1b + (size_t)(r) * 1024) + lane; \
        const u32x2* _y0 = (const u32x2*)(ys + (size_t)_s0 * 1024) + lane; const u32x2* _y1 = (const u32x2*)(ys + (size_t)_s1 * 1024) + lane; \
        _Pragma("unroll") for (int j = 0; j < 4; ++j) { xn[j] = __builtin_nontemporal_load(_x + 64 * j); y0n[j] = __builtin_nontemporal_load(_y0 + 64 * j); y1n[j] = __builtin_nontemporal_load(_y1 + 64 * j); } } while (0)
    if (gw < NTOK) FIN_LOAD(gw);
    for (int row = gw; row < NTOK; row += NGW) {
        f32x4* xr = (f32x4*)(out + (size_t)row * 1024) + lane;
        f32x4 v[4]; float ss = 0.f;
#pragma unroll
        for (int j = 0; j < 4; ++j) { const u32x2 p = y0n[j], q = y1n[j], xw = xn[j];
            v[j] = (f32x4){bf_lo(xw.x), bf_hi(xw.x), bf_lo(xw.y), bf_hi(xw.y)} + (f32x4){bf_lo(p.x), bf_hi(p.x), bf_lo(p.y), bf_hi(p.y)} + (f32x4){bf_lo(q.x), bf_hi(q.x), bf_lo(q.y), bf_hi(q.y)}; ss += dot4(v[j], v[j]); }
        if (row + NGW < NTOK) FIN_LOAD(row + NGW);
        const float rstd = 1.f / sqrtf(wave_sum(ss) * (1.f / 1024.f) + RMS_EPS);
#pragma unroll
        for (int j = 0; j < 4; ++j) __builtin_nontemporal_store(v[j] * rstd * gv[j], xr + 64 * j);
    }
#undef FIN_LOAD
}

__device__ __forceinline__ void stagger_delay(unsigned ticks) {
    if (ticks == 0u) return;
    const unsigned long long t0 = __builtin_amdgcn_s_memrealtime();
    while ((unsigned long long)__builtin_amdgcn_s_memrealtime() - t0 < (unsigned long long)ticks) __builtin_amdgcn_s_sleep(16);
}
#ifndef GEMM1_WGM
#define GEMM1_WGM 4
#endif
#ifndef STAG5
#define STAG5 400
#endif
#ifndef STAG9
#define STAG9 0
#endif
#ifndef STAG1
#define STAG1 0
#endif
__device__ __forceinline__ void handoff_signal(unsigned* ctr, int tid) {
    asm volatile("s_waitcnt vmcnt(0)" ::: "memory");
    __syncthreads();
    if (tid == 0) { __builtin_amdgcn_fence(__ATOMIC_RELEASE, "agent"); asm volatile("s_waitcnt vmcnt(0)" ::: "memory"); (void)__hip_atomic_fetch_add(ctr, 1u, RLX_AGENT); }
}
__device__ __forceinline__ void handoff_wait(unsigned* ctr, unsigned target, unsigned* tmo, int tid) {
    if (tid == 0) { unsigned sp = 0;
        while (ld_agent(ctr) < target) { __builtin_amdgcn_s_sleep(2); if ((++sp & 255u) == 0u) { if (ld_agent(tmo)) break; if (sp > (1u << 20)) { atomicAdd(tmo, 1u); break; } } }
        __builtin_amdgcn_fence(__ATOMIC_ACQUIRE, "agent"); asm volatile("s_waitcnt vmcnt(0)" ::: "memory"); }
    __syncthreads();
}
constexpr int N_PHASES = 10;
constexpr int KA_OUT = 128, KA_WS = 136, KA_LO = 144, KA_HI = 148;
#if defined(__HIP_DEVICE_COMPILE__)
__device__ __forceinline__ unsigned long long karg64(int off) { auto k = __builtin_amdgcn_kernarg_segment_ptr(); unsigned long long v;
    asm volatile("s_load_dwordx2 %0, %1, %2\n\ts_waitcnt lgkmcnt(0)" : "=s"(v) : "s"(k), "i"(off)); return v; }
__device__ __forceinline__ int karg32(int off) { auto k = __builtin_amdgcn_kernarg_segment_ptr(); int v;
    asm volatile("s_load_dword %0, %1, %2\n\ts_waitcnt lgkmcnt(0)" : "=s"(v) : "s"(k), "i"(off)); return v; }
#else
__device__ __forceinline__ unsigned long long karg64(int) { return 0ull; }
__device__ __forceinline__ int karg32(int) { return 0; }
#endif
#define KIN(i) ((const float*)(const GAS float*)karg64(8 * (i)))
#define KPTR(T, off) ((T*)(GAS T*)karg64(off))
__device__ __forceinline__ Frame make_frame(int wv) {
    extern __shared__ __attribute__((aligned(16))) unsigned char lds_raw[];
    Frame F; int bx = blockIdx.x, G = gridDim.x;
    asm volatile("" : "+s"(bx), "+s"(G), "+s"(wv));
    int tid = wv * 64 + (int)__builtin_amdgcn_mbcnt_hi(~0u, __builtin_amdgcn_mbcnt_lo(~0u, 0u));
    asm volatile("" : "+v"(tid));
    F.lds = (LAS unsigned char*)lds_raw; F.MISC = (volatile LAS unsigned*)(F.lds + MISC_OFF);
    F.tid = tid; F.lane = tid & 63; F.wave = __builtin_amdgcn_readfirstlane(tid >> 6);
    F.G = G; F.bx = bx; F.vcu = (G % 8 == 0) ? (bx % 8) * (G / 8) + bx / 8 : bx;
    F.ws = KPTR(unsigned char, KA_WS); F.ctl = (unsigned*)(F.ws + WS_CTL);
    return F;
}
__global__ void __launch_bounds__(512, 2) mk_fwd(Args args_unused) {
    const int wv = __builtin_amdgcn_readfirstlane((int)threadIdx.x >> 6);
    { Frame F = make_frame(wv); if (F.tid < 64) F.MISC[F.tid] = 0u; __syncthreads();
      if (MK_ONE_LAUNCH) (void)xcd_barrier_post(F.ctl + CW_BAR, F.MISC + 8); }
    const int lo = karg32(KA_LO), hi = karg32(KA_HI);
    if (PROBE_T >= 20) { Frame Fp = make_frame(wv); if (Fp.vcu == 5 && Fp.tid == 0) Fp.ctl[20020] = (unsigned)__builtin_amdgcn_s_memrealtime(); }
#define IN(k) (lo <= (k) && (k) < hi)
#define SEAM(k) do { if (IN(k) && IN((k) + 1)) { Frame Fb = make_frame(wv); XcdBarrier bar; bar.bar = Fb.ctl + CW_BAR; bar.x = xb_xcc_id(); bar.st = Fb.MISC + 8; xcd_barrier(bar); \
        if (PROBE_T >= 20 && Fb.vcu == 5 && Fb.tid == 0) Fb.ctl[20021 + (k)] = (unsigned)__builtin_amdgcn_s_memrealtime(); } } while (0)
#define GBAR() do { Frame Fb = make_frame(wv); XcdBarrier bar; bar.bar = Fb.ctl + CW_BAR; bar.x = xb_xcc_id(); bar.st = Fb.MISC + 8; xcd_barrier(bar); } while (0)
#define REP(k) for (int rep_ = 0; rep_ < (PROBE_DUP == (k) ? 2 : 1); ++rep_)
#define REPBAR(k) do { if (PROBE_DUP == (k) && rep_ == 0) GBAR(); } while (0)
    if (IN(0)) REP(7) { Frame F = make_frame(wv); Args a{}; for (int i = 0; i < 16; ++i) a.in[i] = KIN(i); p0_prologue(F, a); REPBAR(7); } SEAM(0);
    if (IN(1)) REP(1) {
        Frame F = make_frame(wv); bf16* gates = (bf16*)KPTR(float, KA_OUT);
        pg8::Gemm g{(const bf16*)(F.ws + WS_H), nullptr, (const bf16*)(F.ws + WS_WIN), nullptr, 2048, 2048, 16, 16, 128}; pg8::StaticOrder<false, PROBE_DUP == 9> S; S.init(NTOK, IN_W, F.G, F.bx, GEMM1_WGM);
        Epi1 E{(bf16*)(F.ws + WS_QKV), gates, gates + (size_t)NTOK * 1024, (PROBE_T && (F.vcu == 5 || PROBE_T >= 8)) ? (unsigned*)(F.ctl + 20000) : nullptr};
        stagger_delay(xb_xcc_id() * (unsigned)STAG1);
        pg8::gemm_phase<Epi1, pg8::StaticOrder<false, PROBE_DUP == 9>, false>(F.lds, F.tid, g, S, E, nullptr);
        REPBAR(1);
    }
    SEAM(1);
    if (IN(2)) REP(2) { Frame F = make_frame(wv); attn_phase(F, KIN(3)); REPBAR(2); }
    SEAM(2);
    if (IN(3)) REP(8) { Frame F = make_frame(wv); merge_phase(F); REPBAR(8); }
    SEAM(3);
    if (IN(4)) REP(3) {
        Frame F = make_frame(wv); const bf16* gates = (const bf16*)KPTR(float, KA_OUT); const bf16* qkv = (const bf16*)(F.ws + WS_QKV); const bf16* wbr = (const bf16*)(F.ws + WS_WBR);
        pg8::Gemm g{qkv + (COL_QS / 64) * TS, qkv + (COL_YDIL / 64) * TS, wbr, wbr + 1024, 128, 1536 * 2, 16, 8, TS * 2}; pg8::StaticOrder<true> S; S.init(NTOK, 1024, F.G, F.bx);
        EpiMix E{gates, gates + (size_t)NTOK * 1024, (bf16*)(F.ws + WS_QKV) + (COL_MIX / 64) * TS, (PROBE_T && F.vcu == 5) ? (unsigned*)(F.ctl + 20000) : nullptr};
        pg8::gemm_phase<EpiMix, pg8::StaticOrder<true>, false>(F.lds, F.tid, g, S, E, nullptr);
        REPBAR(3);
    }
    SEAM(4);
    if (IN(5)) REP(4) {
        Frame F = make_frame(wv);
        pg8::Gemm g{(const bf16*)(F.ws + WS_QKV) + (COL_MIX / 64) * TS, nullptr, (const bf16*)(F.ws + WS_WOUT), nullptr, 128, 2048, 16, 16, TS * 2}; pg8::StaticOrder<false> S; S.init(NTOK, 1024, F.G, F.bx, pg8::WGM, true);
        EpiRes E{(const bf16*)(F.ws + WS_H), (const float*)(F.ws + WS_RMS1), (bf16*)(F.ws + WS_X1B), (PROBE_T && F.vcu == 5) ? (unsigned*)(F.ctl + 20000) : nullptr};
        pg8::gemm_phase<EpiRes, pg8::StaticOrder<false>, false>(F.lds, F.tid, g, S, E, nullptr);
        REPBAR(4);
    }
    SEAM(5);
    if (IN(6)) { Frame F = make_frame(wv); router_phase(F, (const bf16*)(F.ws + WS_X1B), KIN(9), KIN(11)); }
    SEAM(6);
    if (IN(7)) { Frame F = make_frame(wv); slots_phase(F); }
    SEAM(7);
    if (IN(8)) {
        int R, rem, np4;
        { Frame F = make_frame(wv); np4 = 4 * __builtin_amdgcn_readfirstlane((int)ld_agent((const unsigned*)(F.ws + WS_PEX) + 1023)); R = np4 / F.G; rem = np4 - R * F.G; }
        for (int ps = 0; ps < 2; ++ps) {
            Frame F = make_frame(wv);
            pg8::Gemm g{(const bf16*)(F.ws + WS_X1B), nullptr, (const bf16*)(F.ws + WS_WGU), nullptr, 2048, 2048, 16, 16, 128}; pg8::PanelOrder S;
            S.init((const unsigned*)(F.ws + WS_PEX), (volatile LAS int*)(F.lds + PANEL_TAB_OFF), F.G, F.vcu, F.tid, ps ? R : 0, ps ? R + 1 : R, np4, (const float*)(F.ws + WS_RSS), (LAS float*)(F.lds + PANEL_AUX_OFF));
            EpiGU E{(bf16*)(F.ws + WS_ACT), (const float*)(F.ws + WS_RSS), (const LAS float*)(F.lds + PANEL_AUX_OFF)};
            const bool mine = S.n > 0;
            pg8::gemm_phase<EpiGU, pg8::PanelOrder, true>(F.lds, F.tid, g, S, E, (const unsigned*)(F.ws + WS_TOS));
            if (ps == 0 || mine) { Frame F2 = make_frame(wv); handoff_signal(F2.ctl + CW_HO + 64 * ps, F2.tid); }
        }
        for (int ps = 0; ps < 2; ++ps) {
            Frame F = make_frame(wv);
            const int c = ps ? F.G - 1 - F.vcu : F.vcu;
            if (ps == 0) handoff_wait(F.ctl + CW_HO, (unsigned)F.G, F.ctl + CW_BAR + XB_TMO, F.tid);
            else if (c < rem) handoff_wait(F.ctl + CW_HO + 64, (unsigned)rem, F.ctl + CW_BAR + XB_TMO, F.tid);
            pg8::Gemm g{(const bf16*)(F.ws + WS_ACT), nullptr, (const bf16*)(F.ws + WS_WD), nullptr, 1024, 1024, 8, 8, 128}; pg8::PanelOrder S;
            S.init((const unsigned*)(F.ws + WS_PEX), (volatile LAS int*)(F.lds + PANEL_TAB_OFF), F.G, c, F.tid, ps ? R : 0, ps ? R + 1 : R, np4, (const float*)(F.ws + WS_WOS), (LAS float*)(F.lds + PANEL_AUX_OFF));
            S.rev = true;
            EpiDown E{(bf16*)(F.ws + WS_YS), (const float*)(F.ws + WS_WOS), (const LAS float*)(F.lds + PANEL_AUX_OFF), (PROBE_T && (F.vcu == 5 || PROBE_T >= 8)) ? (unsigned*)(F.ctl + 20000) : nullptr};
            pg8::gemm_phase<EpiDown, pg8::PanelOrder, false>(F.lds, F.tid, g, S, E, nullptr);
        }
    }
    SEAM(9);
    if (IN(10)) { Frame F = make_frame(wv); final_phase(F, KPTR(float, KA_OUT), KIN(15)); }
#if PROBE_T
    { Frame F = make_frame(wv);
      if (F.vcu == 5) { const unsigned kl = ld_agent(F.ctl + 20001), ep = ld_agent(F.ctl + 20002), cyc = ld_agent(F.ctl + 20003), tk = ld_agent(F.ctl + 20004);
        unsigned d = 0;
        if (PROBE_T == 5) d = (unsigned)((float)cyc / (float)tk * 100.f * 25.f);
        if (PROBE_T == 6) d = ep * 2u;
        if (PROBE_T == 7) d = kl;
        if (PROBE_T >= 20 && PROBE_T < 40) { const unsigned t1 = (PROBE_T - 20 == 10) ? (unsigned)__builtin_amdgcn_s_memrealtime() : ld_agent(F.ctl + 20021 + (PROBE_T - 20)); d = 4u * (t1 - ld_agent(F.ctl + 20020 + (PROBE_T - 20))); }
        if (PROBE_T >= 40 && PROBE_T < 46) d = 4u * ld_agent(F.ctl + 20040 + (PROBE_T - 40));
        if (PROBE_T == 8) d = ld_agent(F.ctl + 20010);
        if (PROBE_T == 9) d = 0x7fffffffu - ld_agent(F.ctl + 20011);
        stagger_delay(d > 200000u ? 200000u : d); } }
#endif
#undef IN
#undef SEAM
}

extern "C" void kernel_launch(void* const* d_in, const int* in_sizes, int n_in, void* d_out, int out_size, void* d_ws, size_t ws_size, hipStream_t stream) {
    static int grid = 0;
    if (grid == 0) {
        if (n_in != 16 || in_sizes[0] != NTOK * D || out_size != NTOK * D || ws_size < WS_END) { fprintf(stderr, "kernel_launch: unexpected shapes / workspace (%d inputs, ws %zu)\n", n_in, ws_size); grid = -1; return; }
        int dev = 0, cus = 0;
        if (hipGetDevice(&dev) != hipSuccess || hipDeviceGetAttribute(&cus, hipDeviceAttributeMultiprocessorCount, dev) != hipSuccess) { grid = -1; return; }
        if (hipFuncSetAttribute((const void*)mk_fwd, hipFuncAttributeMaxDynamicSharedMemorySize, LDS_BYTES) != hipSuccess) { fprintf(stderr, "kernel_launch: hipFuncSetAttribute(%d) failed\n", LDS_BYTES); grid = -1; return; }
        int per_cu = 0;
        if (hipOccupancyMaxActiveBlocksPerMultiprocessor(&per_cu, (const void*)mk_fwd, 512, LDS_BYTES) != hipSuccess || per_cu < 1) { fprintf(stderr, "kernel_launch: occupancy query says %d\n", per_cu); }
        (void)hipGetLastError();
        if (cus < 128) { fprintf(stderr, "kernel_launch: needs at least 128 CUs (got %d)\n", cus); grid = -1; return; }
        int g = 64; while (g * 2 <= cus && g * 2 <= 256) g *= 2;
        grid = g;
    }
    if (grid < 0) return;
    (void)hipMemsetAsync((char*)d_ws + WS_CTL, 0, CTL_ZERO_BYTES, stream);
    Args a{};
    for (int i = 0; i < 16; ++i) a.in[i] = (const float*)d_in[i];
    a.out = (float*)d_out; a.ws = (unsigned char*)d_ws;
#if MK_ONE_LAUNCH
    a.ph_lo = 0; a.ph_hi = N_PHASES + 1;
    hipLaunchKernelGGL(mk_fwd, dim3(grid), dim3(512), LDS_BYTES, stream, a);
#else
    for (int p = 0; p <= N_PHASES; ++p) { a.ph_lo = p; a.ph_hi = p + 1; hipLaunchKernelGGL(mk_fwd, dim3(grid), dim3(512), LDS_BYTES, stream, a); }
#endif
}
```
